# Optimizing an MI355X kernel written in HIP

```python
import jax, jax.numpy as jnp
from jax import lax
import numpy as np

D_MODEL = 1024
BATCH = 32
SEQ = 2048
DEPTH = 2
DEC_BATCH = 8
DEC_SEQ = 16
PAST_LEN = 4096

CHUNK = 64
POOL_WINDOWS = (2, 4, 8, 16)
POOL_PAST = max(POOL_WINDOWS) - 1
POOL_WIDTH = D_MODEL // 4
POOL_GROUP = POOL_WIDTH // len(POOL_WINDOWS)
CONV_WIDTH = 3 * D_MODEL // 8
CONV_K = 31
SCONV_WIDTH = D_MODEL - POOL_WIDTH - CONV_WIDTH
SCONV_K = 3
MIX_WIDTH = POOL_WIDTH + CONV_WIDTH + SCONV_WIDTH
IN_WIDTH = POOL_WIDTH + 2 * CONV_WIDTH + 3 * SCONV_WIDTH
D_FF = -(-8 * D_MODEL // (3 * 256)) * 256
EPS = 1e-6

kernel_name = 'hybrid_pool_conv_streaming_step'


def _rmsnorm(x, g):
    xf = x.astype(jnp.float32)
    y = xf * lax.rsqrt(jnp.mean(xf * xf, axis=-1, keepdims=True) + EPS) * g.astype(jnp.float32)
    return y.astype(x.dtype)


def _depthwise_causal(ext, w):
    C = ext.shape[-1]
    return lax.conv_general_dilated(ext, w.astype(ext.dtype)[:, None, :], (1,), 'VALID',
                                    dimension_numbers=('NWC', 'WIO', 'NWC'),
                                    feature_group_count=C)


def _pool_mixer(xa, past, start, w_pool, s_pool):
    B, T, _ = xa.shape
    ext = jnp.concatenate([past.astype(xa.dtype), xa], axis=1)
    cs = jnp.pad(jnp.cumsum(ext.astype(jnp.float32), axis=1), ((0, 0), (1, 0), (0, 0)))
    pos = jnp.arange(T, dtype=jnp.float32) + start
    means = []
    for g, w in enumerate(POOL_WINDOWS):
        lo, hi = g * POOL_GROUP, (g + 1) * POOL_GROUP
        wsum = (cs[:, POOL_PAST + 1:POOL_PAST + 1 + T, lo:hi]
                - cs[:, POOL_PAST + 1 - w:POOL_PAST + 1 - w + T, lo:hi])
        cnt = jnp.minimum(pos + 1.0, float(w))[None, :, None]
        means.append(wsum / cnt)
    pooled = jnp.concatenate(means, axis=-1) - xa.astype(jnp.float32)
    pooled = pooled.reshape(B, T, len(POOL_WINDOWS), POOL_GROUP)
    mixed = jnp.einsum('btgc,gcd->btgd', pooled, w_pool.astype(jnp.float32)).reshape(B, T, POOL_WIDTH)
    y = (mixed * s_pool.astype(jnp.float32)).astype(xa.dtype)
    return y, ext[:, -POOL_PAST:]


def _conformer_conv(xb, past, w_dw, b_dw, ln_g, ln_b):
    a, g = jnp.split(xb, 2, axis=-1)
    u = a * jax.nn.sigmoid(g)
    ext = jnp.concatenate([past.astype(u.dtype), u], axis=1)
    z = (_depthwise_causal(ext, w_dw) + b_dw.astype(u.dtype)).astype(jnp.float32)
    mu = jnp.mean(z, axis=-1, keepdims=True)
    zc = z - mu
    var = jnp.mean(zc * zc, axis=-1, keepdims=True)
    z = zc * lax.rsqrt(var + EPS) * ln_g.astype(jnp.float32) + ln_b.astype(jnp.float32)
    return jax.nn.silu(z).astype(xb.dtype), ext[:, -(CONV_K - 1):]


def _short_conv(xc, past, w_sc):
    h, bg, cg = jnp.split(xc, 3, axis=-1)
    u = cg * h
    ext = jnp.concatenate([past.astype(u.dtype), u], axis=1)
    y = bg * _depthwise_causal(ext, w_sc)
    return y, ext[:, -(SCONV_K - 1):]


def _layer(x, c, pool_past, conv_past, sconv_past, start,
           w_ada, b_ada, g_pre_mix, g_post_mix, g_pre_ffn, g_post_ffn,
           w_in, w_pool, s_pool, w_dw, b_dw, ln_g, ln_b, w_sc, w_out,
           w_gate, w_up, w_down):
    mod = jax.nn.silu(c) @ w_ada + b_ada
    sh1, sc1, gt1, sh2, sc2, gt2 = [m[:, None, :] for m in jnp.split(mod, 6, axis=-1)]
    h = _rmsnorm(x, g_pre_mix) * (1 + sc1) + sh1
    proj = h @ w_in
    xa = proj[..., :POOL_WIDTH]
    xb = proj[..., POOL_WIDTH:POOL_WIDTH + 2 * CONV_WIDTH]
    xc = proj[..., POOL_WIDTH + 2 * CONV_WIDTH:]
    ya, pool_new = _pool_mixer(xa, pool_past, start, w_pool, s_pool)
    yb, conv_new = _conformer_conv(xb, conv_past, w_dw, b_dw, ln_g, ln_b)
    yc, sconv_new = _short_conv(xc, sconv_past, w_sc)
    mix = jnp.concatenate([ya, yb, yc], axis=-1) @ w_out
    x = x + gt1 * _rmsnorm(mix, g_post_mix)
    h = _rmsnorm(x, g_pre_ffn) * (1 + sc2) + sh2
    f = (jax.nn.silu(h @ w_gate) * (h @ w_up)) @ w_down
    x = x + gt2 * _rmsnorm(f, g_post_ffn)
    return x, pool_new, conv_new, sconv_new


def setup_inputs(seed: int = 0) -> dict:
    key = jax.random.key(seed)
    ks = jax.random.split(key, 25)
    f32 = jnp.float32

    def nrm(k, shape, s):
        return jax.random.normal(k, shape, f32) * s

    D = D_MODEL
    return {
        'x_prompt': nrm(ks[0], (BATCH, SEQ, D), 1.0),
        'x_sample': nrm(ks[1], (DEC_BATCH, DEC_SEQ, D), 1.0),
        'c_prompt': nrm(ks[2], (BATCH, D), 1.0),
        'c_sample': nrm(ks[3], (DEC_BATCH, D), 1.0),
        'state_pool': nrm(ks[4], (DEPTH, DEC_BATCH, POOL_PAST, POOL_WIDTH), 1.0),
        'state_conv': nrm(ks[5], (DEPTH, DEC_BATCH, CONV_K - 1, CONV_WIDTH), 0.5),
        'state_sconv': nrm(ks[6], (DEPTH, DEC_BATCH, SCONV_K - 1, SCONV_WIDTH), 1.0),
        'w_ada': nrm(ks[7], (DEPTH, D, 6 * D), 0.5 * D ** -0.5),
        'b_ada': nrm(ks[8], (DEPTH, 6 * D), 0.02),
        'g_pre_mix': 1.0 + nrm(ks[9], (DEPTH, D), 0.05),
        'g_post_mix': 1.0 + nrm(ks[10], (DEPTH, D), 0.05),
        'g_pre_ffn': 1.0 + nrm(ks[11], (DEPTH, D), 0.05),
        'g_post_ffn': 1.0 + nrm(ks[12], (DEPTH, D), 0.05),
        'w_in': nrm(ks[13], (DEPTH, D, IN_WIDTH), D ** -0.5),
        'w_pool': nrm(ks[14], (DEPTH, len(POOL_WINDOWS), POOL_GROUP, POOL_GROUP), POOL_GROUP ** -0.5),
        's_pool': 1.0 + nrm(ks[15], (DEPTH, POOL_WIDTH), 0.05),
        'w_dw': nrm(ks[16], (DEPTH, CONV_K, CONV_WIDTH), CONV_K ** -0.5),
        'b_dw': nrm(ks[17], (DEPTH, CONV_WIDTH), 0.02),
        'ln_g': 1.0 + nrm(ks[18], (DEPTH, CONV_WIDTH), 0.05),
        'ln_b': nrm(ks[19], (DEPTH, CONV_WIDTH), 0.02),
        'w_sc': nrm(ks[20], (DEPTH, SCONV_K, SCONV_WIDTH), SCONV_K ** -0.5),
        'w_out': nrm(ks[21], (DEPTH, MIX_WIDTH, D), MIX_WIDTH ** -0.5),
        'w_gate': nrm(ks[22], (DEPTH, D, D_FF), D ** -0.5),
        'w_up': nrm(ks[23], (DEPTH, D, D_FF), D ** -0.5),
        'w_down': nrm(ks[24], (DEPTH, D_FF, D), D_FF ** -0.5),
    }


def reference(x_prompt, x_sample, c_prompt, c_sample, state_pool, state_conv, state_sconv,
              w_ada, b_ada, g_pre_mix, g_post_mix, g_pre_ffn, g_post_ffn,
              w_in, w_pool, s_pool, w_dw, b_dw, ln_g, ln_b, w_sc, w_out,
              w_gate, w_up, w_down):
    xp, xs = x_prompt, x_sample
    bp = xp.shape[0]
    pool_p, conv_p, sconv_p = [], [], []
    pool_s, conv_s, sconv_s = [], [], []
    for l in range(DEPTH):
        lp = [w[l] for w in (w_ada, b_ada, g_pre_mix, g_post_mix, g_pre_ffn, g_post_ffn,
                             w_in, w_pool, s_pool, w_dw, b_dw, ln_g, ln_b, w_sc, w_out,
                             w_gate, w_up, w_down)]
        zp = jnp.zeros((bp, POOL_PAST, POOL_WIDTH), xp.dtype)
        zc = jnp.zeros((bp, CONV_K - 1, CONV_WIDTH), xp.dtype)
        zs = jnp.zeros((bp, SCONV_K - 1, SCONV_WIDTH), xp.dtype)
        xp, a, b, c = _layer(xp, c_prompt, zp, zc, zs, 0, *lp)
        pool_p.append(a); conv_p.append(b); sconv_p.append(c)
        xs, a, b, c = _layer(xs, c_sample, state_pool[l], state_conv[l], state_sconv[l], PAST_LEN, *lp)
        pool_s.append(a); conv_s.append(b); sconv_s.append(c)
    return (xp, xs,
            jnp.stack(pool_p), jnp.stack(conv_p), jnp.stack(sconv_p),
            jnp.stack(pool_s), jnp.stack(conv_s), jnp.stack(sconv_s))
```

```cpp
#include <hip/hip_runtime.h>
#include <hip/hip_cooperative_groups.h>
#include <cstdio>
#include <cstdint>
namespace cg = cooperative_groups;

#ifndef ONE_LAUNCH
#define ONE_LAUNCH 1
#endif

namespace pg8 {
#define PG8_LAS __attribute__((address_space(3)))
typedef unsigned short bf16_t;
typedef short bf16x8 __attribute__((ext_vector_type(8)));
typedef float f32x4 __attribute__((ext_vector_type(4)));
typedef unsigned u32x4 __attribute__((ext_vector_type(4)));
constexpr int BM = 256, BK = 64, HALF = 128, HTB = HALF * BK * 2, STAGE_BYTES = 8 * HTB, NXCD = 8, WGM = 8;

__host__ __device__ __forceinline__ int lds_byte(int r, int c) { const int st = (r >> 4) * 2 + (c >> 5), rr = r & 15, cc = c & 31, ob = rr * 64 + cc * 2; return st * 1024 + (ob ^ (((ob >> 9) & 1) << 5)); }
__host__ __device__ __forceinline__ void stage_rc(int b, int& R, int& C) { const int st = b / 1024, sb = b % 1024, swz = sb ^ (((sb >> 9) & 1) << 5); R = (st >> 1) * 16 + swz / 64; C = (st & 1) * 32 + (swz % 64) / 2; }
__host__ __device__ __forceinline__ int perm32(int rho) { const int n = rho >> 4, i = rho & 15; return 8 * (i >> 2) + 4 * n + (i & 3); }

struct Unit { int pm, pn; };
struct Gemm { const bf16_t* A; const bf16_t* Bt; int M, N, K; };

struct StaticOrder {
    int nM, nN, nwg, G, c;
    __host__ __device__ void init(int M, int N, int G_, int c_) { nM = M / BM; nN = N / BM; nwg = nM * nN; G = G_; c = c_; }
    __host__ __device__ bool next(int i, Unit& u) const {
        const long L = (long)i * G + c; if (L >= nwg) return false;
        int wgid = (int)L; { const int q = nwg / NXCD, r = nwg % NXCD, xcd = wgid % NXCD, off = wgid / NXCD; wgid = (xcd < r ? xcd * (q + 1) : r * (q + 1) + (xcd - r) * q) + off; }
        const int nig = WGM * nN, gid = wgid / nig, fm = gid * WGM, gsz = (nM - fm) < WGM ? (nM - fm) : WGM;
        u.pm = fm + ((wgid % nig) % gsz); u.pn = (wgid % nig) / gsz; return true;
    }
    __device__ __forceinline__ void a_ready(const Unit&) const {}
    __device__ __forceinline__ void done(const Unit&) const {}
};

__device__ __forceinline__ unsigned cvt_pk_bf16(float lo, float hi) { unsigned r; asm volatile("v_cvt_pk_bf16_f32 %0, %1, %2" : "=v"(r) : "v"(lo), "v"(hi)); return r; }

struct EpiBf16 {
    static constexpr bool PERM = true, AFTER_DRAIN = false;
    bf16_t* O; int ldc;
    __device__ __forceinline__ void operator()(const f32x4 (&acc)[2][2][4][2], const Unit& u, int wr, int wc, int fr, int fq) const {
        const int row0 = u.pm * BM + wr * 64 + fr; const int col0 = u.pn * BM + wc * 32 + 8 * fq;
#pragma unroll
        for (int ai = 0; ai < 2; ++ai)
#pragma unroll
            for (int m = 0; m < 4; ++m) { bf16_t* rowp = O + (size_t)(row0 + ai * HALF + m * 16) * ldc + col0;
#pragma unroll
                for (int bj = 0; bj < 2; ++bj) { const f32x4 v0 = acc[ai][bj][m][0], v1 = acc[ai][bj][m][1];
                    u32x4 w; w.x = cvt_pk_bf16(v0[0], v0[1]); w.y = cvt_pk_bf16(v0[2], v0[3]); w.z = cvt_pk_bf16(v1[0], v1[1]); w.w = cvt_pk_bf16(v1[2], v1[3]);
                    *(u32x4*)(rowp + bj * HALF) = w; } }
    }
};
__device__ __forceinline__ float silu_f(float g) { return g * __builtin_amdgcn_rcpf(1.0f + __builtin_amdgcn_exp2f(-1.44269504089f * g)); }
struct EpiSwiGLU {
    static constexpr bool PERM = true, AFTER_DRAIN = false;
    bf16_t* O; int ldc;
    __device__ __forceinline__ void operator()(const f32x4 (&acc)[2][2][4][2], const Unit& u, int wr, int wc, int fr, int fq) const {
        const int row0 = u.pm * BM + wr * 64 + fr; const int col0 = u.pn * HALF + wc * 32 + 8 * fq;
#pragma unroll
        for (int ai = 0; ai < 2; ++ai)
#pragma unroll
            for (int m = 0; m < 4; ++m) { bf16_t* rowp = O + (size_t)(row0 + ai * HALF + m * 16) * ldc + col0;
                const f32x4 g0 = acc[ai][0][m][0], g1 = acc[ai][0][m][1], u0 = acc[ai][1][m][0], u1 = acc[ai][1][m][1];
                u32x4 w;
                w.x = cvt_pk_bf16(silu_f(g0[0]) * u0[0], silu_f(g0[1]) * u0[1]); w.y = cvt_pk_bf16(silu_f(g0[2]) * u0[2], silu_f(g0[3]) * u0[3]);
                w.z = cvt_pk_bf16(silu_f(g1[0]) * u1[0], silu_f(g1[1]) * u1[1]); w.w = cvt_pk_bf16(silu_f(g1[2]) * u1[2], silu_f(g1[3]) * u1[3]);
                *(u32x4*)rowp = w; asm volatile("" ::: "memory"); }
    }
};

__device__ __forceinline__ float sigm_f(float g) { return __builtin_amdgcn_rcpf(1.0f + __builtin_amdgcn_exp2f(-1.44269504089f * g)); }
struct EpiInProj {
    static constexpr bool PERM = true, AFTER_DRAIN = false;
    bf16_t* O; int ldc;
    __device__ __forceinline__ void operator()(const f32x4 (&acc)[2][2][4][2], const Unit& u, int wr, int wc, int fr, int fq) const {
        const int row0 = u.pm * BM + wr * 64 + fr; const int cl = wc * 32 + 8 * fq; const int pn = u.pn;
        if (pn == 0 || pn >= 7) {
            const int col0 = (pn == 0 ? 0 : 1024 + (pn - 7) * 256) + cl;
#pragma unroll
            for (int ai = 0; ai < 2; ++ai)
#pragma unroll
                for (int m = 0; m < 4; ++m) { bf16_t* rowp = O + (size_t)(row0 + ai * HALF + m * 16) * ldc + col0;
#pragma unroll
                    for (int bj = 0; bj < 2; ++bj) { const f32x4 v0 = acc[ai][bj][m][0], v1 = acc[ai][bj][m][1];
                        u32x4 w; w.x = cvt_pk_bf16(v0[0], v0[1]); w.y = cvt_pk_bf16(v0[2], v0[3]); w.z = cvt_pk_bf16(v1[0], v1[1]); w.w = cvt_pk_bf16(v1[2], v1[3]);
                        if (bj == 0 || pn != 8) *(u32x4*)(rowp + bj * HALF) = w; } }
        } else {
            const bool glu = pn <= 3; const int col0 = (glu ? 256 + (pn - 1) * 128 : 640 + (pn - 4) * 128) + cl;
#pragma unroll
            for (int ai = 0; ai < 2; ++ai)
#pragma unroll
                for (int m = 0; m < 4; ++m) { bf16_t* rowp = O + (size_t)(row0 + ai * HALF + m * 16) * ldc + col0;
                    const f32x4 a0 = acc[ai][0][m][0], a1 = acc[ai][0][m][1]; f32x4 g0 = acc[ai][1][m][0], g1 = acc[ai][1][m][1];
                    if (glu) {
#pragma unroll
                        for (int e = 0; e < 4; ++e) { g0[e] = sigm_f(g0[e]); g1[e] = sigm_f(g1[e]); } }
                    u32x4 w; w.x = cvt_pk_bf16(a0[0] * g0[0], a0[1] * g0[1]); w.y = cvt_pk_bf16(a0[2] * g0[2], a0[3] * g0[3]);
                    w.z = cvt_pk_bf16(a1[0] * g1[0], a1[1] * g1[1]); w.w = cvt_pk_bf16(a1[2] * g1[2], a1[3] * g1[3]);
                    *(u32x4*)rowp = w; asm volatile("" ::: "memory"); }
        }
    }
};

template <class Epi, class Sched, bool ALIGN_EPI = false, bool SP2 = false>
__device__ __forceinline__ void gemm_phase(PG8_LAS unsigned char* lds, const Gemm g, const Sched& S, const Epi& E) {
    int tid_ = threadIdx.x; asm volatile("" : "+v"(tid_));
    const int tid = tid_, wid = __builtin_amdgcn_readfirstlane(tid >> 6), lane = tid & 63, wr = wid >> 2, wc = wid & 3, fr = lane & 15, fq = lane >> 4;
    const int K = g.K, nt = K / BK;
    unsigned voffA[2], voffB[2];
#pragma unroll
    for (int i = 0; i < 2; ++i) { int R, C; stage_rc(tid * 16 + i * 8192, R, C); const int Rb = Epi::PERM ? ((R & ~31) + perm32(R & 31)) : R;
        voffA[i] = (unsigned)(R * K + C) * 2u; voffB[i] = (unsigned)(Rb * K + C) * 2u; }
    const size_t kstep = (size_t)(BK * 2);
    const size_t hstep = (size_t)HALF * K * 2;
    const size_t tstep = 2 * hstep;
    const unsigned ldsw = (unsigned)wid * 1024u;
    const int aoff = lds_byte(wr * 64 + fr, fq * 8), boff = lds_byte(wc * 32 + fr, fq * 8);
#define PG8_SA(b, h) (((b) * 2 + (h)) * HTB)
#define PG8_SB(b, h) ((4 + (b) * 2 + (h)) * HTB)
#define PG8_STAGE(bufoff, gbase, voff) do { _Pragma("unroll") for (int _i = 0; _i < 2; ++_i) \
        __builtin_amdgcn_global_load_lds((const unsigned*)((const char*)(gbase) + (voff)[_i]), (PG8_LAS unsigned*)(lds + (bufoff) + ldsw + _i * 8192), 16, 0, 0); } while (0)
#define PG8_LDA(dst, b, h) do { _Pragma("unroll") for (int m = 0; m < 4; ++m) _Pragma("unroll") for (int k = 0; k < 2; ++k) dst[m][k] = *(const PG8_LAS bf16x8*)(lds + PG8_SA(b, h) + aoff + m * 2048 + k * 1024); } while (0)
#define PG8_LDB(dst, b, h) do { _Pragma("unroll") for (int n = 0; n < 2; ++n) _Pragma("unroll") for (int k = 0; k < 2; ++k) dst[n][k] = *(const PG8_LAS bf16x8*)(lds + PG8_SB(b, h) + boff + n * 2048 + k * 1024); } while (0)
#define PG8_MMA(ai, bj, At, Bt) do { __builtin_amdgcn_s_setprio(1); _Pragma("unroll") for (int m = 0; m < 4; ++m) _Pragma("unroll") for (int n = 0; n < 2; ++n) _Pragma("unroll") for (int k = 0; k < 2; ++k) \
        acc[ai][bj][m][n] = __builtin_amdgcn_mfma_f32_16x16x32_bf16(Bt[n][k], At[m][k], acc[ai][bj][m][n], 0, 0, 0); __builtin_amdgcn_s_setprio(0); } while (0)
#define PG8_WAIT_V(n) asm volatile("s_waitcnt vmcnt(" #n ")" ::: "memory")
#define PG8_WAIT_L(n) asm volatile("s_waitcnt lgkmcnt(" #n ")" ::: "memory")
#define PG8_BAR __builtin_amdgcn_s_barrier()
#define PG8_SCHED __builtin_amdgcn_sched_barrier(0)
    Unit cur, nxt; int ui = 0;
    if (!S.next(0, cur)) return;
    f32x4 acc[2][2][4][2];
#pragma unroll
    for (int a = 0; a < 2; ++a)
#pragma unroll
        for (int b = 0; b < 2; ++b)
#pragma unroll
            for (int m = 0; m < 4; ++m)
#pragma unroll
                for (int n = 0; n < 2; ++n) acc[a][b][m][n] = (f32x4){0.f, 0.f, 0.f, 0.f};
    bf16x8 At[4][2], B0[2][2], B1[2][2];
    const char* cA = (const char*)g.A + (size_t)cur.pm * tstep; const char* cB = (const char*)g.Bt + (size_t)cur.pn * tstep;
    S.a_ready(cur);
    if constexpr (SP2) {
        PG8_STAGE(PG8_SB(0, 0), cB, voffB); PG8_STAGE(PG8_SB(0, 1), cB + hstep, voffB); PG8_STAGE(PG8_SA(0, 0), cA, voffA); PG8_STAGE(PG8_SA(0, 1), cA + hstep, voffA);
        if (wr == 1) PG8_BAR;
        PG8_WAIT_V(2); PG8_BAR;
        PG8_STAGE(PG8_SB(1, 0), cB + kstep, voffB); PG8_STAGE(PG8_SA(1, 0), cA + kstep, voffA); PG8_STAGE(PG8_SB(1, 1), cB + hstep + kstep, voffB);
        PG8_WAIT_V(6); PG8_BAR;
    } else {
        PG8_STAGE(PG8_SB(0, 0), cB, voffB); PG8_STAGE(PG8_SA(0, 0), cA, voffA); PG8_STAGE(PG8_SB(0, 1), cB + hstep, voffB); PG8_STAGE(PG8_SA(0, 1), cA + hstep, voffA);
        if (wr == 1) PG8_BAR;
        PG8_WAIT_V(4); PG8_BAR;
        PG8_STAGE(PG8_SB(1, 0), cB + kstep, voffB); PG8_STAGE(PG8_SA(1, 0), cA + kstep, voffA); PG8_STAGE(PG8_SB(1, 1), cB + hstep + kstep, voffB);
        PG8_WAIT_V(6); PG8_BAR;
    }
    for (;;) {
        const bool has_next = S.next(ui + 1, nxt);
        const char* nA = has_next ? (const char*)g.A + (size_t)nxt.pm * tstep : cA; const char* nB = has_next ? (const char*)g.Bt + (size_t)nxt.pn * tstep : cB;
        for (int t = 0; t < nt; t += 2) {
            const bool last = (t == nt - 2);
            const char* a1 = cA + (size_t)(t + 1) * kstep;
            const char* a2 = last ? nA : cA + (size_t)(t + 2) * kstep; const char* b2 = last ? nB : cB + (size_t)(t + 2) * kstep;
            const char* a3 = a2 + kstep; const char* b3 = b2 + kstep;
            if (last && has_next) S.a_ready(nxt);
            if constexpr (SP2) {
            PG8_LDB(B0, 0, 0); PG8_LDB(B1, 0, 1); PG8_SCHED; PG8_LDA(At, 0, 0); PG8_STAGE(PG8_SA(1, 1), a1 + hstep, voffA);
            PG8_WAIT_V(8); PG8_WAIT_L(0); PG8_BAR; PG8_MMA(0, 0, At, B0); PG8_MMA(0, 1, At, B1); PG8_BAR; PG8_SCHED;
            PG8_LDA(At, 0, 1); PG8_STAGE(PG8_SB(0, 0), b2, voffB); PG8_STAGE(PG8_SB(0, 1), b2 + hstep, voffB); PG8_STAGE(PG8_SA(0, 0), a2, voffA);
            PG8_WAIT_V(8); PG8_WAIT_L(0); PG8_BAR; PG8_MMA(1, 0, At, B0); PG8_MMA(1, 1, At, B1); PG8_BAR; PG8_SCHED;
            PG8_LDB(B0, 1, 0); PG8_LDB(B1, 1, 1); PG8_SCHED; PG8_LDA(At, 1, 0); PG8_STAGE(PG8_SA(0, 1), a2 + hstep, voffA);
            PG8_WAIT_V(8); PG8_WAIT_L(0); PG8_BAR; PG8_MMA(0, 0, At, B0); PG8_MMA(0, 1, At, B1); PG8_BAR; PG8_SCHED;
            PG8_LDA(At, 1, 1); PG8_STAGE(PG8_SB(1, 0), b3, voffB); PG8_STAGE(PG8_SB(1, 1), b3 + hstep, voffB); PG8_STAGE(PG8_SA(1, 0), a3, voffA);
            PG8_WAIT_V(8); PG8_WAIT_L(0); PG8_BAR; PG8_MMA(1, 0, At, B0); PG8_MMA(1, 1, At, B1); PG8_BAR; PG8_SCHED;
            } else {
            PG8_LDB(B0, 0, 0); PG8_SCHED; PG8_LDA(At, 0, 0); PG8_STAGE(PG8_SA(1, 1), a1 + hstep, voffA);
            PG8_WAIT_L(8); PG8_BAR; PG8_WAIT_L(0); PG8_MMA(0, 0, At, B0); PG8_BAR; PG8_SCHED;
            PG8_LDB(B1, 0, 1); PG8_STAGE(PG8_SB(0, 0), b2, voffB);
            PG8_BAR; PG8_WAIT_L(0); PG8_MMA(0, 1, At, B1); PG8_BAR;
            PG8_LDA(At, 0, 1); PG8_STAGE(PG8_SA(0, 0), a2, voffA);
            PG8_BAR; PG8_WAIT_L(0); PG8_MMA(1, 0, At, B0); PG8_BAR; PG8_SCHED;
            PG8_STAGE(PG8_SB(0, 1), b2 + hstep, voffB);
            PG8_WAIT_V(6); PG8_BAR; PG8_MMA(1, 1, At, B1); PG8_BAR;
            PG8_LDB(B0, 1, 0); PG8_SCHED; PG8_LDA(At, 1, 0); PG8_STAGE(PG8_SA(0, 1), a2 + hstep, voffA);
            PG8_WAIT_L(8); PG8_BAR; PG8_WAIT_L(0); PG8_MMA(0, 0, At, B0); PG8_BAR; PG8_SCHED;
            PG8_LDB(B1, 1, 1); PG8_STAGE(PG8_SB(1, 0), b3, voffB);
            PG8_BAR; PG8_WAIT_L(0); PG8_MMA(0, 1, At, B1); PG8_BAR;
            PG8_LDA(At, 1, 1); PG8_STAGE(PG8_SA(1, 0), a3, voffA);
            PG8_BAR; PG8_WAIT_L(0); PG8_MMA(1, 0, At, B0); PG8_BAR; PG8_SCHED;
            PG8_STAGE(PG8_SB(1, 1), b3 + hstep, voffB);
            PG8_WAIT_V(6); PG8_BAR; PG8_MMA(1, 1, At, B1); PG8_BAR;
            }
        }
        if constexpr (ALIGN_EPI) { if (wr == 0) PG8_BAR; }
        if constexpr (!Epi::AFTER_DRAIN) { E(acc, cur, wr, wc, fr, fq); S.done(cur); }
        if (!has_next) break;
#pragma unroll
        for (int a = 0; a < 2; ++a)
#pragma unroll
            for (int b = 0; b < 2; ++b)
#pragma unroll
                for (int m = 0; m < 4; ++m)
#pragma unroll
                    for (int n = 0; n < 2; ++n) acc[a][b][m][n] = (f32x4){0.f, 0.f, 0.f, 0.f};
        cur = nxt; cA = nA; cB = nB; ++ui;
        if constexpr (ALIGN_EPI) { if (wr == 1) PG8_BAR; }
    }
    PG8_WAIT_V(0);
    if constexpr (!ALIGN_EPI) { if (wr == 0) PG8_BAR; }
    PG8_BAR;
#undef PG8_SA
#undef PG8_SB
#undef PG8_STAGE
#undef PG8_LDA
#undef PG8_LDB
#undef PG8_MMA
#undef PG8_WAIT_V
#undef PG8_WAIT_L
#undef PG8_BAR
#undef PG8_SCHED
}
}

#define LAS __attribute__((address_space(3)))
typedef unsigned short bf16;
typedef float f32x4 __attribute__((ext_vector_type(4)));
typedef float f32x2 __attribute__((ext_vector_type(2)));
typedef unsigned u32x4 __attribute__((ext_vector_type(4)));
typedef unsigned u32x2 __attribute__((ext_vector_type(2)));
typedef short bf16x8 __attribute__((ext_vector_type(8)));

constexpr int D = 1024, NB = 32, T_P = 2048, NDB = 8, T_S = 16, PASTLEN = 4096;
constexpr int MP = NB * T_P;
constexpr int MS = NDB * T_S;
constexpr int MR = MP + MS;
constexpr int MPAD = 257 * 256;
constexpr int INW = 2176, INWP = 2304, DFF = 2816, NGU = 2 * DFF;
constexpr int PW = 256, CW = 384, SW = 384, P2W = 1408;
constexpr float EPS = 1e-6f;
constexpr int NMODR = NB + NDB;
constexpr int KCH = 8;

constexpr size_t O_YP = 0, O_YS = (size_t)MP * D, O_POOLP = O_YS + (size_t)MS * D, O_CONVP = O_POOLP + 2 * 32 * 15 * 256,
                 O_SCP = O_CONVP + 2 * 32 * 30 * 384, O_POOLS = O_SCP + 2 * 32 * 2 * 384, O_CONVS = O_POOLS + 2 * 8 * 15 * 256, O_SCS = O_CONVS + 2 * 8 * 30 * 384;
constexpr size_t MiB = 1u << 20;
constexpr size_t WL_IN = 0, WL_OUT = (size_t)INWP * D * 2, WL_GU = WL_OUT + (size_t)D * D * 2, WL_DN = WL_GU + (size_t)NGU * D * 2, WL_SZ = WL_DN + (size_t)D * DFF * 2;
static_assert(WL_SZ == 23 * MiB, "weight block");
constexpr size_t WS_W = 2 * MiB, WS_PART = 48 * MiB, WS_H = 64 * MiB, WS_Y = 193 * MiB, WS_P = 322 * MiB, WS_CAT = 612 * MiB, WS_ACT = WS_P, WS_END = 741 * MiB;
static_assert(WS_PART + (size_t)2 * NMODR * 6144 * 4 <= WS_H && WS_H + (size_t)MPAD * D * 2 <= WS_Y && WS_Y + (size_t)MPAD * D * 2 <= WS_P && WS_P + (size_t)MPAD * INWP * 2 <= WS_CAT && WS_CAT + (size_t)MPAD * D * 2 <= WS_END && WS_ACT + (size_t)MPAD * DFF * 2 <= WS_END, "ws map");

constexpr int LDS_BYTES = 147456;

struct Args { const float* in[25]; float* out; unsigned char* ws; int ph_lo, ph_hi; };
enum { I_XP = 0, I_XS, I_CP, I_CS, I_SPOOL, I_SCONV, I_SSC, I_WADA, I_BADA, I_GPREMIX, I_GPOSTMIX, I_GPREFFN, I_GPOSTFFN, I_WIN, I_WPOOL, I_SPOOLW, I_WDW, I_BDW, I_LNG, I_LNB, I_WSC, I_WOUT, I_WGATE, I_WUP, I_WDOWN };

__device__ __forceinline__ unsigned f2bf(float f) { unsigned u = __builtin_bit_cast(unsigned, f); return (u + 0x7fffu + ((u >> 16) & 1u)) >> 16; }
__device__ __forceinline__ unsigned pk2(float lo, float hi) { unsigned r; asm("v_cvt_pk_bf16_f32 %0, %1, %2" : "=v"(r) : "v"(lo), "v"(hi)); return r; }
__device__ __forceinline__ float bflo(unsigned u) { return __builtin_bit_cast(float, u << 16); }
__device__ __forceinline__ float bfhi(unsigned u) { return __builtin_bit_cast(float, u & 0xffff0000u); }
__device__ __forceinline__ float wave_sum(float v) {
#pragma unroll
    for (int o = 1; o < 64; o <<= 1) v += __shfl_xor(v, o);
    return v;
}
__device__ __forceinline__ float sigmoid_f(float g) { return __builtin_amdgcn_rcpf(1.0f + __builtin_amdgcn_exp2f(-1.44269504089f * g)); }
__device__ __forceinline__ float silu_acc(float g) { return g / (1.0f + __expf(-g)); }

__device__ __forceinline__ void p0_transpose_item(const float* W, int N, bf16* WT, int Kp, int dest_row0, int k0, int n0, LAS float* scr, int lane) {
#pragma unroll 8
    for (int i = 0; i < 32; ++i) { const int kk = 2 * i + (lane >> 5); scr[kk * 33 + (lane & 31)] = W[(size_t)(k0 + kk) * N + n0 + (lane & 31)]; }
    asm volatile("s_waitcnt lgkmcnt(0)" ::: "memory");
    const int c = lane & 7;
#pragma unroll
    for (int j = 0; j < 4; ++j) { const int n = (lane >> 3) + 8 * j; const LAS float* s = scr + (8 * c) * 33 + n;
        u32x4 o; o.x = pk2(s[0 * 33], s[1 * 33]); o.y = pk2(s[2 * 33], s[3 * 33]); o.z = pk2(s[4 * 33], s[5 * 33]); o.w = pk2(s[6 * 33], s[7 * 33]);
        *(u32x4*)(WT + (size_t)(dest_row0 + n) * Kp + k0 + 8 * c) = o; }
    asm volatile("s_waitcnt lgkmcnt(0)" ::: "memory");
}

__device__ __forceinline__ void p0_prologue(const Args& a, LAS unsigned char* lds) {
    int tid = threadIdx.x; asm volatile("" : "+v"(tid));
    const int lane = tid & 63, wave = __builtin_amdgcn_readfirstlane(tid >> 6);
    LAS float* scr = (LAS float*)(lds + wave * 16384);
    const int gw = blockIdx.x * 8 + wave, NGW = gridDim.x * 8;
    constexpr int NMODWG = 120;
    const bool split = gridDim.x >= 2 * NMODWG;
    float* modp = (float*)(a.ws + WS_PART);
    if (!split || blockIdx.x < NMODWG) {
        LAS float* sc = (LAS float*)lds;
        for (int wi = blockIdx.x; wi < NMODWG; wi += gridDim.x) {
            const int it = wi * 8 + wave, rg = it % 5, cb = (it / 5) % 96, l = it / 480;
            float acc[8];
#pragma unroll
            for (int r = 0; r < 8; ++r) acc[r] = 0.f;
            const float* wp = a.in[I_WADA] + (size_t)l * D * 6144 + cb * 64;
#pragma unroll 1
            for (int half = 0; half < 2; ++half) {
                __syncthreads();
#pragma unroll 8
                for (int r = 0; r < NMODR; ++r) { const float cv = (r < NB) ? a.in[I_CP][r * D + half * 512 + tid] : a.in[I_CS][(r - NB) * D + half * 512 + tid]; sc[r * 512 + tid] = silu_acc(cv); }
                __syncthreads();
                const LAS float* sp = sc + rg * 8 * 512;
#pragma unroll 2
                for (int k0 = 0; k0 < 512; k0 += 8) {
                    const float* wq = wp + (size_t)(half * 512 + k0) * 6144 + lane;
                    const float w0 = wq[0], w1 = wq[6144], w2 = wq[2 * 6144], w3 = wq[3 * 6144], w4 = wq[4 * 6144], w5 = wq[5 * 6144], w6 = wq[6 * 6144], w7 = wq[7 * 6144];
#pragma unroll
                    for (int r = 0; r < 8; ++r) { const f32x4 s0 = *(const LAS f32x4*)(sp + r * 512 + k0), s1 = *(const LAS f32x4*)(sp + r * 512 + k0 + 4);
                        acc[r] += ((s0[0] * w0 + s0[1] * w1) + (s0[2] * w2 + s0[3] * w3)) + ((s1[0] * w4 + s1[1] * w5) + (s1[2] * w6 + s1[3] * w7)); }
                }
            }
            const float bias = a.in[I_BADA][l * 6144 + cb * 64 + lane];
            float* mo = modp + ((size_t)l * NMODR + rg * 8) * 6144 + cb * 64 + lane;
#pragma unroll
            for (int r = 0; r < 8; ++r) mo[(size_t)r * 6144] = acc[r] + bias;
        }
        __syncthreads();
    }
    constexpr int I_IN = 16 * (INW / 32), I_OUT = 16 * (D / 32), I_G = 16 * (DFF / 32), I_DN = (DFF / 64) * (D / 32), I_PADZ = 128;
    constexpr int PER_L = I_IN + I_OUT + 2 * I_G + I_DN + I_PADZ;
    const int tw0 = split ? NMODWG * 8 : 0;
    for (int it0 = gw - tw0; it0 < 2 * PER_L; it0 += NGW - tw0) {
        if (it0 < 0) break;
        const int l = it0 / PER_L; int r = it0 % PER_L;
        bf16* wl = (bf16*)(a.ws + WS_W + (size_t)l * WL_SZ);
        if (r < I_IN) { const int nblk = INW / 32, kb = r / nblk, nb = r % nblk, n0 = nb * 32; int dr;
            if (n0 < 256) dr = n0;
            else if (n0 < 640) { const int j = n0 - 256; dr = 256 * (1 + (j >> 7)) + (j & 127); }
            else if (n0 < 1024) { const int j = n0 - 640; dr = 256 * (1 + (j >> 7)) + 128 + (j & 127); }
            else if (n0 < 1408) { const int j = n0 - 1024; dr = 256 * (4 + (j >> 7)) + (j & 127); }
            else if (n0 < 1792) { dr = 1792 + (n0 - 1408); }
            else { const int j = n0 - 1792; dr = 256 * (4 + (j >> 7)) + 128 + (j & 127); }
            p0_transpose_item(a.in[I_WIN] + (size_t)l * D * INW, INW, (bf16*)((char*)wl + WL_IN), D, dr, kb * 64, n0, scr, lane); continue; } r -= I_IN;
        if (r < I_OUT) { const int nblk = D / 32, kb = r / nblk, nb = r % nblk; p0_transpose_item(a.in[I_WOUT] + (size_t)l * D * D, D, (bf16*)((char*)wl + WL_OUT), D, nb * 32, kb * 64, nb * 32, scr, lane); continue; } r -= I_OUT;
        if (r < 2 * I_G) { const int up = r >= I_G; if (up) r -= I_G; const int nblk = DFF / 32, kb = r / nblk, nb = r % nblk, n0 = nb * 32;
            p0_transpose_item(a.in[up ? I_WUP : I_WGATE] + (size_t)l * D * DFF, DFF, (bf16*)((char*)wl + WL_GU), D, (n0 >> 7) * 256 + up * 128 + (n0 & 127), kb * 64, n0, scr, lane); continue; } r -= 2 * I_G;
        if (r < I_DN) { const int nblk = D / 32, kb = r / nblk, nb = r % nblk; p0_transpose_item(a.in[I_WDOWN] + (size_t)l * DFF * D, D, (bf16*)((char*)wl + WL_DN), DFF, nb * 32, kb * 64, nb * 32, scr, lane); continue; } r -= I_DN;
        { u32x4* z = (u32x4*)((char*)wl + WL_IN + (size_t)(INW + r) * D * 2); z[lane] = (u32x4){0u, 0u, 0u, 0u}; z[lane + 64] = (u32x4){0u, 0u, 0u, 0u}; }
    }
}

__device__ __forceinline__ void load_mod(const Args& a, int l, int r, int which, int lane, f32x4 (&v)[4]) {
    const float* modp = (const float*)(a.ws + WS_PART) + ((size_t)l * NMODR + r) * 6144 + which * 1024;
#pragma unroll
    for (int j = 0; j < 4; ++j) v[j] = *(const f32x4*)(modp + 256 * j + 4 * lane);
}
__device__ __forceinline__ void load_vec(const float* g, int lane, f32x4 (&v)[4]) {
#pragma unroll
    for (int j = 0; j < 4; ++j) v[j] = *(const f32x4*)(g + 256 * j + 4 * lane);
}
template <int MODE>
__device__ __forceinline__ void rows_do(const float* xin, float* xout, const bf16* Y, bf16* H, int nrows, const f32x4 (&GB)[4], const f32x4 (&GA)[4], const f32x4 (&SH)[4], int lane) {
    f32x4 xc[4], xn[4]; u32x2 yc[4], yn[4];
#pragma unroll
    for (int j = 0; j < 4; ++j) { xc[j] = *(const f32x4*)(xin + 256 * j + 4 * lane); if (MODE != 0) yc[j] = *(const u32x2*)(Y + 256 * j + 4 * lane); }
    for (int i = 0; i < nrows; ++i) {
        const int ip = (i + 1 < nrows) ? i + 1 : i;
#pragma unroll
        for (int j = 0; j < 4; ++j) { xn[j] = *(const f32x4*)(xin + (size_t)ip * D + 256 * j + 4 * lane); if (MODE != 0) yn[j] = *(const u32x2*)(Y + (size_t)ip * D + 256 * j + 4 * lane); }
        f32x4 x[4];
#pragma unroll
        for (int j = 0; j < 4; ++j) x[j] = xc[j];
        if (MODE != 0) {
            f32x4 y[4]; float ss = 0.f;
#pragma unroll
            for (int j = 0; j < 4; ++j) { y[j] = (f32x4){bflo(yc[j].x), bfhi(yc[j].x), bflo(yc[j].y), bfhi(yc[j].y)}; ss += (y[j][0] * y[j][0] + y[j][1] * y[j][1]) + (y[j][2] * y[j][2] + y[j][3] * y[j][3]); }
            const float rs = 1.0f / sqrtf(wave_sum(ss) * (1.0f / D) + EPS);
#pragma unroll
            for (int j = 0; j < 4; ++j) { x[j] += GB[j] * (y[j] * rs); *(f32x4*)(xout + (size_t)i * D + 256 * j + 4 * lane) = x[j]; }
        }
        if (MODE != 2) {
            float ss = 0.f;
#pragma unroll
            for (int j = 0; j < 4; ++j) ss += (x[j][0] * x[j][0] + x[j][1] * x[j][1]) + (x[j][2] * x[j][2] + x[j][3] * x[j][3]);
            const float rs = 1.0f / sqrtf(wave_sum(ss) * (1.0f / D) + EPS);
#pragma unroll
            for (int j = 0; j < 4; ++j) { const f32x4 h = (x[j] * rs) * GA[j] + SH[j]; u32x2 o; o.x = pk2(h[0], h[1]); o.y = pk2(h[2], h[3]); *(u32x2*)(H + (size_t)i * D + 256 * j + 4 * lane) = o; }
        }
#pragma unroll
        for (int j = 0; j < 4; ++j) { xc[j] = xn[j]; if (MODE != 0) yc[j] = yn[j]; }
    }
}
template <int MODE>
__device__ __forceinline__ void row_phase(const Args& a, bool x_from_input, int lb, int wgt, const float* gpost, int lh, int wsh, const float* gpre) {
    int tid = threadIdx.x; asm volatile("" : "+v"(tid));
    const int lane = tid & 63, wave = __builtin_amdgcn_readfirstlane(tid >> 6);
    const int gw = blockIdx.x * 8 + wave, NGW = gridDim.x * 8;
    const bf16* Y = (const bf16*)(a.ws + WS_Y); bf16* H = (bf16*)(a.ws + WS_H);
    const int nchunk = MP / 32 + MS;
    for (int ch = gw; ch < nchunk; ch += NGW) {
        int row0, nrows, r;
        if (ch < MP / 32) { row0 = ch * 32; nrows = 32; r = row0 / T_P; } else { const int j = ch - MP / 32; row0 = MP + j; nrows = 1; r = NB + j / T_S; }
        f32x4 GB[4], GA[4], SH[4];
        if (MODE != 0) { f32x4 gt[4], gp[4]; load_mod(a, lb, r, wgt, lane, gt); load_vec(gpost, lane, gp);
#pragma unroll
            for (int j = 0; j < 4; ++j) GB[j] = gt[j] * gp[j]; }
        if (MODE != 2) { f32x4 sc[4], gp[4]; load_mod(a, lh, r, wsh + 1, lane, sc); load_mod(a, lh, r, wsh, lane, SH); load_vec(gpre, lane, gp);
#pragma unroll
            for (int j = 0; j < 4; ++j) GA[j] = gp[j] * (1.0f + sc[j]); }
        const float* xin = x_from_input ? (row0 < MP ? a.in[I_XP] + (size_t)row0 * D : a.in[I_XS] + (size_t)(row0 - MP) * D) : a.out + (size_t)row0 * D;
        rows_do<MODE>(xin, a.out + (size_t)row0 * D, Y + (size_t)row0 * D, H + (size_t)row0 * D, nrows, GB, GA, SH, lane);
    }
}

template <int N, int SZ>
__device__ __forceinline__ void tr_reduce_step(float (&v)[SZ], int lane) {
    constexpr int Hh = N / 2;
    const bool up = (lane & Hh) != 0;
#pragma unroll
    for (int i = 0; i < Hh; ++i) { const float send = up ? v[i] : v[i + Hh]; const float keep = up ? v[i + Hh] : v[i]; v[i] = keep + __shfl_xor(send, Hh); }
}
template <int R, int N> struct ConvLoop {
    static __device__ __forceinline__ void run(f32x2 (&z)[32], const f32x2 (&w)[31], const LAS unsigned* up) {
        const unsigned v = up[R * 192]; const f32x2 uv = {bflo(v), bfhi(v)};
#pragma unroll
        for (int i = (R - 30 > 0 ? R - 30 : 0); i <= (R < 31 ? R : 31); ++i) z[i] += w[R - i] * uv;
        if ((R & 7) == 7) asm volatile("" ::: "memory");
        ConvLoop<R + 1, N>::run(z, w, up);
    }
};
template <int N> struct ConvLoop<N, N> { static __device__ __forceinline__ void run(f32x2 (&)[32], const f32x2 (&)[31], const LAS unsigned*) {} };

constexpr int MIX_UC = 0, MIX_XA = 73728, XA_PITCH = 528, MIX_ST = MIX_XA + 79 * XA_PITCH;
static_assert(MIX_ST + 6 * 64 * 4 <= 131072, "mixer LDS");

__device__ __forceinline__ void mixer_phase(const Args& a, int l, LAS unsigned char* lds, int mode = 7) {
    const bf16* P = (const bf16*)(a.ws + WS_P); bf16* CAT = (bf16*)(a.ws + WS_CAT);
    LAS bf16* Uc = (LAS bf16*)(lds + MIX_UC);
    LAS unsigned char* XaB = lds + MIX_XA;
    LAS float* ST = (LAS float*)(lds + MIX_ST);
    const int NU = MP / 64 + NDB;
    for (int u = blockIdx.x; u < NU; u += gridDim.x) {
        int tid = threadIdx.x; asm volatile("" : "+v"(tid));
        const int lane = tid & 63, wave = __builtin_amdgcn_readfirstlane(tid >> 6);
        int rowbase, T, t0, start, b; bool smp;
        if (u < MP / 64) { b = u / 32; t0 = (u % 32) * 64; T = T_P; start = 0; rowbase = b * T_P; smp = false; }
        else { b = u - MP / 64; t0 = 0; T = T_S; start = PASTLEN; rowbase = MP + b * T_S; smp = true; }
        const int nbat = smp ? NDB : NB;
        float* pool_out = a.out + (smp ? O_POOLS : O_POOLP) + ((size_t)l * nbat + b) * 15 * 256;
        float* conv_out = a.out + (smp ? O_CONVS : O_CONVP) + ((size_t)l * nbat + b) * 30 * 384;
        float* sc_out = a.out + (smp ? O_SCS : O_SCP) + ((size_t)l * nbat + b) * 2 * 384;
        const float* st_pool = a.in[I_SPOOL] + ((size_t)l * NDB + b) * 15 * 256;
        const float* st_conv = a.in[I_SCONV] + ((size_t)l * NDB + b) * 30 * 384;
        const float* st_sc = a.in[I_SSC] + ((size_t)l * NDB + b) * 2 * 384;
        const int seg = tid / 48, oc = tid - seg * 48, cc = oc * 8;
        u32x4 va[12], vb[5];
        if (tid < 384) {
#pragma unroll
            for (int q = 0; q < 12; ++q) { const int r = seg + 8 * q, t = t0 - 30 + r;
                va[q] = (u32x4){0u, 0u, 0u, 0u};
                if (r < 94 && t >= 0 && t < T) va[q] = *(const u32x4*)(P + (size_t)(rowbase + t) * P2W + 256 + cc); }
        }
#pragma unroll
        for (int q = 0; q < 5; ++q) { const int i = tid + 512 * q, r = i >> 5, o = i & 31, t = t0 - 15 + r;
            vb[q] = (u32x4){0u, 0u, 0u, 0u};
            if (i < 79 * 32 && t >= 0 && t < T) vb[q] = *(const u32x4*)(P + (size_t)(rowbase + t) * P2W + o * 8); }
        if (smp) {
            if (tid < 384) {
#pragma unroll
                for (int q = 0; q < 4; ++q) { const int r = seg + 8 * q, t = r - 30;
                    if (t < 0) { const f32x4 p0 = *(const f32x4*)(st_conv + (30 + t) * 384 + cc), p1 = *(const f32x4*)(st_conv + (30 + t) * 384 + cc + 4);
                        va[q].x = pk2(p0[0], p0[1]); va[q].y = pk2(p0[2], p0[3]); va[q].z = pk2(p1[0], p1[1]); va[q].w = pk2(p1[2], p1[3]); } }
            }
#pragma unroll
            for (int q = 0; q < 1; ++q) { const int i = tid, r = i >> 5, o = i & 31, t = r - 15, c = o * 8;
                if (t < 0) { const f32x4 p0 = *(const f32x4*)(st_pool + (15 + t) * 256 + c), p1 = *(const f32x4*)(st_pool + (15 + t) * 256 + c + 4);
                    vb[q].x = pk2(p0[0], p0[1]); vb[q].y = pk2(p0[2], p0[3]); vb[q].z = pk2(p1[0], p1[1]); vb[q].w = pk2(p1[2], p1[3]); } }
        }
        if (tid < 384) {
#pragma unroll
            for (int q = 0; q < 12; ++q) { const int r = seg + 8 * q; if (r < 94) *(LAS u32x4*)(Uc + r * 384 + cc) = va[q]; }
        }
#pragma unroll
        for (int q = 0; q < 5; ++q) { const int i = tid + 512 * q, r = i >> 5, o = i & 31; if (i < 79 * 32) *(LAS u32x4*)(XaB + r * XA_PITCH + o * 16) = vb[q]; }
        if (t0 + 64 >= T) {
            for (int i = tid; i < 30 * 48; i += 512) { const int sr = i / 48, o = i - sr * 48, t = T - 30 + sr, c = o * 8; float* d = conv_out + sr * 384 + c;
                if (t >= 0) { const u32x4 w = *(const u32x4*)(P + (size_t)(rowbase + t) * P2W + 256 + c);
                    *(f32x4*)d = (f32x4){bflo(w.x), bfhi(w.x), bflo(w.y), bfhi(w.y)}; *(f32x4*)(d + 4) = (f32x4){bflo(w.z), bfhi(w.z), bflo(w.w), bfhi(w.w)}; }
                else { *(f32x4*)d = *(const f32x4*)(st_conv + (30 + t) * 384 + c); *(f32x4*)(d + 4) = *(const f32x4*)(st_conv + (30 + t) * 384 + c + 4); } }
            for (int i = tid; i < 15 * 32; i += 512) { const int sr = i >> 5, o = i & 31, t = T - 15 + sr, c = o * 8; float* d = pool_out + sr * 256 + c;
                if (t >= 0) { const u32x4 w = *(const u32x4*)(P + (size_t)(rowbase + t) * P2W + c);
                    *(f32x4*)d = (f32x4){bflo(w.x), bfhi(w.x), bflo(w.y), bfhi(w.y)}; *(f32x4*)(d + 4) = (f32x4){bflo(w.z), bfhi(w.z), bflo(w.w), bfhi(w.w)}; }
                else { *(f32x4*)d = *(const f32x4*)(st_pool + (15 + t) * 256 + c); *(f32x4*)(d + 4) = *(const f32x4*)(st_pool + (15 + t) * 256 + c + 4); } }
            for (int i = tid; i < 2 * 48; i += 512) { const int sr = i / 48, o = i - sr * 48, t = T - 2 + sr, c = o * 8; float* d = sc_out + sr * 384 + c;
                const u32x4 w = *(const u32x4*)(P + (size_t)(rowbase + t) * P2W + 640 + c);
                *(f32x4*)d = (f32x4){bflo(w.x), bfhi(w.x), bflo(w.y), bfhi(w.y)}; *(f32x4*)(d + 4) = (f32x4){bflo(w.z), bfhi(w.z), bflo(w.w), bfhi(w.w)}; }
        }
        if (tid < 384) {
            float w0[8], w1[8], w2[8];
            { const float* ws = a.in[I_WSC] + (size_t)l * 3 * 384 + cc;
#pragma unroll
              for (int e = 0; e < 8; ++e) { w0[e] = ws[e]; w1[e] = ws[384 + e]; w2[e] = ws[768 + e]; } }
            float up2[8], up1[8];
#pragma unroll
            for (int ps = 0; ps < 2; ++ps) {
                u32x4 vu[6], vg[4];
#pragma unroll
                for (int d = (ps ? 2 : 0); d < 6; ++d) { const int t = t0 + 8 * seg + 4 * ps + d - 2; vu[d] = (u32x4){0u, 0u, 0u, 0u};
                    if (t >= 0 && t < T) vu[d] = *(const u32x4*)(P + (size_t)(rowbase + t) * P2W + 640 + cc); }
#pragma unroll
                for (int d = 0; d < 4; ++d) { const int t = t0 + 8 * seg + 4 * ps + d; vg[d] = (u32x4){0u, 0u, 0u, 0u};
                    if (t < T) vg[d] = *(const u32x4*)(P + (size_t)(rowbase + t) * P2W + 1024 + cc); }
#pragma unroll
                for (int d = (ps ? 2 : 0); d < 6; ++d) {
                    const int t = t0 + 8 * seg + 4 * ps + d - 2;
                    float uc[8];
#pragma unroll
                    for (int e = 0; e < 4; ++e) { uc[2 * e] = bflo(vu[d][e]); uc[2 * e + 1] = bfhi(vu[d][e]); }
                    if (ps == 0 && d < 2 && smp && t < 0) { const f32x4 p0 = *(const f32x4*)(st_sc + (2 + t) * 384 + cc), p1 = *(const f32x4*)(st_sc + (2 + t) * 384 + cc + 4);
#pragma unroll
                        for (int e = 0; e < 4; ++e) { uc[e] = p0[e]; uc[4 + e] = p1[e]; } }
                    if (d >= 2) {
                        const u32x4 bv = vg[d - 2];
                        float y[8];
#pragma unroll
                        for (int e = 0; e < 4; ++e) {
                            y[2 * e] = bflo(bv[e]) * (w0[2 * e] * up2[2 * e] + w1[2 * e] * up1[2 * e] + w2[2 * e] * uc[2 * e]);
                            y[2 * e + 1] = bfhi(bv[e]) * (w0[2 * e + 1] * up2[2 * e + 1] + w1[2 * e + 1] * up1[2 * e + 1] + w2[2 * e + 1] * uc[2 * e + 1]); }
                        if (t < T) {
                            u32x4 w; w.x = pk2(y[0], y[1]); w.y = pk2(y[2], y[3]); w.z = pk2(y[4], y[5]); w.w = pk2(y[6], y[7]);
                            *(u32x4*)(CAT + (size_t)(rowbase + t) * D + 640 + cc) = w;
                        }
                    }
#pragma unroll
                    for (int e = 0; e < 8; ++e) { if (ps == 1 || d >= 1) up2[e] = up1[e]; up1[e] = uc[e]; }
                }
            }
        }
        __syncthreads();
        f32x2 z[32];
        int tid2 = tid; asm volatile("" : "+v"(tid2));
        const int half = (tid2 >= 192) ? 1 : 0, p = tid2 - 192 * half;
        if (wave < 6 && (mode & 2)) {
            f32x2 w[31];
            const float* wd = a.in[I_WDW] + (size_t)l * 31 * 384 + 2 * p;
#pragma unroll
            for (int j = 0; j < 31; ++j) w[j] = *(const f32x2*)(wd + j * 384);
            const f32x2 bb = *(const f32x2*)(a.in[I_BDW] + l * 384 + 2 * p);
#pragma unroll
            for (int i = 0; i < 32; ++i) z[i] = bb;
            const LAS unsigned* up = (const LAS unsigned*)Uc + (32 * half) * 192 + p;
            ConvLoop<0, 62>::run(z, w, up);
            float sv[32];
            { const bool up = (lane & 32) != 0;
#pragma unroll
              for (int i = 0; i < 32; ++i) { const f32x2 zl = z[i >> 1], zh = z[16 + (i >> 1)];
                  const float va_ = (i & 1) ? (zl[0] * zl[0] + zl[1] * zl[1]) : (zl[0] + zl[1]), vb_ = (i & 1) ? (zh[0] * zh[0] + zh[1] * zh[1]) : (zh[0] + zh[1]);
                  const float send = up ? va_ : vb_, keep = up ? vb_ : va_; sv[i] = keep + __shfl_xor(send, 32);
                  if ((i & 7) == 7) asm volatile("" ::: "memory"); } }
            tr_reduce_step<32>(sv, lane); tr_reduce_step<16>(sv, lane); tr_reduce_step<8>(sv, lane); tr_reduce_step<4>(sv, lane); tr_reduce_step<2>(sv, lane);
            ST[wave * 64 + lane] = sv[0];
        } else if (mode & 2) {
            const int fr = tid2 & 15, fq = (tid2 & 63) >> 4;
#pragma unroll 1
            for (int gi = 0; gi < 2; ++gi) {
                const int g = (wave == 6) ? (gi ? 3 : 0) : (gi ? 2 : 1), win = 2 << g;
                bf16x8 Wf[4][2];
#pragma unroll
                for (int nt = 0; nt < 4; ++nt)
#pragma unroll
                    for (int kk = 0; kk < 2; ++kk) { const float* wp = a.in[I_WPOOL] + (((size_t)l * 4 + g) * 64 + 32 * kk + 8 * fq) * 64 + 16 * nt + fr;
                        u32x4 q; q.x = pk2(wp[0], wp[64]); q.y = pk2(wp[128], wp[192]); q.z = pk2(wp[256], wp[320]); q.w = pk2(wp[384], wp[448]);
                        Wf[nt][kk] = __builtin_bit_cast(bf16x8, q); }
                f32x4 spv[4];
#pragma unroll
                for (int nt = 0; nt < 4; ++nt) spv[nt] = *(const f32x4*)(a.in[I_SPOOLW] + l * 256 + 64 * g + 16 * nt + 4 * fq);
#pragma unroll 1
                for (int mt = 0; mt < 4; ++mt) {
                    const int i = 16 * mt + fr, r = i + 15;
                    const int pos = t0 + i + start; const float cnt = (float)((pos + 1 < win) ? pos + 1 : win); const float inv = 1.0f / cnt;
                    bf16x8 Af[2];
#pragma unroll
                    for (int kk = 0; kk < 2; ++kk) {
                        const LAS unsigned char* base = XaB + r * XA_PITCH + (64 * g + 32 * kk + 8 * fq) * 2;
                        float s[8];
#pragma unroll
                        for (int e = 0; e < 8; ++e) s[e] = 0.f;
                        for (int d = 0; d < win; ++d) { const u32x4 v = *(const LAS u32x4*)(base - d * XA_PITCH);
#pragma unroll
                            for (int e = 0; e < 4; ++e) { s[2 * e] += bflo(v[e]); s[2 * e + 1] += bfhi(v[e]); } }
                        const u32x4 cv = *(const LAS u32x4*)base;
                        u32x4 q;
#pragma unroll
                        for (int e = 0; e < 4; ++e) q[e] = pk2(s[2 * e] * inv - bflo(cv[e]), s[2 * e + 1] * inv - bfhi(cv[e]));
                        Af[kk] = __builtin_bit_cast(bf16x8, q);
                    }
                    const bool valid = (t0 + i) < T;
#pragma unroll
                    for (int nt = 0; nt < 4; ++nt) {
                        f32x4 acc = {0.f, 0.f, 0.f, 0.f};
                        acc = __builtin_amdgcn_mfma_f32_16x16x32_bf16(Wf[nt][0], Af[0], acc, 0, 0, 0);
                        acc = __builtin_amdgcn_mfma_f32_16x16x32_bf16(Wf[nt][1], Af[1], acc, 0, 0, 0);
                        const f32x4 sp = spv[nt];
                        u32x2 o; o.x = pk2(acc[0] * sp[0], acc[1] * sp[1]); o.y = pk2(acc[2] * sp[2], acc[3] * sp[3]);
                        if (valid) *(u32x2*)(CAT + (size_t)(rowbase + t0 + i) * D + 64 * g + 16 * nt + 4 * fq) = o;
                    }
                }
            }
        }
        __syncthreads();
        if (wave < 6 && (mode & 4)) {
            const f32x2 lg = *(const f32x2*)(a.in[I_LNG] + l * 384 + 2 * p), lb = *(const f32x2*)(a.in[I_LNB] + l * 384 + 2 * p);
            const float tot = ST[(3 * half) * 64 + lane] + ST[(3 * half + 1) * 64 + lane] + ST[(3 * half + 2) * 64 + lane];
            const float oth = __shfl_xor(tot, 1);
            const float s1 = (lane & 1) ? oth : tot, s2 = (lane & 1) ? tot : oth;
            const float mu_l = s1 * (1.0f / 384.0f); float var_l = s2 * (1.0f / 384.0f) - mu_l * mu_l; var_l = var_l > 0.f ? var_l : 0.f;
            const float rstd_l = __builtin_amdgcn_rsqf(var_l + EPS);
            const int trow = t0 + 32 * half;
            bf16* crow = CAT + (size_t)(rowbase + trow) * D + 256 + 2 * p;
#pragma unroll
            for (int i = 0; i < 32; ++i) {
                const float mu = __builtin_bit_cast(float, __builtin_amdgcn_readlane(__builtin_bit_cast(int, mu_l), 2 * i));
                const float rstd = __builtin_bit_cast(float, __builtin_amdgcn_readlane(__builtin_bit_cast(int, rstd_l), 2 * i));
                const f32x2 sc2 = lg * rstd, of2 = lb - sc2 * mu;
                const f32x2 y = z[i] * sc2 + of2;
                if (trow + i < T) *(unsigned*)(crow + (size_t)i * D) = pk2(y[0] * sigmoid_f(y[0]), y[1] * sigmoid_f(y[1]));
            }
        }
        __syncthreads();
    }
}


__device__ __forceinline__ void sample_gemm(int kind, const bf16* A, const bf16* Bt, int NT, int K, bf16* O, int ldc) {
    int tid = threadIdx.x; asm volatile("" : "+v"(tid));
    const int lane = tid & 63, wave = __builtin_amdgcn_readfirstlane(tid >> 6), fr = lane & 15, fq = lane >> 4;
    const int gw = blockIdx.x * 8 + wave, NGW = gridDim.x * 8, ntask = NT * 64;
    for (int task = gw; task < ntask; task += NGW) {
        const int mt = task & 7, sb = (task >> 3) & 7, pn = task >> 6;
        const bf16* ap = A + (size_t)(mt * 16 + fr) * K + 8 * fq;
        const bf16* bp0 = Bt + (size_t)(256 * pn + 16 * sb + fr) * K + 8 * fq;
        const bf16* bp1 = bp0 + (size_t)128 * K;
        f32x4 acc0 = {0.f, 0.f, 0.f, 0.f}, acc1 = {0.f, 0.f, 0.f, 0.f};
#pragma unroll 1
        for (int k0 = 0; k0 < K; k0 += 256) {
            bf16x8 af[8], b0[8], b1[8];
#pragma unroll
            for (int j = 0; j < 8; ++j) { af[j] = *(const bf16x8*)(ap + k0 + 32 * j); b0[j] = *(const bf16x8*)(bp0 + k0 + 32 * j); b1[j] = *(const bf16x8*)(bp1 + k0 + 32 * j); }
#pragma unroll
            for (int j = 0; j < 8; ++j) { acc0 = __builtin_amdgcn_mfma_f32_16x16x32_bf16(b0[j], af[j], acc0, 0, 0, 0); acc1 = __builtin_amdgcn_mfma_f32_16x16x32_bf16(b1[j], af[j], acc1, 0, 0, 0); }
        }
        bf16* orow = O + (size_t)(mt * 16 + fr) * ldc + 16 * sb + 4 * fq;
        int mode = 0, col = 256 * pn;
        if (kind == 0) { if (pn == 0) col = 0; else if (pn >= 7) { col = 1024 + (pn - 7) * 256; if (pn == 8) mode = 1; } else if (pn <= 3) { mode = 2; col = 256 + (pn - 1) * 128; } else { mode = 3; col = 640 + (pn - 4) * 128; } }
        else if (kind == 2) { mode = 4; col = 128 * pn; }
        if (mode <= 1) {
            u32x2 o; o.x = pk2(acc0[0], acc0[1]); o.y = pk2(acc0[2], acc0[3]); *(u32x2*)(orow + col) = o;
            if (mode == 0) { u32x2 q; q.x = pk2(acc1[0], acc1[1]); q.y = pk2(acc1[2], acc1[3]); *(u32x2*)(orow + col + 128) = q; }
        } else {
            f32x4 r;
#pragma unroll
            for (int e = 0; e < 4; ++e) r[e] = (mode == 2) ? acc0[e] * sigmoid_f(acc1[e]) : (mode == 3) ? acc0[e] * acc1[e] : acc0[e] * sigmoid_f(acc0[e]) * acc1[e];
            u32x2 o; o.x = pk2(r[0], r[1]); o.y = pk2(r[2], r[3]); *(u32x2*)(orow + col) = o;
        }
    }
}

constexpr int NPH = 16;
__global__ void __launch_bounds__(512) mega_fwd(Args a) {
    extern __shared__ __attribute__((aligned(16))) unsigned char lds_raw[];
    LAS unsigned char* lds = (LAS unsigned char*)lds_raw;
    cg::grid_group grid = cg::this_grid();
    bf16* H = (bf16*)(a.ws + WS_H); bf16* Y = (bf16*)(a.ws + WS_Y); bf16* P = (bf16*)(a.ws + WS_P); bf16* CAT = (bf16*)(a.ws + WS_CAT); bf16* ACT = (bf16*)(a.ws + WS_ACT);
    for (int ph = a.ph_lo; ph < a.ph_hi; ++ph) {
#ifdef DUP_MASK
      const int kk_ = ph < 2 ? ph + 7 : (ph - 2) % 7;
      const int nrep_ = ((DUP_MASK >> kk_) & 1) ? 2 : 1;
      for (int rep_ = 0; rep_ < nrep_; ++rep_) {
        if (rep_) grid.sync();
#endif
        if (ph == 0) {
#ifndef SKIP_P0
            p0_prologue(a, lds);
#endif
        }
        else if (ph == 1) {
#ifndef SKIP_ROW
            row_phase<0>(a, true, 0, 0, nullptr, 0, 0, a.in[I_GPREMIX]);
#endif
        }
        else {
            const int l = (ph - 2) / 7, k = (ph - 2) % 7;
            const unsigned char* wl = a.ws + WS_W + (size_t)l * WL_SZ;
            if (k == 0 || k == 2 || k == 4 || k == 5) {
                const bf16* sA; const bf16* sB; bf16* sO; int sNT, sK, sld, skind;
                if (k == 0) {
                    pg8::Gemm g{H, (const bf16*)(wl + WL_IN), MP, INWP, D}; pg8::EpiInProj E{P, P2W};
                    pg8::StaticOrder S; S.init(g.M, g.N, gridDim.x, blockIdx.x);
                    pg8::gemm_phase<pg8::EpiInProj, pg8::StaticOrder, true, true>(lds, g, S, E);
                    sA = H; sB = g.Bt; sO = P; sNT = INWP / 256; sK = D; sld = P2W; skind = 0;
                } else if (k == 4) {
#ifndef SKIP_G3
                    pg8::Gemm g{H, (const bf16*)(wl + WL_GU), MP, NGU, D}; pg8::EpiSwiGLU E{ACT, DFF};
                    pg8::StaticOrder S; S.init(g.M, g.N, gridDim.x, blockIdx.x);
                    pg8::gemm_phase<pg8::EpiSwiGLU, pg8::StaticOrder, true, true>(lds, g, S, E);
#endif
                    sA = H; sB = (const bf16*)(wl + WL_GU); sO = ACT; sNT = NGU / 256; sK = D; sld = DFF; skind = 2;
                } else {
#ifndef SKIP_G1
                    pg8::Gemm g; pg8::EpiBf16 E;
                    if (k == 2) { g = pg8::Gemm{CAT, (const bf16*)(wl + WL_OUT), MP, D, D}; E = pg8::EpiBf16{Y, D}; }
                    else { g = pg8::Gemm{ACT, (const bf16*)(wl + WL_DN), MP, D, DFF}; E = pg8::EpiBf16{Y, D}; }
                    pg8::StaticOrder S; S.init(g.M, g.N, gridDim.x, blockIdx.x);
                    pg8::gemm_phase<pg8::EpiBf16, pg8::StaticOrder, true, true>(lds, g, S, E);
#endif
                    sA = (k == 2) ? CAT : ACT; sB = (const bf16*)(wl + (k == 2 ? WL_OUT : WL_DN)); sO = Y; sNT = D / 256; sK = (k == 2) ? D : DFF; sld = D; skind = 1;
                }
                sample_gemm(skind, sA + (size_t)MP * sK, sB, sNT, sK, sO + (size_t)MP * sld, sld);
            } else if (k == 1) {
#ifndef SKIP_MIX
#ifdef MIX_PROBE
                for (int rep = 0; rep < 2; ++rep) { int md = rep ? 7 : MIX_PROBE; asm volatile("" : "+s"(md)); mixer_phase(a, l, lds, md); if (rep == 0) grid.sync(); }
#else
                mixer_phase(a, l, lds);
#endif
#endif
            }
            else if (k == 3) {
#ifndef SKIP_ROW
                row_phase<1>(a, l == 0, l, 2, a.in[I_GPOSTMIX] + l * D, l, 3, a.in[I_GPREFFN] + l * D);
#endif
            }
            else {
#ifndef SKIP_ROW
                if (l == 0) row_phase<1>(a, false, 0, 5, a.in[I_GPOSTFFN], 1, 0, a.in[I_GPREMIX] + D);
                else row_phase<2>(a, false, 1, 5, a.in[I_GPOSTFFN] + D, 1, 0, nullptr);
#endif
            }
        }
#ifdef DUP_MASK
      }
#endif
        if (ph + 1 < a.ph_hi) grid.sync();
    }
}

extern "C" void kernel_launch(void* const* d_in, const int* in_sizes, int n_in, void* d_out, int out_size, void* d_ws, size_t ws_size, hipStream_t stream) {
    static int grid = 0;
    if (grid == 0) {
        if (n_in != 25 || ws_size < WS_END) { fprintf(stderr, "kernel_launch: unexpected n_in %d / ws_size %zu\n", n_in, ws_size); grid = -1; return; }
        int dev = 0, cus = 0, per_cu = 0;
        hipGetDevice(&dev); hipDeviceGetAttribute(&cus, hipDeviceAttributeMultiprocessorCount, dev);
        if (hipFuncSetAttribute((const void*)mega_fwd, hipFuncAttributeMaxDynamicSharedMemorySize, LDS_BYTES) != hipSuccess) { fprintf(stderr, "kernel_launch: hipFuncSetAttribute failed\n"); grid = -1; return; }
        if (hipOccupancyMaxActiveBlocksPerMultiprocessor(&per_cu, (const void*)mega_fwd, 512, LDS_BYTES) != hipSuccess || per_cu < 1) { fprintf(stderr, "kernel_launch: occupancy query gave %d\n", per_cu); per_cu = 1; }
        (void)hipGetLastError();
        grid = cus;
    }
    if (grid < 0) return;
    Args a{};
    for (int i = 0; i < 25; ++i) a.in[i] = (const float*)d_in[i];
    a.out = (float*)d_out; a.ws = (unsigned char*)d_ws;
#if ONE_LAUNCH
    a.ph_lo = 0; a.ph_hi = NPH;
    void* args[] = {&a};
    hipError_t e = hipLaunchCooperativeKernel((const void*)mega_fwd, dim3(grid), dim3(512), args, LDS_BYTES, stream);
    if (e != hipSuccess) fprintf(stderr, "cooperative launch failed: %s (grid %d)\n", hipGetErrorString(e), grid);
#else
    for (int ph = 0; ph < NPH; ++ph) { a.ph_lo = ph; a.ph_hi = ph + 1; hipLaunchKernelGGL(mega_fwd, dim3(grid), dim3(512), LDS_BYTES, stream, a); }
#endif
}
```

```cpp
#include <hip/hip_runtime.h>
#include <hip/hip_cooperative_groups.h>
#include <cstdio>
#include <cstdint>
namespace cg = cooperative_groups;

#ifndef ONE_LAUNCH
#define ONE_LAUNCH 1
#endif

namespace pg8 {
#define PG8_LAS __attribute__((address_space(3)))
typedef unsigned short bf16_t;
typedef short bf16x8 __attribute__((ext_vector_type(8)));
typedef float f32x4 __attribute__((ext_vector_type(4)));
typedef unsigned u32x4 __attribute__((ext_vector_type(4)));
constexpr int BM = 256, BK = 64, HALF = 128, HTB = HALF * BK * 2, STAGE_BYTES = 8 * HTB, NXCD = 8, WGM = 8;

__host__ __device__ __forceinline__ int lds_byte(int r, int c) { const int st = (r >> 4) * 2 + (c >> 5), rr = r & 15, cc = c & 31, ob = rr * 64 + cc * 2; return st * 1024 + (ob ^ (((ob >> 9) & 1) << 5)); }
__host__ __device__ __forceinline__ void stage_rc(int b, int& R, int& C) { const int st = b / 1024, sb = b % 1024, swz = sb ^ (((sb >> 9) & 1) << 5); R = (st >> 1) * 16 + swz / 64; C = (st & 1) * 32 + (swz % 64) / 2; }
__host__ __device__ __forceinline__ int perm32(int rho) { const int n = rho >> 4, i = rho & 15; return 8 * (i >> 2) + 4 * n + (i & 3); }

struct Unit { int pm, pn; };
struct Gemm { const bf16_t* A; const bf16_t* Bt; int M, N, K; };

struct StaticOrder {
    int nM, nN, nwg, G, c;
    __host__ __device__ void init(int M, int N, int G_, int c_) { nM = M / BM; nN = N / BM; nwg = nM * nN; G = G_; c = c_; }
    __host__ __device__ bool next(int i, Unit& u) const {
        const long L = (long)i * G + c; if (L >= nwg) return false;
        int wgid = (int)L; { const int q = nwg / NXCD, r = nwg % NXCD, xcd = wgid % NXCD, off = wgid / NXCD; wgid = (xcd < r ? xcd * (q + 1) : r * (q + 1) + (xcd - r) * q) + off; }
        const int nig = WGM * nN, gid = wgid / nig, fm = gid * WGM, gsz = (nM - fm) < WGM ? (nM - fm) : WGM;
        u.pm = fm + ((wgid % nig) % gsz); u.pn = (wgid % nig) / gsz; return true;
    }
    __device__ __forceinline__ void a_ready(const Unit&) const {}
    __device__ __forceinline__ void done(const Unit&) const {}
};

__device__ __forceinline__ unsigned cvt_pk_bf16(float lo, float hi) { unsigned r; asm volatile("v_cvt_pk_bf16_f32 %0, %1, %2" : "=v"(r) : "v"(lo), "v"(hi)); return r; }

struct EpiBf16 {
    static constexpr bool PERM = true, AFTER_DRAIN = false;
    bf16_t* O; int ldc;
    __device__ __forceinline__ void operator()(const f32x4 (&acc)[2][2][4][2], const Unit& u, int wr, int wc, int fr, int fq) const {
        const int row0 = u.pm * BM + wr * 64 + fr; const int col0 = u.pn * BM + wc * 32 + 8 * fq;
#pragma unroll
        for (int ai = 0; ai < 2; ++ai)
#pragma unroll
            for (int m = 0; m < 4; ++m) { bf16_t* rowp = O + (size_t)(row0 + ai * HALF + m * 16) * ldc + col0;
#pragma unroll
                for (int bj = 0; bj < 2; ++bj) { const f32x4 v0 = acc[ai][bj][m][0], v1 = acc[ai][bj][m][1];
                    u32x4 w; w.x = cvt_pk_bf16(v0[0], v0[1]); w.y = cvt_pk_bf16(v0[2], v0[3]); w.z = cvt_pk_bf16(v1[0], v1[1]); w.w = cvt_pk_bf16(v1[2], v1[3]);
                    *(u32x4*)(rowp + bj * HALF) = w; } }
    }
};
__device__ __forceinline__ float silu_f(float g) { return g * __builtin_amdgcn_rcpf(1.0f + __builtin_amdgcn_exp2f(-1.44269504089f * g)); }
struct EpiSwiGLU {
    static constexpr bool PERM = true, AFTER_DRAIN = false;
    bf16_t* O; int ldc;
    __device__ __forceinline__ void operator()(const f32x4 (&acc)[2][2][4][2], const Unit& u, int wr, int wc, int fr, int fq) const {
        const int row0 = u.pm * BM + wr * 64 + fr; const int col0 = u.pn * HALF + wc * 32 + 8 * fq;
#pragma unroll
        for (int ai = 0; ai < 2; ++ai)
#pragma unroll
            for (int m = 0; m < 4; ++m) { bf16_t* rowp = O + (size_t)(row0 + ai * HALF + m * 16) * ldc + col0;
                const f32x4 g0 = acc[ai][0][m][0], g1 = acc[ai][0][m][1], u0 = acc[ai][1][m][0], u1 = acc[ai][1][m][1];
                u32x4 w;
                w.x = cvt_pk_bf16(silu_f(g0[0]) * u0[0], silu_f(g0[1]) * u0[1]); w.y = cvt_pk_bf16(silu_f(g0[2]) * u0[2], silu_f(g0[3]) * u0[3]);
                w.z = cvt_pk_bf16(silu_f(g1[0]) * u1[0], silu_f(g1[1]) * u1[1]); w.w = cvt_pk_bf16(silu_f(g1[2]) * u1[2], silu_f(g1[3]) * u1[3]);
                *(u32x4*)rowp = w; asm volatile("" ::: "memory"); }
    }
};

__device__ __forceinline__ float sigm_f(float g) { return __builtin_amdgcn_rcpf(1.0f + __builtin_amdgcn_exp2f(-1.44269504089f * g)); }
struct EpiInProj {
    static constexpr bool PERM = true, AFTER_DRAIN = false;
    bf16_t* O; int ldc;
    __device__ __forceinline__ void operator()(const f32x4 (&acc)[2][2][4][2], const Unit& u, int wr, int wc, int fr, int fq) const {
        const int row0 = u.pm * BM + wr * 64 + fr; const int cl = wc * 32 + 8 * fq; const int pn = u.pn;
        if (pn == 0 || pn >= 7) {
            const int col0 = (pn == 0 ? 0 : 1024 + (pn - 7) * 256) + cl;
#pragma unroll
            for (int ai = 0; ai < 2; ++ai)
#pragma unroll
                for (int m = 0; m < 4; ++m) { bf16_t* rowp = O + (size_t)(row0 + ai * HALF + m * 16) * ldc + col0;
#pragma unroll
                    for (int bj = 0; bj < 2; ++bj) { const f32x4 v0 = acc[ai][bj][m][0], v1 = acc[ai][bj][m][1];
                        u32x4 w; w.x = cvt_pk_bf16(v0[0], v0[1]); w.y = cvt_pk_bf16(v0[2], v0[3]); w.z = cvt_pk_bf16(v1[0], v1[1]); w.w = cvt_pk_bf16(v1[2], v1[3]);
                        if (bj == 0 || pn != 8) *(u32x4*)(rowp + bj * HALF) = w; } }
        } else {
            const bool glu = pn <= 3; const int col0 = (glu ? 256 + (pn - 1) * 128 : 640 + (pn - 4) * 128) + cl;
#pragma unroll
            for (int ai = 0; ai < 2; ++ai)
#pragma unroll
                for (int m = 0; m < 4; ++m) { bf16_t* rowp = O + (size_t)(row0 + ai * HALF + m * 16) * ldc + col0;
                    const f32x4 a0 = acc[ai][0][m][0], a1 = acc[ai][0][m][1]; f32x4 g0 = acc[ai][1][m][0], g1 = acc[ai][1][m][1];
                    if (glu) {
#pragma unroll
                        for (int e = 0; e < 4; ++e) { g0[e] = sigm_f(g0[e]); g1[e] = sigm_f(g1[e]); } }
                    u32x4 w; w.x = cvt_pk_bf16(a0[0] * g0[0], a0[1] * g0[1]); w.y = cvt_pk_bf16(a0[2] * g0[2], a0[3] * g0[3]);
                    w.z = cvt_pk_bf16(a1[0] * g1[0], a1[1] * g1[1]); w.w = cvt_pk_bf16(a1[2] * g1[2], a1[3] * g1[3]);
                    *(u32x4*)rowp = w; asm volatile("" ::: "memory"); }
        }
    }
};

template <class Epi, class Sched, bool ALIGN_EPI = false, bool SP2 = false>
__device__ __forceinline__ void gemm_phase(PG8_LAS unsigned char* lds, const Gemm g, const Sched& S, const Epi& E) {
    int tid_ = threadIdx.x; asm volatile("" : "+v"(tid_));
    const int tid = tid_, wid = __builtin_amdgcn_readfirstlane(tid >> 6), lane = tid & 63, wr = wid >> 2, wc = wid & 3, fr = lane & 15, fq = lane >> 4;
    const int K = g.K, nt = K / BK;
    unsigned voffA[2], voffB[2];
#pragma unroll
    for (int i = 0; i < 2; ++i) { int R, C; stage_rc(tid * 16 + i * 8192, R, C); const int Rb = Epi::PERM ? ((R & ~31) + perm32(R & 31)) : R;
        voffA[i] = (unsigned)(R * K + C) * 2u; voffB[i] = (unsigned)(Rb * K + C) * 2u; }
    const size_t kstep = (size_t)(BK * 2);
    const size_t hstep = (size_t)HALF * K * 2;
    const size_t tstep = 2 * hstep;
    const unsigned ldsw = (unsigned)wid * 1024u;
    const int aoff = lds_byte(wr * 64 + fr, fq * 8), boff = lds_byte(wc * 32 + fr, fq * 8);
#define PG8_SA(b, h) (((b) * 2 + (h)) * HTB)
#define PG8_SB(b, h) ((4 + (b) * 2 + (h)) * HTB)
#define PG8_STAGE(bufoff, gbase, voff) do { _Pragma("unroll") for (int _i = 0; _i < 2; ++_i) \
        __builtin_amdgcn_global_load_lds((const unsigned*)((const char*)(gbase) + (voff)[_i]), (PG8_LAS unsigned*)(lds + (bufoff) + ldsw + _i * 8192), 16, 0, 0); } while (0)
#define PG8_LDA(dst, b, h) do { _Pragma("unroll") for (int m = 0; m < 4; ++m) _Pragma("unroll") for (int k = 0; k < 2; ++k) dst[m][k] = *(const PG8_LAS bf16x8*)(lds + PG8_SA(b, h) + aoff + m * 2048 + k * 1024); } while (0)
#define PG8_LDB(dst, b, h) do { _Pragma("unroll") for (int n = 0; n < 2; ++n) _Pragma("unroll") for (int k = 0; k < 2; ++k) dst[n][k] = *(const PG8_LAS bf16x8*)(lds + PG8_SB(b, h) + boff + n * 2048 + k * 1024); } while (0)
#define PG8_MMA(ai, bj, At, Bt) do { __builtin_amdgcn_s_setprio(1); _Pragma("unroll") for (int m = 0; m < 4; ++m) _Pragma("unroll") for (int n = 0; n < 2; ++n) _Pragma("unroll") for (int k = 0; k < 2; ++k) \
        acc[ai][bj][m][n] = __builtin_amdgcn_mfma_f32_16x16x32_bf16(Bt[n][k], At[m][k], acc[ai][bj][m][n], 0, 0, 0); __builtin_amdgcn_s_setprio(0); } while (0)
#define PG8_WAIT_V(n) asm volatile("s_waitcnt vmcnt(" #n ")" ::: "memory")
#define PG8_WAIT_L(n) asm volatile("s_waitcnt lgkmcnt(" #n ")" ::: "memory")
#define PG8_BAR __builtin_amdgcn_s_barrier()
#define PG8_SCHED __builtin_amdgcn_sched_barrier(0)
    Unit cur, nxt; int ui = 0;
    if (!S.next(0, cur)) return;
    f32x4 acc[2][2][4][2];
#pragma unroll
    for (int a = 0; a < 2; ++a)
#pragma unroll
        for (int b = 0; b < 2; ++b)
#pragma unroll
            for (int m = 0; m < 4; ++m)
#pragma unroll
                for (int n = 0; n < 2; ++n) acc[a][b][m][n] = (f32x4){0.f, 0.f, 0.f, 0.f};
    bf16x8 At[4][2], B0[2][2], B1[2][2];
    const char* cA = (const char*)g.A + (size_t)cur.pm * tstep; const char* cB = (const char*)g.Bt + (size_t)cur.pn * tstep;
    S.a_ready(cur);
    if constexpr (SP2) {
        PG8_STAGE(PG8_SB(0, 0), cB, voffB); PG8_STAGE(PG8_SB(0, 1), cB + hstep, voffB); PG8_STAGE(PG8_SA(0, 0), cA, voffA); PG8_STAGE(PG8_SA(0, 1), cA + hstep, voffA);
        if (wr == 1) PG8_BAR;
        PG8_WAIT_V(2); PG8_BAR;
        PG8_STAGE(PG8_SB(1, 0), cB + kstep, voffB); PG8_STAGE(PG8_SA(1, 0), cA + kstep, voffA); PG8_STAGE(PG8_SB(1, 1), cB + hstep + kstep, voffB);
        PG8_WAIT_V(6); PG8_BAR;
    } else {
        PG8_STAGE(PG8_SB(0, 0), cB, voffB); PG8_STAGE(PG8_SA(0, 0), cA, voffA); PG8_STAGE(PG8_SB(0, 1), cB + hstep, voffB); PG8_STAGE(PG8_SA(0, 1), cA + hstep, voffA);
        if (wr == 1) PG8_BAR;
        PG8_WAIT_V(4); PG8_BAR;
        PG8_STAGE(PG8_SB(1, 0), cB + kstep, voffB); PG8_STAGE(PG8_SA(1, 0), cA + kstep, voffA); PG8_STAGE(PG8_SB(1, 1), cB + hstep + kstep, voffB);
        PG8_WAIT_V(6); PG8_BAR;
    }
    for (;;) {
        const bool has_next = S.next(ui + 1, nxt);
        const char* nA = has_next ? (const char*)g.A + (size_t)nxt.pm * tstep : cA; const char* nB = has_next ? (const char*)g.Bt + (size_t)nxt.pn * tstep : cB;
        for (int t = 0; t < nt; t += 2) {
            const bool last = (t == nt - 2);
            const char* a1 = cA + (size_t)(t + 1) * kstep;
            const char* a2 = last ? nA : cA + (size_t)(t + 2) * kstep; const char* b2 = last ? nB : cB + (size_t)(t + 2) * kstep;
            const char* a3 = a2 + kstep; const char* b3 = b2 + kstep;
            if (last && has_next) S.a_ready(nxt);
            if constexpr (SP2) {
            PG8_LDB(B0, 0, 0); PG8_LDB(B1, 0, 1); PG8_SCHED; PG8_LDA(At, 0, 0); PG8_STAGE(PG8_SA(1, 1), a1 + hstep, voffA);
            PG8_WAIT_V(8); PG8_WAIT_L(0); PG8_BAR; PG8_MMA(0, 0, At, B0); PG8_MMA(0, 1, At, B1); PG8_BAR; PG8_SCHED;
            PG8_LDA(At, 0, 1); PG8_STAGE(PG8_SB(0, 0), b2, voffB); PG8_STAGE(PG8_SB(0, 1), b2 + hstep, voffB); PG8_STAGE(PG8_SA(0, 0), a2, voffA);
            PG8_WAIT_V(8); PG8_WAIT_L(0); PG8_BAR; PG8_MMA(1, 0, At, B0); PG8_MMA(1, 1, At, B1); PG8_BAR; PG8_SCHED;
            PG8_LDB(B0, 1, 0); PG8_LDB(B1, 1, 1); PG8_SCHED; PG8_LDA(At, 1, 0); PG8_STAGE(PG8_SA(0, 1), a2 + hstep, voffA);
            PG8_WAIT_V(8); PG8_WAIT_L(0); PG8_BAR; PG8_MMA(0, 0, At, B0); PG8_MMA(0, 1, At, B1); PG8_BAR; PG8_SCHED;
            PG8_LDA(At, 1, 1); PG8_STAGE(PG8_SB(1, 0), b3, voffB); PG8_STAGE(PG8_SB(1, 1), b3 + hstep, voffB); PG8_STAGE(PG8_SA(1, 0), a3, voffA);
            PG8_WAIT_V(8); PG8_WAIT_L(0); PG8_BAR; PG8_MMA(1, 0, At, B0); PG8_MMA(1, 1, At, B1); PG8_BAR; PG8_SCHED;
            } else {
            PG8_LDB(B0, 0, 0); PG8_SCHED; PG8_LDA(At, 0, 0); PG8_STAGE(PG8_SA(1, 1), a1 + hstep, voffA);
            PG8_WAIT_L(8); PG8_BAR; PG8_WAIT_L(0); PG8_MMA(0, 0, At, B0); PG8_BAR; PG8_SCHED;
            PG8_LDB(B1, 0, 1); PG8_STAGE(PG8_SB(0, 0), b2, voffB);
            PG8_BAR; PG8_WAIT_L(0); PG8_MMA(0, 1, At, B1); PG8_BAR;
            PG8_LDA(At, 0, 1); PG8_STAGE(PG8_SA(0, 0), a2, voffA);
            PG8_BAR; PG8_WAIT_L(0); PG8_MMA(1, 0, At, B0); PG8_BAR; PG8_SCHED;
            PG8_STAGE(PG8_SB(0, 1), b2 + hstep, voffB);
            PG8_WAIT_V(6); PG8_BAR; PG8_MMA(1, 1, At, B1); PG8_BAR;
            PG8_LDB(B0, 1, 0); PG8_SCHED; PG8_LDA(At, 1, 0); PG8_STAGE(PG8_SA(0, 1), a2 + hstep, voffA);
            PG8_WAIT_L(8); PG8_BAR; PG8_WAIT_L(0); PG8_MMA(0, 0, At, B0); PG8_BAR; PG8_SCHED;
            PG8_LDB(B1, 1, 1); PG8_STAGE(PG8_SB(1, 0), b3, voffB);
            PG8_BAR; PG8_WAIT_L(0); PG8_MMA(0, 1, At, B1); PG8_BAR;
            PG8_LDA(At, 1, 1); PG8_STAGE(PG8_SA(1, 0), a3, voffA);
            PG8_BAR; PG8_WAIT_L(0); PG8_MMA(1, 0, At, B0); PG8_BAR; PG8_SCHED;
            PG8_STAGE(PG8_SB(1, 1), b3 + hstep, voffB);
            PG8_WAIT_V(6); PG8_BAR; PG8_MMA(1, 1, At, B1); PG8_BAR;
            }
        }
        if constexpr (ALIGN_EPI) { if (wr == 0) PG8_BAR; }
        if constexpr (!Epi::AFTER_DRAIN) { E(acc, cur, wr, wc, fr, fq); S.done(cur); }
        if (!has_next) break;
#pragma unroll
        for (int a = 0; a < 2; ++a)
#pragma unroll
            for (int b = 0; b < 2; ++b)
#pragma unroll
                for (int m = 0; m < 4; ++m)
#pragma unroll
                    for (int n = 0; n < 2; ++n) acc[a][b][m][n] = (f32x4){0.f, 0.f, 0.f, 0.f};
        cur = nxt; cA = nA; cB = nB; ++ui;
        if constexpr (ALIGN_EPI) { if (wr == 1) PG8_BAR; }
    }
    PG8_WAIT_V(0);
    if constexpr (!ALIGN_EPI) { if (wr == 0) PG8_BAR; }
    PG8_BAR;
#undef PG8_SA
#undef PG8_SB
#undef PG8_STAGE
#undef PG8_LDA
#undef PG8_LDB
#undef PG8_MMA
#undef PG8_WAIT_V
#undef PG8_WAIT_L
#undef PG8_BAR
#undef PG8_SCHED
}
}

#define LAS __attribute__((address_space(3)))
typedef unsigned short bf16;
typedef float f32x4 __attribute__((ext_vector_type(4)));
typedef float f32x2 __attribute__((ext_vector_type(2)));
typedef unsigned u32x4 __attribute__((ext_vector_type(4)));
typedef unsigned u32x2 __attribute__((ext_vector_type(2)));
typedef short bf16x8 __attribute__((ext_vector_type(8)));

constexpr int D = 1024, NB = 32, T_P = 2048, NDB = 8, T_S = 16, PASTLEN = 4096;
constexpr int MP = NB * T_P;
constexpr int MS = NDB * T_S;
constexpr int MR = MP + MS;
constexpr int MPAD = 257 * 256;
constexpr int INW = 2176, INWP = 2304, DFF = 2816, NGU = 2 * DFF;
constexpr int PW = 256, CW = 384, SW = 384, P2W = 1408;
constexpr float EPS = 1e-6f;
constexpr int NMODR = NB + NDB;
constexpr int KCH = 8;

constexpr size_t O_YP = 0, O_YS = (size_t)MP * D, O_POOLP = O_YS + (size_t)MS * D, O_CONVP = O_POOLP + 2 * 32 * 15 * 256,
                 O_SCP = O_CONVP + 2 * 32 * 30 * 384, O_POOLS = O_SCP + 2 * 32 * 2 * 384, O_CONVS = O_POOLS + 2 * 8 * 15 * 256, O_SCS = O_CONVS + 2 * 8 * 30 * 384;
constexpr size_t MiB = 1u << 20;
constexpr size_t WL_IN = 0, WL_OUT = (size_t)INWP * D * 2, WL_GU = WL_OUT + (size_t)D * D * 2, WL_DN = WL_GU + (size_t)NGU * D * 2, WL_SZ = WL_DN + (size_t)D * DFF * 2;
static_assert(WL_SZ == 23 * MiB, "weight block");
constexpr size_t WS_W = 2 * MiB, WS_PART = 48 * MiB, WS_H = 64 * MiB, WS_Y = 193 * MiB, WS_P = 322 * MiB, WS_CAT = 612 * MiB, WS_ACT = WS_P, WS_XB = 741 * MiB, WS_END = 870 * MiB;
static_assert(WS_PART + (size_t)2 * NMODR * 6144 * 4 <= WS_H && WS_H + (size_t)MPAD * D * 2 <= WS_Y && WS_Y + (size_t)MPAD * D * 2 <= WS_P && WS_P + (size_t)MPAD * INWP * 2 <= WS_CAT && WS_CAT + (size_t)MPAD * D * 2 <= WS_XB && WS_ACT + (size_t)MPAD * DFF * 2 <= WS_XB && WS_XB + (size_t)MR * D * 2 <= WS_END, "ws map");

constexpr int LDS_BYTES = 147456;

struct Args { const float* in[25]; float* out; unsigned char* ws; int ph_lo, ph_hi; };
enum { I_XP = 0, I_XS, I_CP, I_CS, I_SPOOL, I_SCONV, I_SSC, I_WADA, I_BADA, I_GPREMIX, I_GPOSTMIX, I_GPREFFN, I_GPOSTFFN, I_WIN, I_WPOOL, I_SPOOLW, I_WDW, I_BDW, I_LNG, I_LNB, I_WSC, I_WOUT, I_WGATE, I_WUP, I_WDOWN };

__device__ __forceinline__ unsigned f2bf(float f) { unsigned u = __builtin_bit_cast(unsigned, f); return (u + 0x7fffu + ((u >> 16) & 1u)) >> 16; }
__device__ __forceinline__ unsigned pk2(float lo, float hi) { unsigned r; asm("v_cvt_pk_bf16_f32 %0, %1, %2" : "=v"(r) : "v"(lo), "v"(hi)); return r; }
__device__ __forceinline__ float bflo(unsigned u) { return __builtin_bit_cast(float, u << 16); }
__device__ __forceinline__ float bfhi(unsigned u) { return __builtin_bit_cast(float, u & 0xffff0000u); }
__device__ __forceinline__ float wave_sum(float v) {
#pragma unroll
    for (int o = 1; o < 64; o <<= 1) v += __shfl_xor(v, o);
    return v;
}
__device__ __forceinline__ float sigmoid_f(float g) { return __builtin_amdgcn_rcpf(1.0f + __builtin_amdgcn_exp2f(-1.44269504089f * g)); }
__device__ __forceinline__ float silu_acc(float g) { return g / (1.0f + __expf(-g)); }

__device__ __forceinline__ void p0_transpose_item(const float* W, int N, bf16* WT, int Kp, int dest_row0, int k0, int n0, LAS float* scr, int lane) {
#pragma unroll 8
    for (int i = 0; i < 32; ++i) { const int kk = 2 * i + (lane >> 5); scr[kk * 33 + (lane & 31)] = W[(size_t)(k0 + kk) * N + n0 + (lane & 31)]; }
    asm volatile("s_waitcnt lgkmcnt(0)" ::: "memory");
    const int c = lane & 7;
#pragma unroll
    for (int j = 0; j < 4; ++j) { const int n = (lane >> 3) + 8 * j; const LAS float* s = scr + (8 * c) * 33 + n;
        u32x4 o; o.x = pk2(s[0 * 33], s[1 * 33]); o.y = pk2(s[2 * 33], s[3 * 33]); o.z = pk2(s[4 * 33], s[5 * 33]); o.w = pk2(s[6 * 33], s[7 * 33]);
        *(u32x4*)(WT + (size_t)(dest_row0 + n) * Kp + k0 + 8 * c) = o; }
    asm volatile("s_waitcnt lgkmcnt(0)" ::: "memory");
}

__device__ __forceinline__ void p0_prologue(const Args& a, LAS unsigned char* lds) {
    int tid = threadIdx.x; asm volatile("" : "+v"(tid));
    const int lane = tid & 63, wave = __builtin_amdgcn_readfirstlane(tid >> 6);
    LAS float* scr = (LAS float*)(lds + wave * 16384);
    const int gw = blockIdx.x * 8 + wave, NGW = gridDim.x * 8;
    constexpr int NMODWG = 120;
    const bool split = gridDim.x >= 2 * NMODWG;
    float* modp = (float*)(a.ws + WS_PART);
    if (!split || blockIdx.x < NMODWG) {
        LAS float* sc = (LAS float*)lds;
        for (int wi = blockIdx.x; wi < NMODWG; wi += gridDim.x) {
            const int it = wi * 8 + wave, rg = it % 5, cb = (it / 5) % 96, l = it / 480;
            float acc[8];
#pragma unroll
            for (int r = 0; r < 8; ++r) acc[r] = 0.f;
            const float* wp = a.in[I_WADA] + (size_t)l * D * 6144 + cb * 64;
#pragma unroll 1
            for (int half = 0; half < 2; ++half) {
                __syncthreads();
#pragma unroll 8
                for (int r = 0; r < NMODR; ++r) { const float cv = (r < NB) ? a.in[I_CP][r * D + half * 512 + tid] : a.in[I_CS][(r - NB) * D + half * 512 + tid]; sc[r * 512 + tid] = silu_acc(cv); }
                __syncthreads();
                const LAS float* sp = sc + rg * 8 * 512;
#pragma unroll 2
                for (int k0 = 0; k0 < 512; k0 += 8) {
                    const float* wq = wp + (size_t)(half * 512 + k0) * 6144 + lane;
                    const float w0 = wq[0], w1 = wq[6144], w2 = wq[2 * 6144], w3 = wq[3 * 6144], w4 = wq[4 * 6144], w5 = wq[5 * 6144], w6 = wq[6 * 6144], w7 = wq[7 * 6144];
#pragma unroll
                    for (int r = 0; r < 8; ++r) { const f32x4 s0 = *(const LAS f32x4*)(sp + r * 512 + k0), s1 = *(const LAS f32x4*)(sp + r * 512 + k0 + 4);
                        acc[r] += ((s0[0] * w0 + s0[1] * w1) + (s0[2] * w2 + s0[3] * w3)) + ((s1[0] * w4 + s1[1] * w5) + (s1[2] * w6 + s1[3] * w7)); }
                }
            }
            const float bias = a.in[I_BADA][l * 6144 + cb * 64 + lane];
            float* mo = modp + ((size_t)l * NMODR + rg * 8) * 6144 + cb * 64 + lane;
#pragma unroll
            for (int r = 0; r < 8; ++r) mo[(size_t)r * 6144] = acc[r] + bias;
        }
        __syncthreads();
    }
    constexpr int I_IN = 16 * (INW / 32), I_OUT = 16 * (D / 32), I_G = 16 * (DFF / 32), I_DN = (DFF / 64) * (D / 32), I_PADZ = 128;
    constexpr int PER_L = I_IN + I_OUT + 2 * I_G + I_DN + I_PADZ;
    const int tw0 = split ? NMODWG * 8 : 0;
    for (int it0 = gw - tw0; it0 < 2 * PER_L; it0 += NGW - tw0) {
        if (it0 < 0) break;
        const int l = it0 / PER_L; int r = it0 % PER_L;
        bf16* wl = (bf16*)(a.ws + WS_W + (size_t)l * WL_SZ);
        if (r < I_IN) { const int nblk = INW / 32, kb = r / nblk, nb = r % nblk, n0 = nb * 32; int dr;
            if (n0 < 256) dr = n0;
            else if (n0 < 640) { const int j = n0 - 256; dr = 256 * (1 + (j >> 7)) + (j & 127); }
            else if (n0 < 1024) { const int j = n0 - 640; dr = 256 * (1 + (j >> 7)) + 128 + (j & 127); }
            else if (n0 < 1408) { const int j = n0 - 1024; dr = 256 * (4 + (j >> 7)) + (j & 127); }
            else if (n0 < 1792) { dr = 1792 + (n0 - 1408); }
            else { const int j = n0 - 1792; dr = 256 * (4 + (j >> 7)) + 128 + (j & 127); }
            p0_transpose_item(a.in[I_WIN] + (size_t)l * D * INW, INW, (bf16*)((char*)wl + WL_IN), D, dr, kb * 64, n0, scr, lane); continue; } r -= I_IN;
        if (r < I_OUT) { const int nblk = D / 32, kb = r / nblk, nb = r % nblk; p0_transpose_item(a.in[I_WOUT] + (size_t)l * D * D, D, (bf16*)((char*)wl + WL_OUT), D, nb * 32, kb * 64, nb * 32, scr, lane); continue; } r -= I_OUT;
        if (r < 2 * I_G) { const int up = r >= I_G; if (up) r -= I_G; const int nblk = DFF / 32, kb = r / nblk, nb = r % nblk, n0 = nb * 32;
            p0_transpose_item(a.in[up ? I_WUP : I_WGATE] + (size_t)l * D * DFF, DFF, (bf16*)((char*)wl + WL_GU), D, (n0 >> 7) * 256 + up * 128 + (n0 & 127), kb * 64, n0, scr, lane); continue; } r -= 2 * I_G;
        if (r < I_DN) { const int nblk = D / 32, kb = r / nblk, nb = r % nblk; p0_transpose_item(a.in[I_WDOWN] + (size_t)l * DFF * D, D, (bf16*)((char*)wl + WL_DN), DFF, nb * 32, kb * 64, nb * 32, scr, lane); continue; } r -= I_DN;
        { u32x4* z = (u32x4*)((char*)wl + WL_IN + (size_t)(INW + r) * D * 2); z[lane] = (u32x4){0u, 0u, 0u, 0u}; z[lane + 64] = (u32x4){0u, 0u, 0u, 0u}; }
    }
}

__device__ __forceinline__ void load_mod(const Args& a, int l, int r, int which, int lane, f32x4 (&v)[4]) {
    const float* modp = (const float*)(a.ws + WS_PART) + ((size_t)l * NMODR + r) * 6144 + which * 1024;
#pragma unroll
    for (int j = 0; j < 4; ++j) v[j] = *(const f32x4*)(modp + 256 * j + 4 * lane);
}
__device__ __forceinline__ void load_vec(const float* g, int lane, f32x4 (&v)[4]) {
#pragma unroll
    for (int j = 0; j < 4; ++j) v[j] = *(const f32x4*)(g + 256 * j + 4 * lane);
}
template <int MODE>
__device__ __forceinline__ void rows_do(const float* xin, const bf16* xinb, bool xbf, float* xout, bf16* xoutb, const bf16* Y, bf16* H, int nrows, const f32x4 (&GB)[4], const f32x4 (&GA)[4], const f32x4 (&SH)[4], int lane) {
    f32x4 xc[4], xn[4]; u32x2 yc[4], yn[4];
#pragma unroll
    for (int j = 0; j < 4; ++j) {
        if (xbf) { const u32x2 q = *(const u32x2*)(xinb + 256 * j + 4 * lane); xc[j] = (f32x4){bflo(q.x), bfhi(q.x), bflo(q.y), bfhi(q.y)}; } else xc[j] = *(const f32x4*)(xin + 256 * j + 4 * lane);
        if (MODE != 0) yc[j] = *(const u32x2*)(Y + 256 * j + 4 * lane); }
    for (int i = 0; i < nrows; ++i) {
        const int ip = (i + 1 < nrows) ? i + 1 : i;
#pragma unroll
        for (int j = 0; j < 4; ++j) {
            if (xbf) { const u32x2 q = *(const u32x2*)(xinb + (size_t)ip * D + 256 * j + 4 * lane); xn[j] = (f32x4){bflo(q.x), bfhi(q.x), bflo(q.y), bfhi(q.y)}; } else xn[j] = *(const f32x4*)(xin + (size_t)ip * D + 256 * j + 4 * lane);
            if (MODE != 0) yn[j] = *(const u32x2*)(Y + (size_t)ip * D + 256 * j + 4 * lane); }
        f32x4 x[4];
#pragma unroll
        for (int j = 0; j < 4; ++j) x[j] = xc[j];
        if (MODE != 0) {
            f32x4 y[4]; float ss = 0.f;
#pragma unroll
            for (int j = 0; j < 4; ++j) { y[j] = (f32x4){bflo(yc[j].x), bfhi(yc[j].x), bflo(yc[j].y), bfhi(yc[j].y)}; ss += (y[j][0] * y[j][0] + y[j][1] * y[j][1]) + (y[j][2] * y[j][2] + y[j][3] * y[j][3]); }
            const float rs = __builtin_amdgcn_rsqf(wave_sum(ss) * (1.0f / D) + EPS);
#pragma unroll
            for (int j = 0; j < 4; ++j) { x[j] += GB[j] * (y[j] * rs);
                if (MODE == 2) *(f32x4*)(xout + (size_t)i * D + 256 * j + 4 * lane) = x[j];
                else { u32x2 o; o.x = pk2(x[j][0], x[j][1]); o.y = pk2(x[j][2], x[j][3]); *(u32x2*)(xoutb + (size_t)i * D + 256 * j + 4 * lane) = o; } }
        }
        if (MODE != 2) {
            float ss = 0.f;
#pragma unroll
            for (int j = 0; j < 4; ++j) ss += (x[j][0] * x[j][0] + x[j][1] * x[j][1]) + (x[j][2] * x[j][2] + x[j][3] * x[j][3]);
            const float rs = __builtin_amdgcn_rsqf(wave_sum(ss) * (1.0f / D) + EPS);
#pragma unroll
            for (int j = 0; j < 4; ++j) { const f32x4 h = (x[j] * rs) * GA[j] + SH[j]; u32x2 o; o.x = pk2(h[0], h[1]); o.y = pk2(h[2], h[3]); *(u32x2*)(H + (size_t)i * D + 256 * j + 4 * lane) = o; }
        }
#pragma unroll
        for (int j = 0; j < 4; ++j) { xc[j] = xn[j]; if (MODE != 0) yc[j] = yn[j]; }
    }
}
template <int MODE>
__device__ __forceinline__ void row_phase(const Args& a, bool x_from_input, int lb, int wgt, const float* gpost, int lh, int wsh, const float* gpre) {
    int tid = threadIdx.x; asm volatile("" : "+v"(tid));
    const int lane = tid & 63, wave = __builtin_amdgcn_readfirstlane(tid >> 6);
    const int gw = blockIdx.x * 8 + wave, NGW = gridDim.x * 8;
    const bf16* Y = (const bf16*)(a.ws + WS_Y); bf16* H = (bf16*)(a.ws + WS_H); bf16* XB = (bf16*)(a.ws + WS_XB);
    const int nchunk = MP / 32 + MS;
    for (int ch = gw; ch < nchunk; ch += NGW) {
        int row0, nrows, r;
        if (ch < MP / 32) { row0 = ch * 32; nrows = 32; r = row0 / T_P; } else { const int j = ch - MP / 32; row0 = MP + j; nrows = 1; r = NB + j / T_S; }
        f32x4 GB[4], GA[4], SH[4];
        if (MODE != 0) { f32x4 gt[4], gp[4]; load_mod(a, lb, r, wgt, lane, gt); load_vec(gpost, lane, gp);
#pragma unroll
            for (int j = 0; j < 4; ++j) GB[j] = gt[j] * gp[j]; }
        if (MODE != 2) { f32x4 sc[4], gp[4]; load_mod(a, lh, r, wsh + 1, lane, sc); load_mod(a, lh, r, wsh, lane, SH); load_vec(gpre, lane, gp);
#pragma unroll
            for (int j = 0; j < 4; ++j) GA[j] = gp[j] * (1.0f + sc[j]); }
        const float* xin = (row0 < MP ? a.in[I_XP] + (size_t)row0 * D : a.in[I_XS] + (size_t)(row0 - MP) * D);
        rows_do<MODE>(xin, XB + (size_t)row0 * D, !x_from_input, a.out + (size_t)row0 * D, XB + (size_t)row0 * D, Y + (size_t)row0 * D, H + (size_t)row0 * D, nrows, GB, GA, SH, lane);
    }
}

template <int N, int SZ>
__device__ __forceinline__ void tr_reduce_step(float (&v)[SZ], int lane) {
    constexpr int Hh = N / 2;
    const bool up = (lane & Hh) != 0;
#pragma unroll
    for (int i = 0; i < Hh; ++i) { const float send = up ? v[i] : v[i + Hh]; const float keep = up ? v[i + Hh] : v[i]; v[i] = keep + __shfl_xor(send, Hh); }
}
template <int R, int N> struct ConvLoop {
    static __device__ __forceinline__ void run(f32x2 (&z)[32], const f32x2 (&w)[31], const LAS unsigned* up) {
        const unsigned v = up[R * 192]; const f32x2 uv = {bflo(v), bfhi(v)};
#pragma unroll
        for (int i = (R - 30 > 0 ? R - 30 : 0); i <= (R < 31 ? R : 31); ++i) z[i] += w[R - i] * uv;
        if ((R & 7) == 7) asm volatile("" ::: "memory");
        ConvLoop<R + 1, N>::run(z, w, up);
    }
};
template <int N> struct ConvLoop<N, N> { static __device__ __forceinline__ void run(f32x2 (&)[32], const f32x2 (&)[31], const LAS unsigned*) {} };

constexpr int MIX_UC = 0, MIX_XA = 73728, XA_PITCH = 528, MIX_ST = MIX_XA + 79 * XA_PITCH;
static_assert(MIX_ST + 6 * 64 * 4 <= 131072, "mixer LDS");

__device__ __forceinline__ void mixer_phase(const Args& a, int l, LAS unsigned char* lds, int mode = 7) {
    const bf16* P = (const bf16*)(a.ws + WS_P); bf16* CAT = (bf16*)(a.ws + WS_CAT);
    LAS bf16* Uc = (LAS bf16*)(lds + MIX_UC);
    LAS unsigned char* XaB = lds + MIX_XA;
    LAS float* ST = (LAS float*)(lds + MIX_ST);
    const int NU = MP / 64 + NDB;
    for (int u = blockIdx.x; u < NU; u += gridDim.x) {
        int tid = threadIdx.x; asm volatile("" : "+v"(tid));
        const int lane = tid & 63, wave = __builtin_amdgcn_readfirstlane(tid >> 6);
        int rowbase, T, t0, start, b; bool smp;
        if (u < MP / 64) { b = u / 32; t0 = (u % 32) * 64; T = T_P; start = 0; rowbase = b * T_P; smp = false; }
        else { b = u - MP / 64; t0 = 0; T = T_S; start = PASTLEN; rowbase = MP + b * T_S; smp = true; }
        const int nbat = smp ? NDB : NB;
        float* pool_out = a.out + (smp ? O_POOLS : O_POOLP) + ((size_t)l * nbat + b) * 15 * 256;
        float* conv_out = a.out + (smp ? O_CONVS : O_CONVP) + ((size_t)l * nbat + b) * 30 * 384;
        float* sc_out = a.out + (smp ? O_SCS : O_SCP) + ((size_t)l * nbat + b) * 2 * 384;
        const float* st_pool = a.in[I_SPOOL] + ((size_t)l * NDB + b) * 15 * 256;
        const float* st_conv = a.in[I_SCONV] + ((size_t)l * NDB + b) * 30 * 384;
        const float* st_sc = a.in[I_SSC] + ((size_t)l * NDB + b) * 2 * 384;
        const int seg = tid / 48, oc = tid - seg * 48, cc = oc * 8;
        u32x4 va[12], vb[5];
        if (tid < 384) {
#pragma unroll
            for (int q = 0; q < 12; ++q) { const int r = seg + 8 * q, t = t0 - 30 + r;
                va[q] = (u32x4){0u, 0u, 0u, 0u};
                if (r < 94 && t >= 0 && t < T) va[q] = *(const u32x4*)(P + (size_t)(rowbase + t) * P2W + 256 + cc); }
        }
#pragma unroll
        for (int q = 0; q < 5; ++q) { const int i = tid + 512 * q, r = i >> 5, o = i & 31, t = t0 - 15 + r;
            vb[q] = (u32x4){0u, 0u, 0u, 0u};
            if (i < 79 * 32 && t >= 0 && t < T) vb[q] = *(const u32x4*)(P + (size_t)(rowbase + t) * P2W + o * 8); }
        if (smp) {
            if (tid < 384) {
#pragma unroll
                for (int q = 0; q < 4; ++q) { const int r = seg + 8 * q, t = r - 30;
                    if (t < 0) { const f32x4 p0 = *(const f32x4*)(st_conv + (30 + t) * 384 + cc), p1 = *(const f32x4*)(st_conv + (30 + t) * 384 + cc + 4);
                        va[q].x = pk2(p0[0], p0[1]); va[q].y = pk2(p0[2], p0[3]); va[q].z = pk2(p1[0], p1[1]); va[q].w = pk2(p1[2], p1[3]); } }
            }
#pragma unroll
            for (int q = 0; q < 1; ++q) { const int i = tid, r = i >> 5, o = i & 31, t = r - 15, c = o * 8;
                if (t < 0) { const f32x4 p0 = *(const f32x4*)(st_pool + (15 + t) * 256 + c), p1 = *(const f32x4*)(st_pool + (15 + t) * 256 + c + 4);
                    vb[q].x = pk2(p0[0], p0[1]); vb[q].y = pk2(p0[2], p0[3]); vb[q].z = pk2(p1[0], p1[1]); vb[q].w = pk2(p1[2], p1[3]); } }
        }
        if (tid < 384) {
#pragma unroll
            for (int q = 0; q < 12; ++q) { const int r = seg + 8 * q; if (r < 94) *(LAS u32x4*)(Uc + r * 384 + cc) = va[q]; }
        }
#pragma unroll
        for (int q = 0; q < 5; ++q) { const int i = tid + 512 * q, r = i >> 5, o = i & 31; if (i < 79 * 32) *(LAS u32x4*)(XaB + r * XA_PITCH + o * 16) = vb[q]; }
        if (t0 + 64 >= T) {
            for (int i = tid; i < 30 * 48; i += 512) { const int sr = i / 48, o = i - sr * 48, t = T - 30 + sr, c = o * 8; float* d = conv_out + sr * 384 + c;
                if (t >= 0) { const u32x4 w = *(const u32x4*)(P + (size_t)(rowbase + t) * P2W + 256 + c);
                    *(f32x4*)d = (f32x4){bflo(w.x), bfhi(w.x), bflo(w.y), bfhi(w.y)}; *(f32x4*)(d + 4) = (f32x4){bflo(w.z), bfhi(w.z), bflo(w.w), bfhi(w.w)}; }
                else { *(f32x4*)d = *(const f32x4*)(st_conv + (30 + t) * 384 + c); *(f32x4*)(d + 4) = *(const f32x4*)(st_conv + (30 + t) * 384 + c + 4); } }
            for (int i = tid; i < 15 * 32; i += 512) { const int sr = i >> 5, o = i & 31, t = T - 15 + sr, c = o * 8; float* d = pool_out + sr * 256 + c;
                if (t >= 0) { const u32x4 w = *(const u32x4*)(P + (size_t)(rowbase + t) * P2W + c);
                    *(f32x4*)d = (f32x4){bflo(w.x), bfhi(w.x), bflo(w.y), bfhi(w.y)}; *(f32x4*)(d + 4) = (f32x4){bflo(w.z), bfhi(w.z), bflo(w.w), bfhi(w.w)}; }
                else { *(f32x4*)d = *(const f32x4*)(st_pool + (15 + t) * 256 + c); *(f32x4*)(d + 4) = *(const f32x4*)(st_pool + (15 + t) * 256 + c + 4); } }
            for (int i = tid; i < 2 * 48; i += 512) { const int sr = i / 48, o = i - sr * 48, t = T - 2 + sr, c = o * 8; float* d = sc_out + sr * 384 + c;
                const u32x4 w = *(const u32x4*)(P + (size_t)(rowbase + t) * P2W + 640 + c);
                *(f32x4*)d = (f32x4){bflo(w.x), bfhi(w.x), bflo(w.y), bfhi(w.y)}; *(f32x4*)(d + 4) = (f32x4){bflo(w.z), bfhi(w.z), bflo(w.w), bfhi(w.w)}; }
        }
        if (tid < 384) {
            float w0[8], w1[8], w2[8];
            { const float* ws = a.in[I_WSC] + (size_t)l * 3 * 384 + cc;
#pragma unroll
              for (int e = 0; e < 8; ++e) { w0[e] = ws[e]; w1[e] = ws[384 + e]; w2[e] = ws[768 + e]; } }
            float up2[8], up1[8];
#pragma unroll
            for (int ps = 0; ps < 2; ++ps) {
                u32x4 vu[6], vg[4];
#pragma unroll
                for (int d = (ps ? 2 : 0); d < 6; ++d) { const int t = t0 + 8 * seg + 4 * ps + d - 2; vu[d] = (u32x4){0u, 0u, 0u, 0u};
                    if (t >= 0 && t < T) vu[d] = *(const u32x4*)(P + (size_t)(rowbase + t) * P2W + 640 + cc); }
#pragma unroll
                for (int d = 0; d < 4; ++d) { const int t = t0 + 8 * seg + 4 * ps + d; vg[d] = (u32x4){0u, 0u, 0u, 0u};
                    if (t < T) vg[d] = *(const u32x4*)(P + (size_t)(rowbase + t) * P2W + 1024 + cc); }
#pragma unroll
                for (int d = (ps ? 2 : 0); d < 6; ++d) {
                    const int t = t0 + 8 * seg + 4 * ps + d - 2;
                    float uc[8];
#pragma unroll
                    for (int e = 0; e < 4; ++e) { uc[2 * e] = bflo(vu[d][e]); uc[2 * e + 1] = bfhi(vu[d][e]); }
                    if (ps == 0 && d < 2 && smp && t < 0) { const f32x4 p0 = *(const f32x4*)(st_sc + (2 + t) * 384 + cc), p1 = *(const f32x4*)(st_sc + (2 + t) * 384 + cc + 4);
#pragma unroll
                        for (int e = 0; e < 4; ++e) { uc[e] = p0[e]; uc[4 + e] = p1[e]; } }
                    if (d >= 2) {
                        const u32x4 bv = vg[d - 2];
                        float y[8];
#pragma unroll
                        for (int e = 0; e < 4; ++e) {
                            y[2 * e] = bflo(bv[e]) * (w0[2 * e] * up2[2 * e] + w1[2 * e] * up1[2 * e] + w2[2 * e] * uc[2 * e]);
                            y[2 * e + 1] = bfhi(bv[e]) * (w0[2 * e + 1] * up2[2 * e + 1] + w1[2 * e + 1] * up1[2 * e + 1] + w2[2 * e + 1] * uc[2 * e + 1]); }
                        if (t < T) {
                            u32x4 w; w.x = pk2(y[0], y[1]); w.y = pk2(y[2], y[3]); w.z = pk2(y[4], y[5]); w.w = pk2(y[6], y[7]);
                            *(u32x4*)(CAT + (size_t)(rowbase + t) * D + 640 + cc) = w;
                        }
                    }
#pragma unroll
                    for (int e = 0; e < 8; ++e) { if (ps == 1 || d >= 1) up2[e] = up1[e]; up1[e] = uc[e]; }
                }
            }
        }
        __syncthreads();
        f32x2 z[32];
        int tid2 = tid; asm volatile("" : "+v"(tid2));
        const int half = (tid2 >= 192) ? 1 : 0, p = tid2 - 192 * half;
        if (wave < 6 && (mode & 2)) {
            f32x2 w[31];
            const float* wd = a.in[I_WDW] + (size_t)l * 31 * 384 + 2 * p;
#pragma unroll
            for (int j = 0; j < 31; ++j) w[j] = *(const f32x2*)(wd + j * 384);
            const f32x2 bb = *(const f32x2*)(a.in[I_BDW] + l * 384 + 2 * p);
#pragma unroll
            for (int i = 0; i < 32; ++i) z[i] = bb;
            const LAS unsigned* up = (const LAS unsigned*)Uc + (32 * half) * 192 + p;
            ConvLoop<0, 62>::run(z, w, up);
            float sv[32];
            { const bool up = (lane & 32) != 0;
#pragma unroll
              for (int i = 0; i < 32; ++i) { const f32x2 zl = z[i >> 1], zh = z[16 + (i >> 1)];
                  const float va_ = (i & 1) ? (zl[0] * zl[0] + zl[1] * zl[1]) : (zl[0] + zl[1]), vb_ = (i & 1) ? (zh[0] * zh[0] + zh[1] * zh[1]) : (zh[0] + zh[1]);
                  const float send = up ? va_ : vb_, keep = up ? vb_ : va_; sv[i] = keep + __shfl_xor(send, 32);
                  if ((i & 7) == 7) asm volatile("" ::: "memory"); } }
            tr_reduce_step<32>(sv, lane); tr_reduce_step<16>(sv, lane); tr_reduce_step<8>(sv, lane); tr_reduce_step<4>(sv, lane); tr_reduce_step<2>(sv, lane);
            ST[wave * 64 + lane] = sv[0];
        } else if (mode & 2) {
            const int fr = tid2 & 15, fq = (tid2 & 63) >> 4;
#pragma unroll 1
            for (int gi = 0; gi < 2; ++gi) {
                const int g = (wave == 6) ? (gi ? 3 : 0) : (gi ? 2 : 1), win = 2 << g;
                bf16x8 Wf[4][2];
#pragma unroll
                for (int nt = 0; nt < 4; ++nt)
#pragma unroll
                    for (int kk = 0; kk < 2; ++kk) { const float* wp = a.in[I_WPOOL] + (((size_t)l * 4 + g) * 64 + 32 * kk + 8 * fq) * 64 + 16 * nt + fr;
                        u32x4 q; q.x = pk2(wp[0], wp[64]); q.y = pk2(wp[128], wp[192]); q.z = pk2(wp[256], wp[320]); q.w = pk2(wp[384], wp[448]);
                        Wf[nt][kk] = __builtin_bit_cast(bf16x8, q); }
                f32x4 spv[4];
#pragma unroll
                for (int nt = 0; nt < 4; ++nt) spv[nt] = *(const f32x4*)(a.in[I_SPOOLW] + l * 256 + 64 * g + 16 * nt + 4 * fq);
#pragma unroll 1
                for (int mt = 0; mt < 4; ++mt) {
                    const int i = 16 * mt + fr, r = i + 15;
                    const int pos = t0 + i + start; const float cnt = (float)((pos + 1 < win) ? pos + 1 : win); const float inv = 1.0f / cnt;
                    bf16x8 Af[2];
#pragma unroll
                    for (int kk = 0; kk < 2; ++kk) {
                        const LAS unsigned char* base = XaB + r * XA_PITCH + (64 * g + 32 * kk + 8 * fq) * 2;
                        float s[8];
#pragma unroll
                        for (int e = 0; e < 8; ++e) s[e] = 0.f;
                        for (int d = 0; d < win; ++d) { const u32x4 v = *(const LAS u32x4*)(base - d * XA_PITCH);
#pragma unroll
                            for (int e = 0; e < 4; ++e) { s[2 * e] += bflo(v[e]); s[2 * e + 1] += bfhi(v[e]); } }
                        const u32x4 cv = *(const LAS u32x4*)base;
                        u32x4 q;
#pragma unroll
                        for (int e = 0; e < 4; ++e) q[e] = pk2(s[2 * e] * inv - bflo(cv[e]), s[2 * e + 1] * inv - bfhi(cv[e]));
                        Af[kk] = __builtin_bit_cast(bf16x8, q);
                    }
                    const bool valid = (t0 + i) < T;
#pragma unroll
                    for (int nt = 0; nt < 4; ++nt) {
                        f32x4 acc = {0.f, 0.f, 0.f, 0.f};
                        acc = __builtin_amdgcn_mfma_f32_16x16x32_bf16(Wf[nt][0], Af[0], acc, 0, 0, 0);
                        acc = __builtin_amdgcn_mfma_f32_16x16x32_bf16(Wf[nt][1], Af[1], acc, 0, 0, 0);
                        const f32x4 sp = spv[nt];
                        u32x2 o; o.x = pk2(acc[0] * sp[0], acc[1] * sp[1]); o.y = pk2(acc[2] * sp[2], acc[3] * sp[3]);
                        if (valid) *(u32x2*)(CAT + (size_t)(rowbase + t0 + i) * D + 64 * g + 16 * nt + 4 * fq) = o;
                    }
                }
            }
        }
        __syncthreads();
        if (wave < 6 && (mode & 4)) {
            const f32x2 lg = *(const f32x2*)(a.in[I_LNG] + l * 384 + 2 * p), lb = *(const f32x2*)(a.in[I_LNB] + l * 384 + 2 * p);
            const float tot = ST[(3 * half) * 64 + lane] + ST[(3 * half + 1) * 64 + lane] + ST[(3 * half + 2) * 64 + lane];
            const float oth = __shfl_xor(tot, 1);
            const float s1 = (lane & 1) ? oth : tot, s2 = (lane & 1) ? tot : oth;
            const float mu_l = s1 * (1.0f / 384.0f); float var_l = s2 * (1.0f / 384.0f) - mu_l * mu_l; var_l = var_l > 0.f ? var_l : 0.f;
            const float rstd_l = __builtin_amdgcn_rsqf(var_l + EPS);
            const int trow = t0 + 32 * half;
            bf16* crow = CAT + (size_t)(rowbase + trow) * D + 256 + 2 * p;
#pragma unroll
            for (int i = 0; i < 32; ++i) {
                const float mu = __builtin_bit_cast(float, __builtin_amdgcn_readlane(__builtin_bit_cast(int, mu_l), 2 * i));
                const float rstd = __builtin_bit_cast(float, __builtin_amdgcn_readlane(__builtin_bit_cast(int, rstd_l), 2 * i));
                const f32x2 sc2 = lg * rstd, of2 = lb - sc2 * mu;
                const f32x2 y = z[i] * sc2 + of2;
                if (trow + i < T) *(unsigned*)(crow + (size_t)i * D) = pk2(y[0] * sigmoid_f(y[0]), y[1] * sigmoid_f(y[1]));
            }
        }
        __syncthreads();
    }
}


__device__ __forceinline__ void sample_gemm(int kind, const bf16* A, const bf16* Bt, int NT, int K, bf16* O, int ldc) {
    int tid = threadIdx.x; asm volatile("" : "+v"(tid));
    const int lane = tid & 63, wave = __builtin_amdgcn_readfirstlane(tid >> 6), fr = lane & 15, fq = lane >> 4;
    const int gw = blockIdx.x * 8 + wave, NGW = gridDim.x * 8, ntask = NT * 64;
    for (int task = gw; task < ntask; task += NGW) {
        const int mt = task & 7, sb = (task >> 3) & 7, pn = task >> 6;
        const bf16* ap = A + (size_t)(mt * 16 + fr) * K + 8 * fq;
        const bf16* bp0 = Bt + (size_t)(256 * pn + 16 * sb + fr) * K + 8 * fq;
        const bf16* bp1 = bp0 + (size_t)128 * K;
        f32x4 acc0 = {0.f, 0.f, 0.f, 0.f}, acc1 = {0.f, 0.f, 0.f, 0.f};
#pragma unroll 1
        for (int k0 = 0; k0 < K; k0 += 256) {
            bf16x8 af[8], b0[8], b1[8];
#pragma unroll
            for (int j = 0; j < 8; ++j) { af[j] = *(const bf16x8*)(ap + k0 + 32 * j); b0[j] = *(const bf16x8*)(bp0 + k0 + 32 * j); b1[j] = *(const bf16x8*)(bp1 + k0 + 32 * j); }
#pragma unroll
            for (int j = 0; j < 8; ++j) { acc0 = __builtin_amdgcn_mfma_f32_16x16x32_bf16(b0[j], af[j], acc0, 0, 0, 0); acc1 = __builtin_amdgcn_mfma_f32_16x16x32_bf16(b1[j], af[j], acc1, 0, 0, 0); }
        }
        bf16* orow = O + (size_t)(mt * 16 + fr) * ldc + 16 * sb + 4 * fq;
        int mode = 0, col = 256 * pn;
        if (kind == 0) { if (pn == 0) col = 0; else if (pn >= 7) { col = 1024 + (pn - 7) * 256; if (pn == 8) mode = 1; } else if (pn <= 3) { mode = 2; col = 256 + (pn - 1) * 128; } else { mode = 3; col = 640 + (pn - 4) * 128; } }
        else if (kind == 2) { mode = 4; col = 128 * pn; }
        if (mode <= 1) {
            u32x2 o; o.x = pk2(acc0[0], acc0[1]); o.y = pk2(acc0[2], acc0[3]); *(u32x2*)(orow + col) = o;
            if (mode == 0) { u32x2 q; q.x = pk2(acc1[0], acc1[1]); q.y = pk2(acc1[2], acc1[3]); *(u32x2*)(orow + col + 128) = q; }
        } else {
            f32x4 r;
#pragma unroll
            for (int e = 0; e < 4; ++e) r[e] = (mode == 2) ? acc0[e] * sigmoid_f(acc1[e]) : (mode == 3) ? acc0[e] * acc1[e] : acc0[e] * sigmoid_f(acc0[e]) * acc1[e];
            u32x2 o; o.x = pk2(r[0], r[1]); o.y = pk2(r[2], r[3]); *(u32x2*)(orow + col) = o;
        }
    }
}

constexpr int NPH = 16;
__global__ void __launch_bounds__(512) mega_fwd(Args a) {
    extern __shared__ __attribute__((aligned(16))) unsigned char lds_raw[];
    LAS unsigned char* lds = (LAS unsigned char*)lds_raw;
    cg::grid_group grid = cg::this_grid();
    bf16* H = (bf16*)(a.ws + WS_H); bf16* Y = (bf16*)(a.ws + WS_Y); bf16* P = (bf16*)(a.ws + WS_P); bf16* CAT = (bf16*)(a.ws + WS_CAT); bf16* ACT = (bf16*)(a.ws + WS_ACT);
    for (int ph = a.ph_lo; ph < a.ph_hi; ++ph) {
#ifdef DUP_MASK
      const int kk_ = ph < 2 ? ph + 7 : (ph - 2) % 7;
      const int nrep_ = ((DUP_MASK >> kk_) & 1) ? 2 : 1;
      for (int rep_ = 0; rep_ < nrep_; ++rep_) {
        if (rep_) grid.sync();
#endif
        if (ph == 0) {
#ifndef SKIP_P0
            p0_prologue(a, lds);
#endif
        }
        else if (ph == 1) {
#ifndef SKIP_ROW
            row_phase<0>(a, true, 0, 0, nullptr, 0, 0, a.in[I_GPREMIX]);
#endif
        }
        else {
            const int l = (ph - 2) / 7, k = (ph - 2) % 7;
            const unsigned char* wl = a.ws + WS_W + (size_t)l * WL_SZ;
            if (k == 0 || k == 2 || k == 4 || k == 5) {
                const bf16* sA; const bf16* sB; bf16* sO; int sNT, sK, sld, skind;
                if (k == 0) {
                    pg8::Gemm g{H, (const bf16*)(wl + WL_IN), MP, INWP, D}; pg8::EpiInProj E{P, P2W};
                    pg8::StaticOrder S; S.init(g.M, g.N, gridDim.x, blockIdx.x);
                    pg8::gemm_phase<pg8::EpiInProj, pg8::StaticOrder, true, true>(lds, g, S, E);
                    sA = H; sB = g.Bt; sO = P; sNT = INWP / 256; sK = D; sld = P2W; skind = 0;
                } else if (k == 4) {
#ifndef SKIP_G3
                    pg8::Gemm g{H, (const bf16*)(wl + WL_GU), MP, NGU, D}; pg8::EpiSwiGLU E{ACT, DFF};
                    pg8::StaticOrder S; S.init(g.M, g.N, gridDim.x, blockIdx.x);
                    pg8::gemm_phase<pg8::EpiSwiGLU, pg8::StaticOrder, true, true>(lds, g, S, E);
#endif
                    sA = H; sB = (const bf16*)(wl + WL_GU); sO = ACT; sNT = NGU / 256; sK = D; sld = DFF; skind = 2;
                } else {
#ifndef SKIP_G1
                    pg8::Gemm g; pg8::EpiBf16 E;
                    if (k == 2) { g = pg8::Gemm{CAT, (const bf16*)(wl + WL_OUT), MP, D, D}; E = pg8::EpiBf16{Y, D}; }
                    else { g = pg8::Gemm{ACT, (const bf16*)(wl + WL_DN), MP, D, DFF}; E = pg8::EpiBf16{Y, D}; }
                    pg8::StaticOrder S; S.init(g.M, g.N, gridDim.x, blockIdx.x);
                    pg8::gemm_phase<pg8::EpiBf16, pg8::StaticOrder, true, true>(lds, g, S, E);
#endif
                    sA = (k == 2) ? CAT : ACT; sB = (const bf16*)(wl + (k == 2 ? WL_OUT : WL_DN)); sO = Y; sNT = D / 256; sK = (k == 2) ? D : DFF; sld = D; skind = 1;
                }
                sample_gemm(skind, sA + (size_t)MP * sK, sB, sNT, sK, sO + (size_t)MP * sld, sld);
            } else if (k == 1) {
#ifndef SKIP_MIX
#ifdef MIX_PROBE
                for (int rep = 0; rep < 2; ++rep) { int md = rep ? 7 : MIX_PROBE; asm volatile("" : "+s"(md)); mixer_phase(a, l, lds, md); if (rep == 0) grid.sync(); }
#else
                mixer_phase(a, l, lds);
#endif
#endif
            }
            else if (k == 3) {
#ifndef SKIP_ROW
                row_phase<1>(a, l == 0, l, 2, a.in[I_GPOSTMIX] + l * D, l, 3, a.in[I_GPREFFN] + l * D);
#endif
            }
            else {
#ifndef SKIP_ROW
                if (l == 0) row_phase<1>(a, false, 0, 5, a.in[I_GPOSTFFN], 1, 0, a.in[I_GPREMIX] + D);
                else row_phase<2>(a, false, 1, 5, a.in[I_GPOSTFFN] + D, 1, 0, nullptr);
#endif
            }
        }
#ifdef DUP_MASK
      }
#endif
        if (ph + 1 < a.ph_hi) grid.sync();
    }
}

extern "C" void kernel_launch(void* const* d_in, const int* in_sizes, int n_in, void* d_out, int out_size, void* d_ws, size_t ws_size, hipStream_t stream) {
    static int grid = 0;
    if (grid == 0) {
        if (n_in != 25 || ws_size < WS_END) { fprintf(stderr, "kernel_launch: unexpected n_in %d / ws_size %zu\n", n_in, ws_size); grid = -1; return; }
        int dev = 0, cus = 0, per_cu = 0;
        hipGetDevice(&dev); hipDeviceGetAttribute(&cus, hipDeviceAttributeMultiprocessorCount, dev);
        if (hipFuncSetAttribute((const void*)mega_fwd, hipFuncAttributeMaxDynamicSharedMemorySize, LDS_BYTES) != hipSuccess) { fprintf(stderr, "kernel_launch: hipFuncSetAttribute failed\n"); grid = -1; return; }
        if (hipOccupancyMaxActiveBlocksPerMultiprocessor(&per_cu, (const void*)mega_fwd, 512, LDS_BYTES) != hipSuccess || per_cu < 1) { fprintf(stderr, "kernel_launch: occupancy query gave %d\n", per_cu); per_cu = 1; }
        (void)hipGetLastError();
        grid = cus;
    }
    if (grid < 0) return;
    Args a{};
    for (int i = 0; i < 25; ++i) a.in[i] = (const float*)d_in[i];
    a.out = (float*)d_out; a.ws = (unsigned char*)d_ws;
#if ONE_LAUNCH
    a.ph_lo = 0; a.ph_hi = NPH;
    void* args[] = {&a};
    hipError_t e = hipLaunchCooperativeKernel((const void*)mega_fwd, dim3(grid), dim3(512), args, LDS_BYTES, stream);
    if (e != hipSuccess) fprintf(stderr, "cooperative launch failed: %s (grid %d)\n", hipGetErrorString(e), grid);
#else
    for (int ph = 0; ph < NPH; ++ph) { a.ph_lo = ph; a.ph_hi = ph + 1; hipLaunchKernelGGL(mega_fwd, dim3(grid), dim3(512), LDS_BYTES, stream, a); }
#endif
}
```

```cpp
#include <hip/hip_runtime.h>
#include <hip/hip_cooperative_groups.h>
#include <cstdio>
#include <cstdint>
namespace cg = cooperative_groups;

#ifndef ONE_LAUNCH
#define ONE_LAUNCH 1
#endif

namespace pg8 {
#define PG8_LAS __attribute__((address_space(3)))
typedef unsigned short bf16_t;
typedef short bf16x8 __attribute__((ext_vector_type(8)));
typedef float f32x4 __attribute__((ext_vector_type(4)));
typedef unsigned u32x4 __attribute__((ext_vector_type(4)));
constexpr int BM = 256, BK = 64, HALF = 128, HTB = HALF * BK * 2, STAGE_BYTES = 8 * HTB, NXCD = 8, WGM = 4;

__host__ __device__ __forceinline__ int lds_byte(int r, int c) { const int st = (r >> 4) * 2 + (c >> 5), rr = r & 15, cc = c & 31, ob = rr * 64 + cc * 2; return st * 1024 + (ob ^ (((ob >> 9) & 1) << 5)); }
__host__ __device__ __forceinline__ void stage_rc(int b, int& R, int& C) { const int st = b / 1024, sb = b % 1024, swz = sb ^ (((sb >> 9) & 1) << 5); R = (st >> 1) * 16 + swz / 64; C = (st & 1) * 32 + (swz % 64) / 2; }
__host__ __device__ __forceinline__ int perm32(int rho) { const int n = rho >> 4, i = rho & 15; return 8 * (i >> 2) + 4 * n + (i & 3); }

struct Unit { int pm, pn; };
struct Gemm { const bf16_t* A; const bf16_t* Bt; int M, N, K; };

struct StaticOrder {
    int nM, nN, nwg, G, c;
    __host__ __device__ void init(int M, int N, int G_, int c_) { nM = M / BM; nN = N / BM; nwg = nM * nN; G = G_; c = c_; }
    __host__ __device__ bool next(int i, Unit& u) const {
        const long L = (long)i * G + c; if (L >= nwg) return false;
        int wgid = (int)L; { const int q = nwg / NXCD, r = nwg % NXCD, xcd = wgid % NXCD, off = wgid / NXCD; wgid = (xcd < r ? xcd * (q + 1) : r * (q + 1) + (xcd - r) * q) + off; }
        const int nig = WGM * nN, gid = wgid / nig, fm = gid * WGM, gsz = (nM - fm) < WGM ? (nM - fm) : WGM;
        u.pm = fm + ((wgid % nig) % gsz); u.pn = (wgid % nig) / gsz; return true;
    }
    __device__ __forceinline__ void a_ready(const Unit&) const {}
    __device__ __forceinline__ void done(const Unit&) const {}
};

__device__ __forceinline__ unsigned cvt_pk_bf16(float lo, float hi) { unsigned r; asm volatile("v_cvt_pk_bf16_f32 %0, %1, %2" : "=v"(r) : "v"(lo), "v"(hi)); return r; }

struct EpiBf16 {
    static constexpr bool PERM = true, AFTER_DRAIN = false;
    bf16_t* O; int ldc;
    __device__ __forceinline__ void operator()(const f32x4 (&acc)[2][2][4][2], const Unit& u, int wr, int wc, int fr, int fq) const {
        const int row0 = u.pm * BM + wr * 64 + fr; const int col0 = u.pn * BM + wc * 32 + 8 * fq;
#pragma unroll
        for (int ai = 0; ai < 2; ++ai)
#pragma unroll
            for (int m = 0; m < 4; ++m) { bf16_t* rowp = O + (size_t)(row0 + ai * HALF + m * 16) * ldc + col0;
#pragma unroll
                for (int bj = 0; bj < 2; ++bj) { const f32x4 v0 = acc[ai][bj][m][0], v1 = acc[ai][bj][m][1];
                    u32x4 w; w.x = cvt_pk_bf16(v0[0], v0[1]); w.y = cvt_pk_bf16(v0[2], v0[3]); w.z = cvt_pk_bf16(v1[0], v1[1]); w.w = cvt_pk_bf16(v1[2], v1[3]);
                    *(u32x4*)(rowp + bj * HALF) = w; } }
    }
};
__device__ __forceinline__ float silu_f(float g) { return g * __builtin_amdgcn_rcpf(1.0f + __builtin_amdgcn_exp2f(-1.44269504089f * g)); }
struct EpiSwiGLU {
    static constexpr bool PERM = true, AFTER_DRAIN = false;
    bf16_t* O; int ldc;
    __device__ __forceinline__ void operator()(const f32x4 (&acc)[2][2][4][2], const Unit& u, int wr, int wc, int fr, int fq) const {
        const int row0 = u.pm * BM + wr * 64 + fr; const int col0 = u.pn * HALF + wc * 32 + 8 * fq;
#pragma unroll
        for (int ai = 0; ai < 2; ++ai)
#pragma unroll
            for (int m = 0; m < 4; ++m) { bf16_t* rowp = O + (size_t)(row0 + ai * HALF + m * 16) * ldc + col0;
                const f32x4 g0 = acc[ai][0][m][0], g1 = acc[ai][0][m][1], u0 = acc[ai][1][m][0], u1 = acc[ai][1][m][1];
                u32x4 w;
                w.x = cvt_pk_bf16(silu_f(g0[0]) * u0[0], silu_f(g0[1]) * u0[1]); w.y = cvt_pk_bf16(silu_f(g0[2]) * u0[2], silu_f(g0[3]) * u0[3]);
                w.z = cvt_pk_bf16(silu_f(g1[0]) * u1[0], silu_f(g1[1]) * u1[1]); w.w = cvt_pk_bf16(silu_f(g1[2]) * u1[2], silu_f(g1[3]) * u1[3]);
                *(u32x4*)rowp = w; asm volatile("" ::: "memory"); }
    }
};

__device__ __forceinline__ float sigm_f(float g) { return __builtin_amdgcn_rcpf(1.0f + __builtin_amdgcn_exp2f(-1.44269504089f * g)); }
struct EpiInProj {
    static constexpr bool PERM = true, AFTER_DRAIN = false;
    bf16_t* O; int ldc;
    __device__ __forceinline__ void operator()(const f32x4 (&acc)[2][2][4][2], const Unit& u, int wr, int wc, int fr, int fq) const {
        const int row0 = u.pm * BM + wr * 64 + fr; const int cl = wc * 32 + 8 * fq; const int pn = u.pn;
        if (pn == 0 || pn >= 7) {
            const int col0 = (pn == 0 ? 0 : 1024 + (pn - 7) * 256) + cl;
#pragma unroll
            for (int ai = 0; ai < 2; ++ai)
#pragma unroll
                for (int m = 0; m < 4; ++m) { bf16_t* rowp = O + (size_t)(row0 + ai * HALF + m * 16) * ldc + col0;
#pragma unroll
                    for (int bj = 0; bj < 2; ++bj) { const f32x4 v0 = acc[ai][bj][m][0], v1 = acc[ai][bj][m][1];
                        u32x4 w; w.x = cvt_pk_bf16(v0[0], v0[1]); w.y = cvt_pk_bf16(v0[2], v0[3]); w.z = cvt_pk_bf16(v1[0], v1[1]); w.w = cvt_pk_bf16(v1[2], v1[3]);
                        if (bj == 0 || pn != 8) *(u32x4*)(rowp + bj * HALF) = w; } }
        } else {
            const bool glu = pn <= 3; const int col0 = (glu ? 256 + (pn - 1) * 128 : 640 + (pn - 4) * 128) + cl;
#pragma unroll
            for (int ai = 0; ai < 2; ++ai)
#pragma unroll
                for (int m = 0; m < 4; ++m) { bf16_t* rowp = O + (size_t)(row0 + ai * HALF + m * 16) * ldc + col0;
                    const f32x4 a0 = acc[ai][0][m][0], a1 = acc[ai][0][m][1]; f32x4 g0 = acc[ai][1][m][0], g1 = acc[ai][1][m][1];
                    if (glu) {
#pragma unroll
                        for (int e = 0; e < 4; ++e) { g0[e] = sigm_f(g0[e]); g1[e] = sigm_f(g1[e]); } }
                    u32x4 w; w.x = cvt_pk_bf16(a0[0] * g0[0], a0[1] * g0[1]); w.y = cvt_pk_bf16(a0[2] * g0[2], a0[3] * g0[3]);
                    w.z = cvt_pk_bf16(a1[0] * g1[0], a1[1] * g1[1]); w.w = cvt_pk_bf16(a1[2] * g1[2], a1[3] * g1[3]);
                    *(u32x4*)rowp = w; asm volatile("" ::: "memory"); }
        }
    }
};

template <class Epi, class Sched, bool ALIGN_EPI = false, bool SP2 = false>
__device__ __forceinline__ void gemm_phase(PG8_LAS unsigned char* lds, const Gemm g, const Sched& S, const Epi& E) {
    int tid_ = threadIdx.x; asm volatile("" : "+v"(tid_));
    const int tid = tid_, wid = __builtin_amdgcn_readfirstlane(tid >> 6), lane = tid & 63, wr = wid >> 2, wc = wid & 3, fr = lane & 15, fq = lane >> 4;
    const int K = g.K, nt = K / BK;
    unsigned voffA[2], voffB[2];
#pragma unroll
    for (int i = 0; i < 2; ++i) { int R, C; stage_rc(tid * 16 + i * 8192, R, C); const int Rb = Epi::PERM ? ((R & ~31) + perm32(R & 31)) : R;
        voffA[i] = (unsigned)(R * K + C) * 2u; voffB[i] = (unsigned)(Rb * K + C) * 2u; }
    const size_t kstep = (size_t)(BK * 2);
    const size_t hstep = (size_t)HALF * K * 2;
    const size_t tstep = 2 * hstep;
    const unsigned ldsw = (unsigned)wid * 1024u;
    const int aoff = lds_byte(wr * 64 + fr, fq * 8), boff = lds_byte(wc * 32 + fr, fq * 8);
#define PG8_SA(b, h) (((b) * 2 + (h)) * HTB)
#define PG8_SB(b, h) ((4 + (b) * 2 + (h)) * HTB)
#define PG8_STAGE(bufoff, gbase, voff) do { _Pragma("unroll") for (int _i = 0; _i < 2; ++_i) \
        __builtin_amdgcn_global_load_lds((const unsigned*)((const char*)(gbase) + (voff)[_i]), (PG8_LAS unsigned*)(lds + (bufoff) + ldsw + _i * 8192), 16, 0, 0); } while (0)
#define PG8_LDA(dst, b, h) do { _Pragma("unroll") for (int m = 0; m < 4; ++m) _Pragma("unroll") for (int k = 0; k < 2; ++k) dst[m][k] = *(const PG8_LAS bf16x8*)(lds + PG8_SA(b, h) + aoff + m * 2048 + k * 1024); } while (0)
#define PG8_LDB(dst, b, h) do { _Pragma("unroll") for (int n = 0; n < 2; ++n) _Pragma("unroll") for (int k = 0; k < 2; ++k) dst[n][k] = *(const PG8_LAS bf16x8*)(lds + PG8_SB(b, h) + boff + n * 2048 + k * 1024); } while (0)
#define PG8_MMA(ai, bj, At, Bt) do { __builtin_amdgcn_s_setprio(1); _Pragma("unroll") for (int m = 0; m < 4; ++m) _Pragma("unroll") for (int n = 0; n < 2; ++n) _Pragma("unroll") for (int k = 0; k < 2; ++k) \
        acc[ai][bj][m][n] = __builtin_amdgcn_mfma_f32_16x16x32_bf16(Bt[n][k], At[m][k], acc[ai][bj][m][n], 0, 0, 0); __builtin_amdgcn_s_setprio(0); } while (0)
#define PG8_WAIT_V(n) asm volatile("s_waitcnt vmcnt(" #n ")" ::: "memory")
#define PG8_WAIT_L(n) asm volatile("s_waitcnt lgkmcnt(" #n ")" ::: "memory")
#define PG8_BAR __builtin_amdgcn_s_barrier()
#define PG8_SCHED __builtin_amdgcn_sched_barrier(0)
    Unit cur, nxt; int ui = 0;
    if (!S.next(0, cur)) return;
#ifdef STAGGER_TICKS
    {
        const unsigned long long t0_ = __builtin_amdgcn_s_memrealtime(); const unsigned long long dl_ = (unsigned long long)((blockIdx.x >> 3) & 7) * STAGGER_TICKS;
        while (__builtin_amdgcn_s_memrealtime() - t0_ < dl_) __builtin_amdgcn_s_sleep(8);
    }
#endif
    f32x4 acc[2][2][4][2];
#pragma unroll
    for (int a = 0; a < 2; ++a)
#pragma unroll
        for (int b = 0; b < 2; ++b)
#pragma unroll
            for (int m = 0; m < 4; ++m)
#pragma unroll
                for (int n = 0; n < 2; ++n) acc[a][b][m][n] = (f32x4){0.f, 0.f, 0.f, 0.f};
    bf16x8 At[4][2], B0[2][2], B1[2][2];
    const char* cA = (const char*)g.A + (size_t)cur.pm * tstep; const char* cB = (const char*)g.Bt + (size_t)cur.pn * tstep;
    S.a_ready(cur);
    if constexpr (SP2) {
        PG8_STAGE(PG8_SB(0, 0), cB, voffB); PG8_STAGE(PG8_SB(0, 1), cB + hstep, voffB); PG8_STAGE(PG8_SA(0, 0), cA, voffA); PG8_STAGE(PG8_SA(0, 1), cA + hstep, voffA);
        if (wr == 1) PG8_BAR;
        PG8_WAIT_V(2); PG8_BAR;
        PG8_STAGE(PG8_SB(1, 0), cB + kstep, voffB); PG8_STAGE(PG8_SA(1, 0), cA + kstep, voffA); PG8_STAGE(PG8_SB(1, 1), cB + hstep + kstep, voffB);
        PG8_WAIT_V(6); PG8_BAR;
    } else {
        PG8_STAGE(PG8_SB(0, 0), cB, voffB); PG8_STAGE(PG8_SA(0, 0), cA, voffA); PG8_STAGE(PG8_SB(0, 1), cB + hstep, voffB); PG8_STAGE(PG8_SA(0, 1), cA + hstep, voffA);
        if (wr == 1) PG8_BAR;
        PG8_WAIT_V(4); PG8_BAR;
        PG8_STAGE(PG8_SB(1, 0), cB + kstep, voffB); PG8_STAGE(PG8_SA(1, 0), cA + kstep, voffA); PG8_STAGE(PG8_SB(1, 1), cB + hstep + kstep, voffB);
        PG8_WAIT_V(6); PG8_BAR;
    }
    for (;;) {
        const bool has_next = S.next(ui + 1, nxt);
        const char* nA = has_next ? (const char*)g.A + (size_t)nxt.pm * tstep : cA; const char* nB = has_next ? (const char*)g.Bt + (size_t)nxt.pn * tstep : cB;
        for (int t = 0; t < nt; t += 2) {
            const bool last = (t == nt - 2);
            const char* a1 = cA + (size_t)(t + 1) * kstep;
            const char* a2 = last ? nA : cA + (size_t)(t + 2) * kstep; const char* b2 = last ? nB : cB + (size_t)(t + 2) * kstep;
            const char* a3 = a2 + kstep; const char* b3 = b2 + kstep;
            if (last && has_next) S.a_ready(nxt);
            if constexpr (SP2) {
            PG8_LDB(B0, 0, 0); PG8_LDB(B1, 0, 1); PG8_SCHED; PG8_LDA(At, 0, 0); PG8_STAGE(PG8_SA(1, 1), a1 + hstep, voffA);
            PG8_WAIT_V(8); PG8_WAIT_L(0); PG8_BAR; PG8_MMA(0, 0, At, B0); PG8_MMA(0, 1, At, B1); PG8_BAR; PG8_SCHED;
            PG8_LDA(At, 0, 1); PG8_STAGE(PG8_SB(0, 0), b2, voffB); PG8_STAGE(PG8_SB(0, 1), b2 + hstep, voffB); PG8_STAGE(PG8_SA(0, 0), a2, voffA);
            PG8_WAIT_V(8); PG8_WAIT_L(0); PG8_BAR; PG8_MMA(1, 0, At, B0); PG8_MMA(1, 1, At, B1); PG8_BAR; PG8_SCHED;
            PG8_LDB(B0, 1, 0); PG8_LDB(B1, 1, 1); PG8_SCHED; PG8_LDA(At, 1, 0); PG8_STAGE(PG8_SA(0, 1), a2 + hstep, voffA);
            PG8_WAIT_V(8); PG8_WAIT_L(0); PG8_BAR; PG8_MMA(0, 0, At, B0); PG8_MMA(0, 1, At, B1); PG8_BAR; PG8_SCHED;
            PG8_LDA(At, 1, 1); PG8_STAGE(PG8_SB(1, 0), b3, voffB); PG8_STAGE(PG8_SB(1, 1), b3 + hstep, voffB); PG8_STAGE(PG8_SA(1, 0), a3, voffA);
            PG8_WAIT_V(8); PG8_WAIT_L(0); PG8_BAR; PG8_MMA(1, 0, At, B0); PG8_MMA(1, 1, At, B1); PG8_BAR; PG8_SCHED;
            } else {
            PG8_LDB(B0, 0, 0); PG8_SCHED; PG8_LDA(At, 0, 0); PG8_STAGE(PG8_SA(1, 1), a1 + hstep, voffA);
            PG8_WAIT_L(8); PG8_BAR; PG8_WAIT_L(0); PG8_MMA(0, 0, At, B0); PG8_BAR; PG8_SCHED;
            PG8_LDB(B1, 0, 1); PG8_STAGE(PG8_SB(0, 0), b2, voffB);
            PG8_BAR; PG8_WAIT_L(0); PG8_MMA(0, 1, At, B1); PG8_BAR;
            PG8_LDA(At, 0, 1); PG8_STAGE(PG8_SA(0, 0), a2, voffA);
            PG8_BAR; PG8_WAIT_L(0); PG8_MMA(1, 0, At, B0); PG8_BAR; PG8_SCHED;
            PG8_STAGE(PG8_SB(0, 1), b2 + hstep, voffB);
            PG8_WAIT_V(6); PG8_BAR; PG8_MMA(1, 1, At, B1); PG8_BAR;
            PG8_LDB(B0, 1, 0); PG8_SCHED; PG8_LDA(At, 1, 0); PG8_STAGE(PG8_SA(0, 1), a2 + hstep, voffA);
            PG8_WAIT_L(8); PG8_BAR; PG8_WAIT_L(0); PG8_MMA(0, 0, At, B0); PG8_BAR; PG8_SCHED;
            PG8_LDB(B1, 1, 1); PG8_STAGE(PG8_SB(1, 0), b3, voffB);
            PG8_BAR; PG8_WAIT_L(0); PG8_MMA(0, 1, At, B1); PG8_BAR;
            PG8_LDA(At, 1, 1); PG8_STAGE(PG8_SA(1, 0), a3, voffA);
            PG8_BAR; PG8_WAIT_L(0); PG8_MMA(1, 0, At, B0); PG8_BAR; PG8_SCHED;
            PG8_STAGE(PG8_SB(1, 1), b3 + hstep, voffB);
            PG8_WAIT_V(6); PG8_BAR; PG8_MMA(1, 1, At, B1); PG8_BAR;
            }
        }
        if constexpr (ALIGN_EPI) { if (wr == 0) PG8_BAR; }
        if constexpr (!Epi::AFTER_DRAIN) { E(acc, cur, wr, wc, fr, fq); S.done(cur); }
        if (!has_next) break;
#pragma unroll
        for (int a = 0; a < 2; ++a)
#pragma unroll
            for (int b = 0; b < 2; ++b)
#pragma unroll
                for (int m = 0; m < 4; ++m)
#pragma unroll
                    for (int n = 0; n < 2; ++n) acc[a][b][m][n] = (f32x4){0.f, 0.f, 0.f, 0.f};
        cur = nxt; cA = nA; cB = nB; ++ui;
        if constexpr (ALIGN_EPI) { if (wr == 1) PG8_BAR; }
    }
    PG8_WAIT_V(0);
    if constexpr (!ALIGN_EPI) { if (wr == 0) PG8_BAR; }
    PG8_BAR;
#undef PG8_SA
#undef PG8_SB
#undef PG8_STAGE
#undef PG8_LDA
#undef PG8_LDB
#undef PG8_MMA
#undef PG8_WAIT_V
#undef PG8_WAIT_L
#undef PG8_BAR
#undef PG8_SCHED
}
}

#define LAS __attribute__((address_space(3)))
typedef unsigned short bf16;
typedef float f32x4 __attribute__((ext_vector_type(4)));
typedef float f32x2 __attribute__((ext_vector_type(2)));
typedef unsigned u32x4 __attribute__((ext_vector_type(4)));
typedef unsigned u32x2 __attribute__((ext_vector_type(2)));
typedef short bf16x8 __attribute__((ext_vector_type(8)));

constexpr int D = 1024, NB = 32, T_P = 2048, NDB = 8, T_S = 16, PASTLEN = 4096;
constexpr int MP = NB * T_P;
constexpr int MS = NDB * T_S;
constexpr int MR = MP + MS;
constexpr int MPAD = 257 * 256;
constexpr int INW = 2176, INWP = 2304, DFF = 2816, NGU = 2 * DFF;
constexpr int PW = 256, CW = 384, SW = 384, P2W = 1408;
constexpr float EPS = 1e-6f;
constexpr int NMODR = NB + NDB;
constexpr int KCH = 8;

constexpr size_t O_YP = 0, O_YS = (size_t)MP * D, O_POOLP = O_YS + (size_t)MS * D, O_CONVP = O_POOLP + 2 * 32 * 15 * 256,
                 O_SCP = O_CONVP + 2 * 32 * 30 * 384, O_POOLS = O_SCP + 2 * 32 * 2 * 384, O_CONVS = O_POOLS + 2 * 8 * 15 * 256, O_SCS = O_CONVS + 2 * 8 * 30 * 384;
constexpr size_t MiB = 1u << 20;
constexpr size_t WL_IN = 0, WL_OUT = (size_t)INWP * D * 2, WL_GU = WL_OUT + (size_t)D * D * 2, WL_DN = WL_GU + (size_t)NGU * D * 2, WL_SZ = WL_DN + (size_t)D * DFF * 2;
static_assert(WL_SZ == 23 * MiB, "weight block");
constexpr size_t WS_W = 2 * MiB, WS_PART = 48 * MiB, WS_H = 64 * MiB, WS_Y = 193 * MiB, WS_P = 322 * MiB, WS_CAT = 612 * MiB, WS_ACT = WS_P, WS_XB = 741 * MiB, WS_END = 870 * MiB;
static_assert(WS_PART + (size_t)2 * NMODR * 6144 * 4 <= WS_H && WS_H + (size_t)MPAD * D * 2 <= WS_Y && WS_Y + (size_t)MPAD * D * 2 <= WS_P && WS_P + (size_t)MPAD * INWP * 2 <= WS_CAT && WS_CAT + (size_t)MPAD * D * 2 <= WS_XB && WS_ACT + (size_t)MPAD * DFF * 2 <= WS_XB && WS_XB + (size_t)MR * D * 2 <= WS_END, "ws map");

constexpr int LDS_BYTES = 147456;

struct Args { const float* in[25]; float* out; unsigned char* ws; int ph_lo, ph_hi; };
enum { I_XP = 0, I_XS, I_CP, I_CS, I_SPOOL, I_SCONV, I_SSC, I_WADA, I_BADA, I_GPREMIX, I_GPOSTMIX, I_GPREFFN, I_GPOSTFFN, I_WIN, I_WPOOL, I_SPOOLW, I_WDW, I_BDW, I_LNG, I_LNB, I_WSC, I_WOUT, I_WGATE, I_WUP, I_WDOWN };

__device__ __forceinline__ unsigned f2bf(float f) { unsigned u = __builtin_bit_cast(unsigned, f); return (u + 0x7fffu + ((u >> 16) & 1u)) >> 16; }
__device__ __forceinline__ unsigned pk2(float lo, float hi) { unsigned r; asm("v_cvt_pk_bf16_f32 %0, %1, %2" : "=v"(r) : "v"(lo), "v"(hi)); return r; }
__device__ __forceinline__ float bflo(unsigned u) { return __builtin_bit_cast(float, u << 16); }
__device__ __forceinline__ float bfhi(unsigned u) { return __builtin_bit_cast(float, u & 0xffff0000u); }
__device__ __forceinline__ float wave_sum(float v) {
#pragma unroll
    for (int o = 1; o < 64; o <<= 1) v += __shfl_xor(v, o);
    return v;
}
__device__ __forceinline__ float sigmoid_f(float g) { return __builtin_amdgcn_rcpf(1.0f + __builtin_amdgcn_exp2f(-1.44269504089f * g)); }
__device__ __forceinline__ float silu_acc(float g) { return g * __builtin_amdgcn_rcpf(1.0f + __builtin_amdgcn_exp2f(-1.44269504089f * g)); }


#define XB_TMO      128
#define XB_XCNT(j)  (256  + 64 * (j))
#define XB_XSUB(j)  (1280 + 64 * (j))
#define XB_XGEN(j)  (2304 + 64 * (j))
#define XB_TOP      3328
#define XB_TOPGEN   3392
#define XCD_BAR_WORDS 3456
#define XB_SPIN_CAP (1u << 22)
__device__ __forceinline__ unsigned xb_ld(unsigned* p)              { return __hip_atomic_load(p, __ATOMIC_RELAXED, __HIP_MEMORY_SCOPE_AGENT); }
__device__ __forceinline__ unsigned xb_add(unsigned* p, unsigned v) { return __hip_atomic_fetch_add(p, v, __ATOMIC_RELAXED, __HIP_MEMORY_SCOPE_AGENT); }
__device__ __forceinline__ unsigned xb_xcc_id() { return (unsigned)__builtin_amdgcn_s_getreg((3 << 11) | 20) & 0xFu; }
#define XB_SPIN(cond, bar) do { unsigned _sp = 0; while (cond) { __builtin_amdgcn_s_sleep(1); \
    if ((++_sp & 255u) == 0u) { if (xb_ld(&(bar)[XB_TMO])) break; if (_sp > XB_SPIN_CAP) { atomicAdd(&(bar)[XB_TMO], 1u); break; } } } } while (0)
struct XcdBarrier { unsigned* bar; unsigned x; volatile LAS unsigned* st; };
__device__ __forceinline__ XcdBarrier xcd_barrier_post(unsigned* bar, volatile LAS unsigned* st) {
    XcdBarrier b; b.bar = bar; b.x = xb_xcc_id(); b.st = st;
    if (threadIdx.x == 0) (void)xb_add(&bar[XB_XCNT(b.x)], 1u);
    return b;
}
__device__ __forceinline__ void xcd_barrier_complete(unsigned* bar, unsigned x, unsigned& nloc, unsigned& nx) {
    const unsigned G = gridDim.x * gridDim.y * gridDim.z;
    unsigned sum, cnt, mine, sp = 0u;
    for (;;) {
        sum = 0u; cnt = 0u; mine = 0u;
#pragma unroll
        for (unsigned j = 0; j < 16; ++j) { const unsigned c = xb_ld(&bar[XB_XCNT(j)]); sum += c; cnt += (c > 0u) ? 1u : 0u; mine = (j == x) ? c : mine; }
        if (sum == G) break;
        __builtin_amdgcn_s_sleep(1);
        if ((++sp & 255u) == 0u) { if (xb_ld(&bar[XB_TMO])) break; if (sp > XB_SPIN_CAP) { atomicAdd(&bar[XB_TMO], 1u); break; } }
    }
    nloc = mine > 0u ? mine : 1u; nx = cnt > 0u ? cnt : 1u;
}
__device__ __forceinline__ void xcd_barrier(const XcdBarrier& b) {
    asm volatile("s_waitcnt vmcnt(0)" ::: "memory");
    __syncthreads();
    if (threadIdx.x == 0) {
        unsigned* bar = b.bar;
        __builtin_amdgcn_s_waitcnt(0);
        unsigned nloc = b.st[0], nx = b.st[1];
        if (nloc == 0u) { xcd_barrier_complete(bar, b.x, nloc, nx); b.st[0] = nloc; b.st[1] = nx; }
        const unsigned old = xb_add(&bar[XB_XSUB(b.x)], 1u);
        const unsigned gen = old / nloc;
        if (old + 1u == (gen + 1u) * nloc) {
            __builtin_amdgcn_fence(__ATOMIC_RELEASE, "agent");
            asm volatile("s_waitcnt vmcnt(0)" ::: "memory");
            const unsigned og = xb_add(&bar[XB_TOP], 1u);
            const unsigned tg = og / nx;
            if (og + 1u == (tg + 1u) * nx) xb_add(&bar[XB_TOPGEN], 1u);
            else XB_SPIN(xb_ld(&bar[XB_TOPGEN]) == tg, bar);
            __builtin_amdgcn_fence(__ATOMIC_ACQUIRE, "agent");
            xb_add(&bar[XB_XGEN(b.x)], 1u);
            asm volatile("s_waitcnt vmcnt(0)" ::: "memory");
        } else {
            XB_SPIN(xb_ld(&bar[XB_XGEN(b.x)]) == gen, bar);
            __builtin_amdgcn_fence(__ATOMIC_ACQUIRE, "agent");
            asm volatile("s_waitcnt vmcnt(0)" ::: "memory");
        }
    }
    __syncthreads();
}

__device__ __forceinline__ void p0_transpose_item(const float* W, int N, bf16* WT, int Kp, int dest_row0, int k0, int n0, LAS float* scr, int lane) {
    float tv[32];
#pragma unroll
    for (int i = 0; i < 32; ++i) { const int kk = 2 * i + (lane >> 5); tv[i] = W[(size_t)(k0 + kk) * N + n0 + (lane & 31)]; }
#pragma unroll
    for (int i = 0; i < 32; ++i) { const int kk = 2 * i + (lane >> 5); scr[kk * 33 + (lane & 31)] = tv[i]; }
    asm volatile("s_waitcnt lgkmcnt(0)" ::: "memory");
    const int c = lane & 7;
#pragma unroll
    for (int j = 0; j < 4; ++j) { const int n = (lane >> 3) + 8 * j; const LAS float* s = scr + (8 * c) * 33 + n;
        u32x4 o; o.x = pk2(s[0 * 33], s[1 * 33]); o.y = pk2(s[2 * 33], s[3 * 33]); o.z = pk2(s[4 * 33], s[5 * 33]); o.w = pk2(s[6 * 33], s[7 * 33]);
        *(u32x4*)(WT + (size_t)(dest_row0 + n) * Kp + k0 + 8 * c) = o; }
    asm volatile("s_waitcnt lgkmcnt(0)" ::: "memory");
}

__device__ __forceinline__ void p0_prologue(const Args& a, LAS unsigned char* lds) {
    int tid = threadIdx.x; asm volatile("" : "+v"(tid));
    const int lane = tid & 63, wave = __builtin_amdgcn_readfirstlane(tid >> 6);
    LAS float* scr = (LAS float*)(lds + wave * 16384);
    const int gw = blockIdx.x * 8 + wave, NGW = gridDim.x * 8;
    constexpr int NMODWG = 192;
    float* modp = (float*)(a.ws + WS_PART);
    for (int wi = blockIdx.x; wi < NMODWG; wi += gridDim.x) {
        const int cb = wi % 96, l = wi / 96;
        LAS float* sc = (LAS float*)(lds + wave * 10240);
        float acc[NMODR];
#pragma unroll
        for (int r = 0; r < NMODR; ++r) acc[r] = 0.f;
        const float* wp = a.in[I_WADA] + (size_t)l * D * 6144 + cb * 64;
#pragma unroll 1
        for (int half = 0; half < 2; ++half) {
            const int kb = wave * 128 + half * 64;
            int ln = lane; asm volatile("" : "+v"(ln));
#pragma unroll 8
            for (int r = 0; r < NMODR; ++r) { const float cv = (r < NB) ? a.in[I_CP][r * D + kb + ln] : a.in[I_CS][(r - NB) * D + kb + ln]; sc[r * 64 + ln] = silu_acc(cv); }
            asm volatile("s_waitcnt lgkmcnt(0)" ::: "memory");
#pragma unroll 1
            for (int k0 = 0; k0 < 64; k0 += 16) {
                int ko = (kb + k0) * 6144 + lane; asm volatile("" : "+v"(ko));
                float w[16];
#pragma unroll
                for (int i = 0; i < 16; ++i) w[i] = wp[ko + i * 6144];
#pragma unroll
                for (int r = 0; r < NMODR; ++r) {
                    const LAS f32x4* sp = (const LAS f32x4*)(sc + r * 64 + k0);
                    const f32x4 s0 = sp[0], s1 = sp[1], s2 = sp[2], s3 = sp[3];
                    acc[r] += ((s0[0] * w[0] + s0[1] * w[1]) + (s0[2] * w[2] + s0[3] * w[3])) + ((s1[0] * w[4] + s1[1] * w[5]) + (s1[2] * w[6] + s1[3] * w[7]))
                            + ((s2[0] * w[8] + s2[1] * w[9]) + (s2[2] * w[10] + s2[3] * w[11])) + ((s3[0] * w[12] + s3[1] * w[13]) + (s3[2] * w[14] + s3[3] * w[15]));
                    if ((r & 1) == 1) asm volatile("" ::: "memory"); }
            }
            asm volatile("s_waitcnt lgkmcnt(0)" ::: "memory");
        }
#pragma unroll
        for (int r = 0; r < NMODR; ++r) sc[r * 64 + lane] = acc[r];
        __syncthreads();
        for (int o = tid; o < NMODR * 64; o += 512) { float v = a.in[I_BADA][l * 6144 + cb * 64 + (o & 63)];
#pragma unroll
            for (int w8 = 0; w8 < 8; ++w8) v += ((const LAS float*)lds)[w8 * 2560 + o];
            modp[((size_t)l * NMODR + (o >> 6)) * 6144 + cb * 64 + (o & 63)] = v; }
        __syncthreads();
    }
    constexpr int I_IN = 16 * (INW / 32), I_OUT = 16 * (D / 32), I_G = 16 * (DFF / 32), I_DN = (DFF / 64) * (D / 32), I_PADZ = 128;
    constexpr int PER_L = I_IN + I_OUT + 2 * I_G + I_DN + I_PADZ;
    unsigned* qctr = (unsigned*)a.ws + 3520;
    (void)gw; (void)NGW; int qbase = 0;
    for (int qi = 0;; ++qi) {
        int itb;
        if ((qi & 7) == 0) { unsigned itq = 0; if (lane == 0) { itq = __hip_atomic_load(qctr, __ATOMIC_RELAXED, __HIP_MEMORY_SCOPE_AGENT); if (itq < (unsigned)(2 * PER_L)) itq = atomicAdd(qctr, 8u); } itb = __builtin_amdgcn_readfirstlane((int)itq); qbase = itb; }
        const int it0 = qbase + (qi & 7);
        if (it0 >= 2 * PER_L) { if ((qi & 7) == 7 || qbase >= 2 * PER_L) break; else continue; }
        const int l = it0 / PER_L; int r = it0 % PER_L;
        bf16* wl = (bf16*)(a.ws + WS_W + (size_t)l * WL_SZ);
        if (r < I_IN) { const int nblk = INW / 32, kb = r / nblk, nb = r % nblk, n0 = nb * 32; int dr;
            if (n0 < 256) dr = n0;
            else if (n0 < 640) { const int j = n0 - 256; dr = 256 * (1 + (j >> 7)) + (j & 127); }
            else if (n0 < 1024) { const int j = n0 - 640; dr = 256 * (1 + (j >> 7)) + 128 + (j & 127); }
            else if (n0 < 1408) { const int j = n0 - 1024; dr = 256 * (4 + (j >> 7)) + (j & 127); }
            else if (n0 < 1792) { dr = 1792 + (n0 - 1408); }
            else { const int j = n0 - 1792; dr = 256 * (4 + (j >> 7)) + 128 + (j & 127); }
            p0_transpose_item(a.in[I_WIN] + (size_t)l * D * INW, INW, (bf16*)((char*)wl + WL_IN), D, dr, kb * 64, n0, scr, lane); continue; } r -= I_IN;
        if (r < I_OUT) { const int nblk = D / 32, kb = r / nblk, nb = r % nblk; p0_transpose_item(a.in[I_WOUT] + (size_t)l * D * D, D, (bf16*)((char*)wl + WL_OUT), D, nb * 32, kb * 64, nb * 32, scr, lane); continue; } r -= I_OUT;
        if (r < 2 * I_G) { const int up = r >= I_G; if (up) r -= I_G; const int nblk = DFF / 32, kb = r / nblk, nb = r % nblk, n0 = nb * 32;
            p0_transpose_item(a.in[up ? I_WUP : I_WGATE] + (size_t)l * D * DFF, DFF, (bf16*)((char*)wl + WL_GU), D, (n0 >> 7) * 256 + up * 128 + (n0 & 127), kb * 64, n0, scr, lane); continue; } r -= 2 * I_G;
        if (r < I_DN) { const int nblk = D / 32, kb = r / nblk, nb = r % nblk; p0_transpose_item(a.in[I_WDOWN] + (size_t)l * DFF * D, D, (bf16*)((char*)wl + WL_DN), DFF, nb * 32, kb * 64, nb * 32, scr, lane); continue; } r -= I_DN;
        { u32x4* z = (u32x4*)((char*)wl + WL_IN + (size_t)(INW + r) * D * 2); z[lane] = (u32x4){0u, 0u, 0u, 0u}; z[lane + 64] = (u32x4){0u, 0u, 0u, 0u}; }
    }
}

__device__ __forceinline__ void load_mod(const Args& a, int l, int r, int which, int lane, f32x4 (&v)[4]) {
    const float* modp = (const float*)(a.ws + WS_PART) + ((size_t)l * NMODR + r) * 6144 + which * 1024;
#pragma unroll
    for (int j = 0; j < 4; ++j) v[j] = *(const f32x4*)(modp + 256 * j + 4 * lane);
}
__device__ __forceinline__ void load_vec(const float* g, int lane, f32x4 (&v)[4]) {
#pragma unroll
    for (int j = 0; j < 4; ++j) v[j] = *(const f32x4*)(g + 256 * j + 4 * lane);
}
template <int MODE, bool XBF>
__device__ __forceinline__ void rows_do(const float* xin, const bf16* xinb, float* xout, bf16* xoutb, const bf16* Y, bf16* H, int nrows, const f32x4 (&GB)[4], const f32x4 (&GA)[4], const f32x4 (&SH)[4], int lane) {
    constexpr int R = (MODE == 0) ? 3 : 2;
    f32x4 xcf[R][4], xnf[R][4]; u32x2 xcb[R][4], xnb[R][4], yc[R][4], yn[R][4];
#pragma unroll
    for (int rr = 0; rr < R; ++rr) { const int ir = (rr < nrows) ? rr : nrows - 1;
#pragma unroll
        for (int j = 0; j < 4; ++j) {
            if (XBF) xcb[rr][j] = *(const u32x2*)(xinb + (size_t)ir * D + 256 * j + 4 * lane); else xcf[rr][j] = *(const f32x4*)(xin + (size_t)ir * D + 256 * j + 4 * lane);
            if (MODE != 0) yc[rr][j] = *(const u32x2*)(Y + (size_t)ir * D + 256 * j + 4 * lane); } }
    for (int i = 0; i < nrows; i += R) {
#pragma unroll
        for (int rr = 0; rr < R; ++rr) { const int ip = (i + R + rr < nrows) ? i + R + rr : nrows - 1;
#pragma unroll
            for (int j = 0; j < 4; ++j) {
                if (XBF) xnb[rr][j] = *(const u32x2*)(xinb + (size_t)ip * D + 256 * j + 4 * lane); else xnf[rr][j] = *(const f32x4*)(xin + (size_t)ip * D + 256 * j + 4 * lane);
                if (MODE != 0) yn[rr][j] = *(const u32x2*)(Y + (size_t)ip * D + 256 * j + 4 * lane); } }
        f32x4 x[R][4];
#pragma unroll
        for (int rr = 0; rr < R; ++rr)
#pragma unroll
            for (int j = 0; j < 4; ++j) { if (XBF) x[rr][j] = (f32x4){bflo(xcb[rr][j].x), bfhi(xcb[rr][j].x), bflo(xcb[rr][j].y), bfhi(xcb[rr][j].y)}; else x[rr][j] = xcf[rr][j]; }
        if (MODE != 0) {
            f32x4 y[R][4]; float ss[R];
#pragma unroll
            for (int rr = 0; rr < R; ++rr) { ss[rr] = 0.f;
#pragma unroll
                for (int j = 0; j < 4; ++j) { y[rr][j] = (f32x4){bflo(yc[rr][j].x), bfhi(yc[rr][j].x), bflo(yc[rr][j].y), bfhi(yc[rr][j].y)}; ss[rr] += (y[rr][j][0] * y[rr][j][0] + y[rr][j][1] * y[rr][j][1]) + (y[rr][j][2] * y[rr][j][2] + y[rr][j][3] * y[rr][j][3]); } }
#pragma unroll
            for (int o = 1; o < 64; o <<= 1) {
#pragma unroll
                for (int rr = 0; rr < R; ++rr) ss[rr] += __shfl_xor(ss[rr], o); }
#pragma unroll
            for (int rr = 0; rr < R; ++rr) { const float rs = __builtin_amdgcn_rsqf(ss[rr] * (1.0f / D) + EPS);
#pragma unroll
                for (int j = 0; j < 4; ++j) x[rr][j] += GB[j] * (y[rr][j] * rs); }
        }
        float rs2[R];
        if (MODE != 2) {
            float ss[R];
#pragma unroll
            for (int rr = 0; rr < R; ++rr) { ss[rr] = 0.f;
#pragma unroll
                for (int j = 0; j < 4; ++j) ss[rr] += (x[rr][j][0] * x[rr][j][0] + x[rr][j][1] * x[rr][j][1]) + (x[rr][j][2] * x[rr][j][2] + x[rr][j][3] * x[rr][j][3]); }
#pragma unroll
            for (int o = 1; o < 64; o <<= 1) {
#pragma unroll
                for (int rr = 0; rr < R; ++rr) ss[rr] += __shfl_xor(ss[rr], o); }
#pragma unroll
            for (int rr = 0; rr < R; ++rr) rs2[rr] = __builtin_amdgcn_rsqf(ss[rr] * (1.0f / D) + EPS);
        }
#pragma unroll
        for (int rr = 0; rr < R; ++rr) {
            const int ir = (i + rr < nrows) ? i + rr : nrows - 1;
#pragma unroll
            for (int j = 0; j < 4; ++j) {
                if (MODE == 2) *(f32x4*)(xout + (size_t)ir * D + 256 * j + 4 * lane) = x[rr][j];
                if (MODE == 1) { u32x2 o; o.x = pk2(x[rr][j][0], x[rr][j][1]); o.y = pk2(x[rr][j][2], x[rr][j][3]); *(u32x2*)(xoutb + (size_t)ir * D + 256 * j + 4 * lane) = o; }
                if (MODE != 2) { const f32x4 h = (x[rr][j] * rs2[rr]) * GA[j] + SH[j]; u32x2 o; o.x = pk2(h[0], h[1]); o.y = pk2(h[2], h[3]); *(u32x2*)(H + (size_t)ir * D + 256 * j + 4 * lane) = o; }
            }
        }
#pragma unroll
        for (int rr = 0; rr < R; ++rr)
#pragma unroll
            for (int j = 0; j < 4; ++j) { if (XBF) xcb[rr][j] = xnb[rr][j]; else xcf[rr][j] = xnf[rr][j]; if (MODE != 0) yc[rr][j] = yn[rr][j]; }
    }
}
template <int MODE>
__device__ __forceinline__ void row_phase(const Args& a, bool x_from_input, int lb, int wgt, const float* gpost, int lh, int wsh, const float* gpre) {
    int tid = threadIdx.x; asm volatile("" : "+v"(tid));
    const int lane = tid & 63, wave = __builtin_amdgcn_readfirstlane(tid >> 6);
    const int gw = blockIdx.x * 8 + wave, NGW = gridDim.x * 8;
    const bf16* Y = (const bf16*)(a.ws + WS_Y); bf16* H = (bf16*)(a.ws + WS_H); bf16* XB = (bf16*)(a.ws + WS_XB);
    const int nchunk = MP / 32 + MS;
    for (int ch = gw; ch < nchunk; ch += NGW) {
        int row0, nrows, r;
        if (ch < MP / 32) { row0 = ch * 32; nrows = 32; r = row0 / T_P; } else { const int j = ch - MP / 32; row0 = MP + j; nrows = 1; r = NB + j / T_S; }
        f32x4 GB[4], GA[4], SH[4];
        if (MODE != 0) { f32x4 gt[4], gp[4]; load_mod(a, lb, r, wgt, lane, gt); load_vec(gpost, lane, gp);
#pragma unroll
            for (int j = 0; j < 4; ++j) GB[j] = gt[j] * gp[j]; }
        if (MODE != 2) { f32x4 sc[4], gp[4]; load_mod(a, lh, r, wsh + 1, lane, sc); load_mod(a, lh, r, wsh, lane, SH); load_vec(gpre, lane, gp);
#pragma unroll
            for (int j = 0; j < 4; ++j) GA[j] = gp[j] * (1.0f + sc[j]); }
        const float* xin = (row0 < MP ? a.in[I_XP] + (size_t)row0 * D : a.in[I_XS] + (size_t)(row0 - MP) * D);
        if (MODE == 0 || (MODE == 1 && x_from_input)) rows_do<MODE, false>(xin, XB + (size_t)row0 * D, a.out + (size_t)row0 * D, XB + (size_t)row0 * D, Y + (size_t)row0 * D, H + (size_t)row0 * D, nrows, GB, GA, SH, lane);
        else rows_do<(MODE == 0 ? 1 : MODE), true>(xin, XB + (size_t)row0 * D, a.out + (size_t)row0 * D, XB + (size_t)row0 * D, Y + (size_t)row0 * D, H + (size_t)row0 * D, nrows, GB, GA, SH, lane);
    }
}

template <int N, int SZ>
__device__ __forceinline__ void tr_reduce_step(float (&v)[SZ], int lane) {
    constexpr int Hh = N / 2;
    const bool up = (lane & Hh) != 0;
#pragma unroll
    for (int i = 0; i < Hh; ++i) { const float send = up ? v[i] : v[i + Hh]; const float keep = up ? v[i + Hh] : v[i]; v[i] = keep + __shfl_xor(send, Hh); }
}
template <int R, int N> struct ConvLoop {
    static __device__ __forceinline__ void run(f32x2 (&z)[32], const f32x2 (&w)[31], const LAS unsigned* up) {
        const unsigned v = up[R * 192]; const f32x2 uv = {bflo(v), bfhi(v)};
#pragma unroll
        for (int i = (R - 30 > 0 ? R - 30 : 0); i <= (R < 31 ? R : 31); ++i) z[i] += w[R - i] * uv;
        if ((R & 7) == 7) asm volatile("" ::: "memory");
        ConvLoop<R + 1, N>::run(z, w, up);
    }
};
template <int N> struct ConvLoop<N, N> { static __device__ __forceinline__ void run(f32x2 (&)[32], const f32x2 (&)[31], const LAS unsigned*) {} };

constexpr int MIX_UC = 0, MIX_XA = 73728, XA_PITCH = 528, MIX_ST = MIX_XA + 79 * XA_PITCH;
static_assert(MIX_ST + 6 * 64 * 4 <= 131072, "mixer LDS");

__device__ __forceinline__ void mixer_phase(const Args& a, int l, LAS unsigned char* lds, int mode = 7) {
    const bf16* P = (const bf16*)(a.ws + WS_P); bf16* CAT = (bf16*)(a.ws + WS_CAT);
    LAS bf16* Uc = (LAS bf16*)(lds + MIX_UC);
    LAS unsigned char* XaB = lds + MIX_XA;
    LAS float* ST = (LAS float*)(lds + MIX_ST);
    const int NU = MP / 64 + NDB;
    for (int u = blockIdx.x; u < NU; u += gridDim.x) {
        int tid = threadIdx.x; asm volatile("" : "+v"(tid));
        const int lane = tid & 63, wave = __builtin_amdgcn_readfirstlane(tid >> 6);
        int rowbase, T, t0, start, b; bool smp;
        if (u < MP / 64) {
            int uu = u;
            if (gridDim.x == 256) { const int k_ = u >> 8, c_ = u & 255; uu = (8 * k_ + (c_ & 7)) * 32 + (((c_ >> 3) + 8 * k_) & 31); }
            b = uu / 32; t0 = (uu % 32) * 64; T = T_P; start = 0; rowbase = b * T_P; smp = false; }
        else { b = u - MP / 64; t0 = 0; T = T_S; start = PASTLEN; rowbase = MP + b * T_S; smp = true; }
        const int nbat = smp ? NDB : NB;
        float* pool_out = a.out + (smp ? O_POOLS : O_POOLP) + ((size_t)l * nbat + b) * 15 * 256;
        float* conv_out = a.out + (smp ? O_CONVS : O_CONVP) + ((size_t)l * nbat + b) * 30 * 384;
        float* sc_out = a.out + (smp ? O_SCS : O_SCP) + ((size_t)l * nbat + b) * 2 * 384;
        const float* st_pool = a.in[I_SPOOL] + ((size_t)l * NDB + b) * 15 * 256;
        const float* st_conv = a.in[I_SCONV] + ((size_t)l * NDB + b) * 30 * 384;
        const float* st_sc = a.in[I_SSC] + ((size_t)l * NDB + b) * 2 * 384;
        const int seg = tid / 48, oc = tid - seg * 48, cc = oc * 8;
        u32x4 va[12], vb[5];
        if (tid < 384) {
#pragma unroll
            for (int q = 0; q < 12; ++q) { const int r = seg + 8 * q, t = t0 - 30 + r;
                va[q] = (u32x4){0u, 0u, 0u, 0u};
                if (r < 94 && t >= 0 && t < T) va[q] = *(const u32x4*)(P + (size_t)(rowbase + t) * P2W + 256 + cc); }
        }
#pragma unroll
        for (int q = 0; q < 5; ++q) { const int i = tid + 512 * q, r = i >> 5, o = i & 31, t = t0 - 15 + r;
            vb[q] = (u32x4){0u, 0u, 0u, 0u};
            if (i < 79 * 32 && t >= 0 && t < T) vb[q] = *(const u32x4*)(P + (size_t)(rowbase + t) * P2W + o * 8); }
        if (smp) {
            if (tid < 384) {
#pragma unroll
                for (int q = 0; q < 4; ++q) { const int r = seg + 8 * q, t = r - 30;
                    if (t < 0) { const f32x4 p0 = *(const f32x4*)(st_conv + (30 + t) * 384 + cc), p1 = *(const f32x4*)(st_conv + (30 + t) * 384 + cc + 4);
                        va[q].x = pk2(p0[0], p0[1]); va[q].y = pk2(p0[2], p0[3]); va[q].z = pk2(p1[0], p1[1]); va[q].w = pk2(p1[2], p1[3]); } }
            }
#pragma unroll
            for (int q = 0; q < 1; ++q) { const int i = tid, r = i >> 5, o = i & 31, t = r - 15, c = o * 8;
                if (t < 0) { const f32x4 p0 = *(const f32x4*)(st_pool + (15 + t) * 256 + c), p1 = *(const f32x4*)(st_pool + (15 + t) * 256 + c + 4);
                    vb[q].x = pk2(p0[0], p0[1]); vb[q].y = pk2(p0[2], p0[3]); vb[q].z = pk2(p1[0], p1[1]); vb[q].w = pk2(p1[2], p1[3]); } }
        }
        if (tid < 384) {
#pragma unroll
            for (int q = 0; q < 12; ++q) { const int r = seg + 8 * q; if (r < 94) *(LAS u32x4*)(Uc + r * 384 + cc) = va[q]; }
        }
#pragma unroll
        for (int q = 0; q < 5; ++q) { const int i = tid + 512 * q, r = i >> 5, o = i & 31; if (i < 79 * 32) *(LAS u32x4*)(XaB + r * XA_PITCH + o * 16) = vb[q]; }
        if (t0 + 64 >= T && !smp) {
            u32x4 cw[3], pw, sw;
#pragma unroll
            for (int q = 0; q < 3; ++q) { const int i = tid + 512 * q, sr = i / 48, o = i - sr * 48; cw[q] = (u32x4){0u, 0u, 0u, 0u};
                if (i < 30 * 48) cw[q] = *(const u32x4*)(P + (size_t)(rowbase + T - 30 + sr) * P2W + 256 + o * 8); }
            pw = (u32x4){0u, 0u, 0u, 0u}; sw = (u32x4){0u, 0u, 0u, 0u};
            if (tid < 15 * 32) pw = *(const u32x4*)(P + (size_t)(rowbase + T - 15 + (tid >> 5)) * P2W + (tid & 31) * 8);
            if (tid < 2 * 48) sw = *(const u32x4*)(P + (size_t)(rowbase + T - 2 + tid / 48) * P2W + 640 + (tid % 48) * 8);
#pragma unroll
            for (int q = 0; q < 3; ++q) { const int i = tid + 512 * q, sr = i / 48, o = i - sr * 48; const u32x4 w = cw[q];
                if (i < 30 * 48) { float* d = conv_out + sr * 384 + o * 8; *(f32x4*)d = (f32x4){bflo(w.x), bfhi(w.x), bflo(w.y), bfhi(w.y)}; *(f32x4*)(d + 4) = (f32x4){bflo(w.z), bfhi(w.z), bflo(w.w), bfhi(w.w)}; } }
            if (tid < 15 * 32) { float* d = pool_out + (tid >> 5) * 256 + (tid & 31) * 8; *(f32x4*)d = (f32x4){bflo(pw.x), bfhi(pw.x), bflo(pw.y), bfhi(pw.y)}; *(f32x4*)(d + 4) = (f32x4){bflo(pw.z), bfhi(pw.z), bflo(pw.w), bfhi(pw.w)}; }
            if (tid < 2 * 48) { float* d = sc_out + (tid / 48) * 384 + (tid % 48) * 8; *(f32x4*)d = (f32x4){bflo(sw.x), bfhi(sw.x), bflo(sw.y), bfhi(sw.y)}; *(f32x4*)(d + 4) = (f32x4){bflo(sw.z), bfhi(sw.z), bflo(sw.w), bfhi(sw.w)}; }
        } else if (t0 + 64 >= T) {
            for (int i = tid; i < 30 * 48; i += 512) { const int sr = i / 48, o = i - sr * 48, t = T - 30 + sr, c = o * 8; float* d = conv_out + sr * 384 + c;
                if (t >= 0) { const u32x4 w = *(const u32x4*)(P + (size_t)(rowbase + t) * P2W + 256 + c);
                    *(f32x4*)d = (f32x4){bflo(w.x), bfhi(w.x), bflo(w.y), bfhi(w.y)}; *(f32x4*)(d + 4) = (f32x4){bflo(w.z), bfhi(w.z), bflo(w.w), bfhi(w.w)}; }
                else { *(f32x4*)d = *(const f32x4*)(st_conv + (30 + t) * 384 + c); *(f32x4*)(d + 4) = *(const f32x4*)(st_conv + (30 + t) * 384 + c + 4); } }
            for (int i = tid; i < 15 * 32; i += 512) { const int sr = i >> 5, o = i & 31, t = T - 15 + sr, c = o * 8; float* d = pool_out + sr * 256 + c;
                if (t >= 0) { const u32x4 w = *(const u32x4*)(P + (size_t)(rowbase + t) * P2W + c);
                    *(f32x4*)d = (f32x4){bflo(w.x), bfhi(w.x), bflo(w.y), bfhi(w.y)}; *(f32x4*)(d + 4) = (f32x4){bflo(w.z), bfhi(w.z), bflo(w.w), bfhi(w.w)}; }
                else { *(f32x4*)d = *(const f32x4*)(st_pool + (15 + t) * 256 + c); *(f32x4*)(d + 4) = *(const f32x4*)(st_pool + (15 + t) * 256 + c + 4); } }
            for (int i = tid; i < 2 * 48; i += 512) { const int sr = i / 48, o = i - sr * 48, t = T - 2 + sr, c = o * 8; float* d = sc_out + sr * 384 + c;
                const u32x4 w = *(const u32x4*)(P + (size_t)(rowbase + t) * P2W + 640 + c);
                *(f32x4*)d = (f32x4){bflo(w.x), bfhi(w.x), bflo(w.y), bfhi(w.y)}; *(f32x4*)(d + 4) = (f32x4){bflo(w.z), bfhi(w.z), bflo(w.w), bfhi(w.w)}; }
        }
        if (tid < 384) {
            float w0[8], w1[8], w2[8];
            { const float* ws = a.in[I_WSC] + (size_t)l * 3 * 384 + cc;
#pragma unroll
              for (int e = 0; e < 8; ++e) { w0[e] = ws[e]; w1[e] = ws[384 + e]; w2[e] = ws[768 + e]; } }
            float up2[8], up1[8];
#pragma unroll
            for (int ps = 0; ps < 2; ++ps) {
                u32x4 vu[6], vg[4];
#pragma unroll
                for (int d = (ps ? 2 : 0); d < 6; ++d) { const int t = t0 + 8 * seg + 4 * ps + d - 2; vu[d] = (u32x4){0u, 0u, 0u, 0u};
                    if (t >= 0 && t < T) vu[d] = *(const u32x4*)(P + (size_t)(rowbase + t) * P2W + 640 + cc); }
#pragma unroll
                for (int d = 0; d < 4; ++d) { const int t = t0 + 8 * seg + 4 * ps + d; vg[d] = (u32x4){0u, 0u, 0u, 0u};
                    if (t < T) vg[d] = *(const u32x4*)(P + (size_t)(rowbase + t) * P2W + 1024 + cc); }
#pragma unroll
                for (int d = (ps ? 2 : 0); d < 6; ++d) {
                    const int t = t0 + 8 * seg + 4 * ps + d - 2;
                    float uc[8];
#pragma unroll
                    for (int e = 0; e < 4; ++e) { uc[2 * e] = bflo(vu[d][e]); uc[2 * e + 1] = bfhi(vu[d][e]); }
                    if (ps == 0 && d < 2 && smp && t < 0) { const f32x4 p0 = *(const f32x4*)(st_sc + (2 + t) * 384 + cc), p1 = *(const f32x4*)(st_sc + (2 + t) * 384 + cc + 4);
#pragma unroll
                        for (int e = 0; e < 4; ++e) { uc[e] = p0[e]; uc[4 + e] = p1[e]; } }
                    if (d >= 2) {
                        const u32x4 bv = vg[d - 2];
                        float y[8];
#pragma unroll
                        for (int e = 0; e < 4; ++e) {
                            y[2 * e] = bflo(bv[e]) * (w0[2 * e] * up2[2 * e] + w1[2 * e] * up1[2 * e] + w2[2 * e] * uc[2 * e]);
                            y[2 * e + 1] = bfhi(bv[e]) * (w0[2 * e + 1] * up2[2 * e + 1] + w1[2 * e + 1] * up1[2 * e + 1] + w2[2 * e + 1] * uc[2 * e + 1]); }
                        { u32x4 w; w.x = pk2(y[0], y[1]); w.y = pk2(y[2], y[3]); w.z = pk2(y[4], y[5]); w.w = pk2(y[6], y[7]);
                          *(u32x4*)(CAT + (size_t)(t < T ? rowbase + t : MR + (t & 63)) * D + 640 + cc) = w; }
                    }
#pragma unroll
                    for (int e = 0; e < 8; ++e) { if (ps == 1 || d >= 1) up2[e] = up1[e]; up1[e] = uc[e]; }
                }
            }
        }
        __syncthreads();
        f32x2 z[32];
        int tid2 = tid; asm volatile("" : "+v"(tid2));
        const int half = (tid2 >= 192) ? 1 : 0, p = tid2 - 192 * half;
        const bool rows_live = (t0 + 32 * half) < T;
        if (wave < 6 && (mode & 2) && rows_live) {
            f32x2 w[31];
            const float* wd = a.in[I_WDW] + (size_t)l * 31 * 384 + 2 * p;
#pragma unroll
            for (int j = 0; j < 31; ++j) w[j] = *(const f32x2*)(wd + j * 384);
            const f32x2 bb = *(const f32x2*)(a.in[I_BDW] + l * 384 + 2 * p);
#pragma unroll
            for (int i = 0; i < 32; ++i) z[i] = bb;
            const LAS unsigned* up = (const LAS unsigned*)Uc + (32 * half) * 192 + p;
            ConvLoop<0, 62>::run(z, w, up);
            float sv[32];
            { const bool up = (lane & 32) != 0;
#pragma unroll
              for (int i = 0; i < 32; ++i) { const f32x2 zl = z[i >> 1], zh = z[16 + (i >> 1)];
                  const float va_ = (i & 1) ? (zl[0] * zl[0] + zl[1] * zl[1]) : (zl[0] + zl[1]), vb_ = (i & 1) ? (zh[0] * zh[0] + zh[1] * zh[1]) : (zh[0] + zh[1]);
                  const float send = up ? va_ : vb_, keep = up ? vb_ : va_; sv[i] = keep + __shfl_xor(send, 32);
                  if ((i & 7) == 7) asm volatile("" ::: "memory"); } }
            tr_reduce_step<32>(sv, lane); tr_reduce_step<16>(sv, lane); tr_reduce_step<8>(sv, lane); tr_reduce_step<4>(sv, lane); tr_reduce_step<2>(sv, lane);
            ST[wave * 64 + lane] = sv[0];
        } else if (mode & 2) {
            const int fr = tid2 & 15, fq = (tid2 & 63) >> 4;
#pragma unroll 1
            for (int gi = 0; gi < 2; ++gi) {
                const int g = (wave == 6) ? (gi ? 3 : 0) : (gi ? 2 : 1), win = 2 << g;
                bf16x8 Wf[4][2];
#pragma unroll
                for (int nt = 0; nt < 4; ++nt)
#pragma unroll
                    for (int kk = 0; kk < 2; ++kk) { const float* wp = a.in[I_WPOOL] + (((size_t)l * 4 + g) * 64 + 32 * kk + 8 * fq) * 64 + 16 * nt + fr;
                        u32x4 q; q.x = pk2(wp[0], wp[64]); q.y = pk2(wp[128], wp[192]); q.z = pk2(wp[256], wp[320]); q.w = pk2(wp[384], wp[448]);
                        Wf[nt][kk] = __builtin_bit_cast(bf16x8, q); }
                f32x4 spv[4];
#pragma unroll
                for (int nt = 0; nt < 4; ++nt) spv[nt] = *(const f32x4*)(a.in[I_SPOOLW] + l * 256 + 64 * g + 16 * nt + 4 * fq);
#pragma unroll 1
                for (int mt = 0; mt < 4; ++mt) {
                    if (t0 + 16 * mt >= T) break;
                    const int i = 16 * mt + fr, r = i + 15;
                    const int pos = t0 + i + start; const float cnt = (float)((pos + 1 < win) ? pos + 1 : win); const float inv = 1.0f / cnt;
                    bf16x8 Af[2];
#pragma unroll
                    for (int kk = 0; kk < 2; ++kk) {
                        const LAS unsigned char* base = XaB + r * XA_PITCH + (64 * g + 32 * kk + 8 * fq) * 2;
                        float s[8];
#pragma unroll
                        for (int e = 0; e < 8; ++e) s[e] = 0.f;
                        for (int d = 0; d < win; ++d) { const u32x4 v = *(const LAS u32x4*)(base - d * XA_PITCH);
#pragma unroll
                            for (int e = 0; e < 4; ++e) { s[2 * e] += bflo(v[e]); s[2 * e + 1] += bfhi(v[e]); } }
                        const u32x4 cv = *(const LAS u32x4*)base;
                        u32x4 q;
#pragma unroll
                        for (int e = 0; e < 4; ++e) q[e] = pk2(s[2 * e] * inv - bflo(cv[e]), s[2 * e + 1] * inv - bfhi(cv[e]));
                        Af[kk] = __builtin_bit_cast(bf16x8, q);
                    }
                    const bool valid = (t0 + i) < T;
#pragma unroll
                    for (int nt = 0; nt < 4; ++nt) {
                        f32x4 acc = {0.f, 0.f, 0.f, 0.f};
                        acc = __builtin_amdgcn_mfma_f32_16x16x32_bf16(Wf[nt][0], Af[0], acc, 0, 0, 0);
                        acc = __builtin_amdgcn_mfma_f32_16x16x32_bf16(Wf[nt][1], Af[1], acc, 0, 0, 0);
                        const f32x4 sp = spv[nt];
                        u32x2 o; o.x = pk2(acc[0] * sp[0], acc[1] * sp[1]); o.y = pk2(acc[2] * sp[2], acc[3] * sp[3]);
                        *(u32x2*)(CAT + (size_t)(valid ? rowbase + t0 + i : MR + i) * D + 64 * g + 16 * nt + 4 * fq) = o;
                    }
                }
            }
        }
        __syncthreads();
        if (wave < 6 && (mode & 4) && rows_live) {
            f32x2 lg = *(const f32x2*)(a.in[I_LNG] + l * 384 + 2 * p), lb = *(const f32x2*)(a.in[I_LNB] + l * 384 + 2 * p);
            asm volatile("" : "+v"(lg), "+v"(lb));
            const float tot = ST[(3 * half) * 64 + lane] + ST[(3 * half + 1) * 64 + lane] + ST[(3 * half + 2) * 64 + lane];
            const float oth = __shfl_xor(tot, 1);
            const float s1 = (lane & 1) ? oth : tot, s2 = (lane & 1) ? tot : oth;
            const float mu_l = s1 * (1.0f / 384.0f); float var_l = s2 * (1.0f / 384.0f) - mu_l * mu_l; var_l = var_l > 0.f ? var_l : 0.f;
            const float rstd_l = __builtin_amdgcn_rsqf(var_l + EPS);
            const int trow = t0 + 32 * half;
            bf16* crow = CAT + (size_t)(rowbase + trow) * D + 256 + 2 * p;
            bf16* cdummy = CAT + (size_t)(MR + 32 * half) * D + 256 + 2 * p;
#pragma unroll
            for (int i = 0; i < 32; ++i) {
                const float mu = __builtin_bit_cast(float, __builtin_amdgcn_readlane(__builtin_bit_cast(int, mu_l), 2 * i));
                const float rstd = __builtin_bit_cast(float, __builtin_amdgcn_readlane(__builtin_bit_cast(int, rstd_l), 2 * i));
                const f32x2 sc2 = lg * rstd, of2 = lb - sc2 * mu;
                const f32x2 y = z[i] * sc2 + of2;
                *(unsigned*)((trow + i < T ? crow + (size_t)i * D : cdummy + (size_t)i * D)) = pk2(y[0] * sigmoid_f(y[0]), y[1] * sigmoid_f(y[1]));
            }
        }
    }
    __syncthreads();
}


__device__ __forceinline__ void sample_gemm(int kind, const bf16* A, const bf16* Bt, int NT, int K, bf16* O, int ldc) {
    int tid = threadIdx.x; asm volatile("" : "+v"(tid));
    const int lane = tid & 63, wave = __builtin_amdgcn_readfirstlane(tid >> 6), fr = lane & 15, fq = lane >> 4;
    const int gw = blockIdx.x * 8 + wave, NGW = gridDim.x * 8, ntask = NT * 64;
    for (int task = gw; task < ntask; task += NGW) {
        const int mt = task & 7, sb = (task >> 3) & 7, pn = task >> 6;
        const bf16* ap = A + (size_t)(mt * 16 + fr) * K + 8 * fq;
        const bf16* bp0 = Bt + (size_t)(256 * pn + 16 * sb + fr) * K + 8 * fq;
        const bf16* bp1 = bp0 + (size_t)128 * K;
        f32x4 acc0 = {0.f, 0.f, 0.f, 0.f}, acc1 = {0.f, 0.f, 0.f, 0.f};
        bf16x8 fa[4], fb0[4], fb1[4], ga[4], gb0[4], gb1[4];
#pragma unroll
        for (int j = 0; j < 4; ++j) { fa[j] = *(const bf16x8*)(ap + 32 * j); fb0[j] = *(const bf16x8*)(bp0 + 32 * j); fb1[j] = *(const bf16x8*)(bp1 + 32 * j); }
#pragma unroll 1
        for (int k0 = 0; k0 < K; k0 += 256) {
#pragma unroll
            for (int j = 0; j < 4; ++j) { ga[j] = *(const bf16x8*)(ap + k0 + 128 + 32 * j); gb0[j] = *(const bf16x8*)(bp0 + k0 + 128 + 32 * j); gb1[j] = *(const bf16x8*)(bp1 + k0 + 128 + 32 * j); }
#pragma unroll
            for (int j = 0; j < 4; ++j) { acc0 = __builtin_amdgcn_mfma_f32_16x16x32_bf16(fb0[j], fa[j], acc0, 0, 0, 0); acc1 = __builtin_amdgcn_mfma_f32_16x16x32_bf16(fb1[j], fa[j], acc1, 0, 0, 0); }
            const int kn = (k0 + 256 < K) ? k0 + 256 : k0;
#pragma unroll
            for (int j = 0; j < 4; ++j) { fa[j] = *(const bf16x8*)(ap + kn + 32 * j); fb0[j] = *(const bf16x8*)(bp0 + kn + 32 * j); fb1[j] = *(const bf16x8*)(bp1 + kn + 32 * j); }
#pragma unroll
            for (int j = 0; j < 4; ++j) { acc0 = __builtin_amdgcn_mfma_f32_16x16x32_bf16(gb0[j], ga[j], acc0, 0, 0, 0); acc1 = __builtin_amdgcn_mfma_f32_16x16x32_bf16(gb1[j], ga[j], acc1, 0, 0, 0); }
        }
        bf16* orow = O + (size_t)(mt * 16 + fr) * ldc + 16 * sb + 4 * fq;
        int mode = 0, col = 256 * pn;
        if (kind == 0) { if (pn == 0) col = 0; else if (pn >= 7) { col = 1024 + (pn - 7) * 256; if (pn == 8) mode = 1; } else if (pn <= 3) { mode = 2; col = 256 + (pn - 1) * 128; } else { mode = 3; col = 640 + (pn - 4) * 128; } }
        else if (kind == 2) { mode = 4; col = 128 * pn; }
        if (mode <= 1) {
            u32x2 o; o.x = pk2(acc0[0], acc0[1]); o.y = pk2(acc0[2], acc0[3]); *(u32x2*)(orow + col) = o;
            if (mode == 0) { u32x2 q; q.x = pk2(acc1[0], acc1[1]); q.y = pk2(acc1[2], acc1[3]); *(u32x2*)(orow + col + 128) = q; }
        } else {
            f32x4 r;
#pragma unroll
            for (int e = 0; e < 4; ++e) r[e] = (mode == 2) ? acc0[e] * sigmoid_f(acc1[e]) : (mode == 3) ? acc0[e] * acc1[e] : acc0[e] * sigmoid_f(acc0[e]) * acc1[e];
            u32x2 o; o.x = pk2(r[0], r[1]); o.y = pk2(r[2], r[3]); *(u32x2*)(orow + col) = o;
        }
    }
}

constexpr int NPH = 16;
__global__ void __launch_bounds__(512) mega_fwd(Args a) {
    extern __shared__ __attribute__((aligned(16))) unsigned char lds_raw[];
    LAS unsigned char* lds = (LAS unsigned char*)lds_raw;
    cg::grid_group grid = cg::this_grid();
#if ONE_LAUNCH
    volatile LAS unsigned* xst = (volatile LAS unsigned*)(lds + 131072 + 256);
    if (threadIdx.x < 2) xst[threadIdx.x] = 0u;
    __syncthreads();
    const XcdBarrier xbar = xcd_barrier_post((unsigned*)a.ws, xst);
#endif
    bf16* H = (bf16*)(a.ws + WS_H); bf16* Y = (bf16*)(a.ws + WS_Y); bf16* P = (bf16*)(a.ws + WS_P); bf16* CAT = (bf16*)(a.ws + WS_CAT); bf16* ACT = (bf16*)(a.ws + WS_ACT);
#ifdef SYNC_PROBE
    for (int i_ = 0; i_ < SYNC_PROBE; ++i_) grid.sync();
#endif
    for (int ph = a.ph_lo; ph < a.ph_hi; ++ph) {
#ifdef DUP_MASK
      const int kk_ = ph < 2 ? ph + 7 : (ph - 2) % 7;
      const int nrep_ = ((DUP_MASK >> kk_) & 1) ? 2 : 1;
      for (int rep_ = 0; rep_ < nrep_; ++rep_) {
        if (rep_) grid.sync();
#endif
        if (ph == 0) {
#ifndef SKIP_P0
            p0_prologue(a, lds);
#endif
        }
        else if (ph == 1) {
#ifndef SKIP_ROW
            row_phase<0>(a, true, 0, 0, nullptr, 0, 0, a.in[I_GPREMIX]);
#endif
        }
        else {
            const int l = (ph - 2) / 7, k = (ph - 2) % 7;
            const unsigned char* wl = a.ws + WS_W + (size_t)l * WL_SZ;
            if (k == 0 || k == 2 || k == 4 || k == 5) {
                const bf16* sA; const bf16* sB; bf16* sO; int sNT, sK, sld, skind;
                if (k == 0) {
                    pg8::Gemm g{H, (const bf16*)(wl + WL_IN), MP, INWP, D}; pg8::EpiInProj E{P, P2W};
                    pg8::StaticOrder S; S.init(g.M, g.N, gridDim.x, blockIdx.x);
                    pg8::gemm_phase<pg8::EpiInProj, pg8::StaticOrder, true, true>(lds, g, S, E);
                    sA = H; sB = g.Bt; sO = P; sNT = INWP / 256; sK = D; sld = P2W; skind = 0;
                } else if (k == 4) {
#ifndef SKIP_G3
                    pg8::Gemm g{H, (const bf16*)(wl + WL_GU), MP, NGU, D}; pg8::EpiSwiGLU E{ACT, DFF};
                    pg8::StaticOrder S; S.init(g.M, g.N, gridDim.x, blockIdx.x);
                    pg8::gemm_phase<pg8::EpiSwiGLU, pg8::StaticOrder, true, true>(lds, g, S, E);
#endif
                    sA = H; sB = (const bf16*)(wl + WL_GU); sO = ACT; sNT = NGU / 256; sK = D; sld = DFF; skind = 2;
                } else {
#ifndef SKIP_G1
                    pg8::Gemm g; pg8::EpiBf16 E;
                    if (k == 2) { g = pg8::Gemm{CAT, (const bf16*)(wl + WL_OUT), MP, D, D}; E = pg8::EpiBf16{Y, D}; }
                    else { g = pg8::Gemm{ACT, (const bf16*)(wl + WL_DN), MP, D, DFF}; E = pg8::EpiBf16{Y, D}; }
                    pg8::StaticOrder S; S.init(g.M, g.N, gridDim.x, blockIdx.x);
                    pg8::gemm_phase<pg8::EpiBf16, pg8::StaticOrder, true, true>(lds, g, S, E);
#endif
                    sA = (k == 2) ? CAT : ACT; sB = (const bf16*)(wl + (k == 2 ? WL_OUT : WL_DN)); sO = Y; sNT = D / 256; sK = (k == 2) ? D : DFF; sld = D; skind = 1;
                }
                sample_gemm(skind, sA + (size_t)MP * sK, sB, sNT, sK, sO + (size_t)MP * sld, sld);
            } else if (k == 1) {
#ifndef SKIP_MIX
#ifdef MIX_PROBE
                for (int rep = 0; rep < 2; ++rep) { int md = rep ? 7 : MIX_PROBE; asm volatile("" : "+s"(md)); mixer_phase(a, l, lds, md); if (rep == 0) grid.sync(); }
#else
                mixer_phase(a, l, lds);
#endif
#endif
            }
            else if (k == 3) {
#ifndef SKIP_ROW
                row_phase<1>(a, l == 0, l, 2, a.in[I_GPOSTMIX] + l * D, l, 3, a.in[I_GPREFFN] + l * D);
#endif
            }
            else {
#ifndef SKIP_ROW
                if (l == 0) row_phase<1>(a, false, 0, 5, a.in[I_GPOSTFFN], 1, 0, a.in[I_GPREMIX] + D);
                else row_phase<2>(a, false, 1, 5, a.in[I_GPOSTFFN] + D, 1, 0, nullptr);
#endif
            }
        }
#ifdef DUP_MASK
      }
#endif
#if ONE_LAUNCH
        if (ph + 1 < a.ph_hi) { if (a.ph_lo != 0) grid.sync(); else xcd_barrier(xbar); }
#else
        if (ph + 1 < a.ph_hi) grid.sync();
#endif
    }
}

extern "C" void kernel_launch(void* const* d_in, const int* in_sizes, int n_in, void* d_out, int out_size, void* d_ws, size_t ws_size, hipStream_t stream) {
    static int grid = 0;
    if (grid == 0) {
        if (n_in != 25 || ws_size < WS_END) { fprintf(stderr, "kernel_launch: unexpected n_in %d / ws_size %zu\n", n_in, ws_size); grid = -1; return; }
        int dev = 0, cus = 0, per_cu = 0;
        hipGetDevice(&dev); hipDeviceGetAttribute(&cus, hipDeviceAttributeMultiprocessorCount, dev);
        if (hipFuncSetAttribute((const void*)mega_fwd, hipFuncAttributeMaxDynamicSharedMemorySize, LDS_BYTES) != hipSuccess) { fprintf(stderr, "kernel_launch: hipFuncSetAttribute failed\n"); grid = -1; return; }
        if (hipOccupancyMaxActiveBlocksPerMultiprocessor(&per_cu, (const void*)mega_fwd, 512, LDS_BYTES) != hipSuccess || per_cu < 1) { fprintf(stderr, "kernel_launch: occupancy query gave %d\n", per_cu); per_cu = 1; }
        (void)hipGetLastError();
        grid = cus;
    }
    if (grid < 0) return;
    Args a{};
    for (int i = 0; i < 25; ++i) a.in[i] = (const float*)d_in[i];
    a.out = (float*)d_out; a.ws = (unsigned char*)d_ws;
#if ONE_LAUNCH
    if (hipMemsetAsync(d_ws, 0, 16384, stream) != hipSuccess) { fprintf(stderr, "kernel_launch: memset of the barrier words failed\n"); return; }
    a.ph_lo = 0; a.ph_hi = NPH;
    void* args[] = {&a};
    hipError_t e = hipLaunchCooperativeKernel((const void*)mega_fwd, dim3(grid), dim3(512), args, LDS_BYTES, stream);
    if (e != hipSuccess) fprintf(stderr, "cooperative launch failed: %s (grid %d)\n", hipGetErrorString(e), grid);
#else
    (void)hipMemsetAsync(d_ws, 0, 16384, stream);
    for (int ph = 0; ph < NPH; ++ph) { a.ph_lo = ph; a.ph_hi = ph + 1; hipLaunchKernelGGL(mega_fwd, dim3(grid), dim3(512), LDS_BYTES, stream, a); }
#endif
}
```

```cpp
#include <hip/hip_runtime.h>
#include <hip/hip_cooperative_groups.h>
#include <cstdio>
#include <cstdint>
namespace cg = cooperative_groups;

#ifndef ONE_LAUNCH
#define ONE_LAUNCH 1
#endif

namespace pg8 {
#define PG8_LAS __attribute__((address_space(3)))
typedef unsigned short bf16_t;
typedef short bf16x8 __attribute__((ext_vector_type(8)));
typedef float f32x4 __attribute__((ext_vector_type(4)));
typedef unsigned u32x4 __attribute__((ext_vector_type(4)));
constexpr int BM = 256, BK = 64, HALF = 128, HTB = HALF * BK * 2, STAGE_BYTES = 8 * HTB, NXCD = 8, WGM = 4;

__host__ __device__ __forceinline__ int lds_byte(int r, int c) { const int st = (r >> 4) * 2 + (c >> 5), rr = r & 15, cc = c & 31, ob = rr * 64 + cc * 2; return st * 1024 + (ob ^ (((ob >> 9) & 1) << 5)); }
__host__ __device__ __forceinline__ void stage_rc(int b, int& R, int& C) { const int st = b / 1024, sb = b % 1024, swz = sb ^ (((sb >> 9) & 1) << 5); R = (st >> 1) * 16 + swz / 64; C = (st & 1) * 32 + (swz % 64) / 2; }
__host__ __device__ __forceinline__ int perm32(int rho) { const int n = rho >> 4, i = rho & 15; return 8 * (i >> 2) + 4 * n + (i & 3); }

struct Unit { int pm, pn; };
struct Gemm { const bf16_t* A; const bf16_t* Bt; int M, N, K; };

struct StaticOrder {
    int nM, nN, nwg, G, c;
    __host__ __device__ void init(int M, int N, int G_, int c_) { nM = M / BM; nN = N / BM; nwg = nM * nN; G = G_; c = c_; }
    __host__ __device__ bool next(int i, Unit& u) const {
        const long L = (long)i * G + c; if (L >= nwg) return false;
        int wgid = (int)L; { const int q = nwg / NXCD, r = nwg % NXCD, xcd = wgid % NXCD, off = wgid / NXCD; wgid = (xcd < r ? xcd * (q + 1) : r * (q + 1) + (xcd - r) * q) + off; }
        const int nig = WGM * nN, gid = wgid / nig, fm = gid * WGM, gsz = (nM - fm) < WGM ? (nM - fm) : WGM;
        u.pm = fm + ((wgid % nig) % gsz); u.pn = (wgid % nig) / gsz; return true;
    }
    __device__ __forceinline__ void a_ready(const Unit&) const {}
    __device__ __forceinline__ void done(const Unit&) const {}
};

__device__ __forceinline__ unsigned cvt_pk_bf16(float lo, float hi) { unsigned r; asm volatile("v_cvt_pk_bf16_f32 %0, %1, %2" : "=v"(r) : "v"(lo), "v"(hi)); return r; }

struct EpiBf16 {
    static constexpr bool PERM = true, AFTER_DRAIN = false;
    bf16_t* O; int ldc;
    __device__ __forceinline__ void operator()(const f32x4 (&acc)[2][2][4][2], const Unit& u, int wr, int wc, int fr, int fq) const {
        const int row0 = u.pm * BM + wr * 64 + fr; const int col0 = u.pn * BM + wc * 32 + 8 * fq;
#pragma unroll
        for (int ai = 0; ai < 2; ++ai)
#pragma unroll
            for (int m = 0; m < 4; ++m) { bf16_t* rowp = O + (size_t)(row0 + ai * HALF + m * 16) * ldc + col0;
#pragma unroll
                for (int bj = 0; bj < 2; ++bj) { const f32x4 v0 = acc[ai][bj][m][0], v1 = acc[ai][bj][m][1];
                    u32x4 w; w.x = cvt_pk_bf16(v0[0], v0[1]); w.y = cvt_pk_bf16(v0[2], v0[3]); w.z = cvt_pk_bf16(v1[0], v1[1]); w.w = cvt_pk_bf16(v1[2], v1[3]);
                    *(u32x4*)(rowp + bj * HALF) = w; } }
    }
};
__device__ __forceinline__ float silu_f(float g) { return g * __builtin_amdgcn_rcpf(1.0f + __builtin_amdgcn_exp2f(-1.44269504089f * g)); }
struct EpiSwiGLU {
    static constexpr bool PERM = true, AFTER_DRAIN = false;
    bf16_t* O; int ldc;
    __device__ __forceinline__ void operator()(const f32x4 (&acc)[2][2][4][2], const Unit& u, int wr, int wc, int fr, int fq) const {
        const int row0 = u.pm * BM + wr * 64 + fr; const int col0 = u.pn * HALF + wc * 32 + 8 * fq;
#pragma unroll
        for (int ai = 0; ai < 2; ++ai)
#pragma unroll
            for (int m = 0; m < 4; ++m) { bf16_t* rowp = O + (size_t)(row0 + ai * HALF + m * 16) * ldc + col0;
                const f32x4 g0 = acc[ai][0][m][0], g1 = acc[ai][0][m][1], u0 = acc[ai][1][m][0], u1 = acc[ai][1][m][1];
                u32x4 w;
                w.x = cvt_pk_bf16(silu_f(g0[0]) * u0[0], silu_f(g0[1]) * u0[1]); w.y = cvt_pk_bf16(silu_f(g0[2]) * u0[2], silu_f(g0[3]) * u0[3]);
                w.z = cvt_pk_bf16(silu_f(g1[0]) * u1[0], silu_f(g1[1]) * u1[1]); w.w = cvt_pk_bf16(silu_f(g1[2]) * u1[2], silu_f(g1[3]) * u1[3]);
                *(u32x4*)rowp = w; asm volatile("" ::: "memory"); }
    }
};

__device__ __forceinline__ float sigm_f(float g) { return __builtin_amdgcn_rcpf(1.0f + __builtin_amdgcn_exp2f(-1.44269504089f * g)); }
struct EpiInProj {
    static constexpr bool PERM = true, AFTER_DRAIN = false;
    bf16_t* O; int ldc;
    __device__ __forceinline__ void operator()(const f32x4 (&acc)[2][2][4][2], const Unit& u, int wr, int wc, int fr, int fq) const {
        const int row0 = u.pm * BM + wr * 64 + fr; const int cl = wc * 32 + 8 * fq; const int pn = u.pn;
        if (pn == 0 || pn >= 7) {
            const int col0 = (pn == 0 ? 0 : 1024 + (pn - 7) * 256) + cl;
#pragma unroll
            for (int ai = 0; ai < 2; ++ai)
#pragma unroll
                for (int m = 0; m < 4; ++m) { bf16_t* rowp = O + (size_t)(row0 + ai * HALF + m * 16) * ldc + col0;
#pragma unroll
                    for (int bj = 0; bj < 2; ++bj) { const f32x4 v0 = acc[ai][bj][m][0], v1 = acc[ai][bj][m][1];
                        u32x4 w; w.x = cvt_pk_bf16(v0[0], v0[1]); w.y = cvt_pk_bf16(v0[2], v0[3]); w.z = cvt_pk_bf16(v1[0], v1[1]); w.w = cvt_pk_bf16(v1[2], v1[3]);
                        if (bj == 0 || pn != 8) *(u32x4*)(rowp + bj * HALF) = w; } }
        } else {
            const bool glu = pn <= 3; const int col0 = (glu ? 256 + (pn - 1) * 128 : 640 + (pn - 4) * 128) + cl;
#pragma unroll
            for (int ai = 0; ai < 2; ++ai)
#pragma unroll
                for (int m = 0; m < 4; ++m) { bf16_t* rowp = O + (size_t)(row0 + ai * HALF + m * 16) * ldc + col0;
                    const f32x4 a0 = acc[ai][0][m][0], a1 = acc[ai][0][m][1]; f32x4 g0 = acc[ai][1][m][0], g1 = acc[ai][1][m][1];
                    if (glu) {
#pragma unroll
                        for (int e = 0; e < 4; ++e) { g0[e] = sigm_f(g0[e]); g1[e] = sigm_f(g1[e]); } }
                    u32x4 w; w.x = cvt_pk_bf16(a0[0] * g0[0], a0[1] * g0[1]); w.y = cvt_pk_bf16(a0[2] * g0[2], a0[3] * g0[3]);
                    w.z = cvt_pk_bf16(a1[0] * g1[0], a1[1] * g1[1]); w.w = cvt_pk_bf16(a1[2] * g1[2], a1[3] * g1[3]);
                    *(u32x4*)rowp = w; asm volatile("" ::: "memory"); }
        }
    }
};

template <class Epi, class Sched, bool ALIGN_EPI = false, bool SP2 = false>
__device__ __forceinline__ void gemm_phase(PG8_LAS unsigned char* lds, const Gemm g, const Sched& S, const Epi& E) {
    int tid_ = threadIdx.x; asm volatile("" : "+v"(tid_));
    const int tid = tid_, wid = __builtin_amdgcn_readfirstlane(tid >> 6), lane = tid & 63, wr = wid >> 2, wc = wid & 3, fr = lane & 15, fq = lane >> 4;
    const int K = g.K, nt = K / BK;
    unsigned voffA[2], voffB[2];
#pragma unroll
    for (int i = 0; i < 2; ++i) { int R, C; stage_rc(tid * 16 + i * 8192, R, C); const int Rb = Epi::PERM ? ((R & ~31) + perm32(R & 31)) : R;
        voffA[i] = (unsigned)(R * K + C) * 2u; voffB[i] = (unsigned)(Rb * K + C) * 2u; }
    const size_t kstep = (size_t)(BK * 2);
    const size_t hstep = (size_t)HALF * K * 2;
    const size_t tstep = 2 * hstep;
    const unsigned ldsw = (unsigned)wid * 1024u;
    const int aoff = lds_byte(wr * 64 + fr, fq * 8), boff = lds_byte(wc * 32 + fr, fq * 8);
#define PG8_SA(b, h) (((b) * 2 + (h)) * HTB)
#define PG8_SB(b, h) ((4 + (b) * 2 + (h)) * HTB)
#define PG8_STAGE(bufoff, gbase, voff) do { _Pragma("unroll") for (int _i = 0; _i < 2; ++_i) \
        __builtin_amdgcn_global_load_lds((const unsigned*)((const char*)(gbase) + (voff)[_i]), (PG8_LAS unsigned*)(lds + (bufoff) + ldsw + _i * 8192), 16, 0, 0); } while (0)
#define PG8_LDA(dst, b, h) do { _Pragma("unroll") for (int m = 0; m < 4; ++m) _Pragma("unroll") for (int k = 0; k < 2; ++k) dst[m][k] = *(const PG8_LAS bf16x8*)(lds + PG8_SA(b, h) + aoff + m * 2048 + k * 1024); } while (0)
#define PG8_LDB(dst, b, h) do { _Pragma("unroll") for (int n = 0; n < 2; ++n) _Pragma("unroll") for (int k = 0; k < 2; ++k) dst[n][k] = *(const PG8_LAS bf16x8*)(lds + PG8_SB(b, h) + boff + n * 2048 + k * 1024); } while (0)
#define PG8_MMA(ai, bj, At, Bt) do { __builtin_amdgcn_s_setprio(1); _Pragma("unroll") for (int m = 0; m < 4; ++m) _Pragma("unroll") for (int n = 0; n < 2; ++n) _Pragma("unroll") for (int k = 0; k < 2; ++k) \
        acc[ai][bj][m][n] = __builtin_amdgcn_mfma_f32_16x16x32_bf16(Bt[n][k], At[m][k], acc[ai][bj][m][n], 0, 0, 0); __builtin_amdgcn_s_setprio(0); } while (0)
#define PG8_WAIT_V(n) asm volatile("s_waitcnt vmcnt(" #n ")" ::: "memory")
#define PG8_WAIT_L(n) asm volatile("s_waitcnt lgkmcnt(" #n ")" ::: "memory")
#define PG8_BAR __builtin_amdgcn_s_barrier()
#define PG8_SCHED __builtin_amdgcn_sched_barrier(0)
    Unit cur, nxt; int ui = 0;
    if (!S.next(0, cur)) return;
#ifdef STAGGER_TICKS
    {
        const unsigned long long t0_ = __builtin_amdgcn_s_memrealtime(); const unsigned long long dl_ = (unsigned long long)((blockIdx.x >> 3) & 7) * STAGGER_TICKS;
        while (__builtin_amdgcn_s_memrealtime() - t0_ < dl_) __builtin_amdgcn_s_sleep(8);
    }
#endif
    f32x4 acc[2][2][4][2];
#pragma unroll
    for (int a = 0; a < 2; ++a)
#pragma unroll
        for (int b = 0; b < 2; ++b)
#pragma unroll
            for (int m = 0; m < 4; ++m)
#pragma unroll
                for (int n = 0; n < 2; ++n) acc[a][b][m][n] = (f32x4){0.f, 0.f, 0.f, 0.f};
    bf16x8 At[4][2], B0[2][2], B1[2][2];
    const char* cA = (const char*)g.A + (size_t)cur.pm * tstep; const char* cB = (const char*)g.Bt + (size_t)cur.pn * tstep;
    S.a_ready(cur);
    if constexpr (SP2) {
        PG8_STAGE(PG8_SB(0, 0), cB, voffB); PG8_STAGE(PG8_SB(0, 1), cB + hstep, voffB); PG8_STAGE(PG8_SA(0, 0), cA, voffA); PG8_STAGE(PG8_SA(0, 1), cA + hstep, voffA);
        if (wr == 1) PG8_BAR;
        PG8_WAIT_V(2); PG8_BAR;
        PG8_STAGE(PG8_SB(1, 0), cB + kstep, voffB); PG8_STAGE(PG8_SA(1, 0), cA + kstep, voffA); PG8_STAGE(PG8_SB(1, 1), cB + hstep + kstep, voffB);
        PG8_WAIT_V(6); PG8_BAR;
    } else {
        PG8_STAGE(PG8_SB(0, 0), cB, voffB); PG8_STAGE(PG8_SA(0, 0), cA, voffA); PG8_STAGE(PG8_SB(0, 1), cB + hstep, voffB); PG8_STAGE(PG8_SA(0, 1), cA + hstep, voffA);
        if (wr == 1) PG8_BAR;
        PG8_WAIT_V(4); PG8_BAR;
        PG8_STAGE(PG8_SB(1, 0), cB + kstep, voffB); PG8_STAGE(PG8_SA(1, 0), cA + kstep, voffA); PG8_STAGE(PG8_SB(1, 1), cB + hstep + kstep, voffB);
        PG8_WAIT_V(6); PG8_BAR;
    }
    for (;;) {
        const bool has_next = S.next(ui + 1, nxt);
        const char* nA = has_next ? (const char*)g.A + (size_t)nxt.pm * tstep : cA; const char* nB = has_next ? (const char*)g.Bt + (size_t)nxt.pn * tstep : cB;
        for (int t = 0; t < nt; t += 2) {
            const bool last = (t == nt - 2);
            const char* a1 = cA + (size_t)(t + 1) * kstep;
            const char* a2 = last ? nA : cA + (size_t)(t + 2) * kstep; const char* b2 = last ? nB : cB + (size_t)(t + 2) * kstep;
            const char* a3 = a2 + kstep; const char* b3 = b2 + kstep;
            if (last && has_next) S.a_ready(nxt);
            if constexpr (SP2) {
            PG8_LDB(B0, 0, 0); PG8_LDB(B1, 0, 1); PG8_SCHED; PG8_LDA(At, 0, 0); PG8_STAGE(PG8_SA(1, 1), a1 + hstep, voffA);
            PG8_WAIT_V(8); PG8_WAIT_L(0); PG8_BAR; PG8_MMA(0, 0, At, B0); PG8_MMA(0, 1, At, B1); PG8_BAR; PG8_SCHED;
            PG8_LDA(At, 0, 1); PG8_STAGE(PG8_SB(0, 0), b2, voffB); PG8_STAGE(PG8_SB(0, 1), b2 + hstep, voffB); PG8_STAGE(PG8_SA(0, 0), a2, voffA);
            PG8_WAIT_V(8); PG8_WAIT_L(0); PG8_BAR; PG8_MMA(1, 0, At, B0); PG8_MMA(1, 1, At, B1); PG8_BAR; PG8_SCHED;
            PG8_LDB(B0, 1, 0); PG8_LDB(B1, 1, 1); PG8_SCHED; PG8_LDA(At, 1, 0); PG8_STAGE(PG8_SA(0, 1), a2 + hstep, voffA);
            PG8_WAIT_V(8); PG8_WAIT_L(0); PG8_BAR; PG8_MMA(0, 0, At, B0); PG8_MMA(0, 1, At, B1); PG8_BAR; PG8_SCHED;
            PG8_LDA(At, 1, 1); PG8_STAGE(PG8_SB(1, 0), b3, voffB); PG8_STAGE(PG8_SB(1, 1), b3 + hstep, voffB); PG8_STAGE(PG8_SA(1, 0), a3, voffA);
            PG8_WAIT_V(8); PG8_WAIT_L(0); PG8_BAR; PG8_MMA(1, 0, At, B0); PG8_MMA(1, 1, At, B1); PG8_BAR; PG8_SCHED;
            } else {
            PG8_LDB(B0, 0, 0); PG8_SCHED; PG8_LDA(At, 0, 0); PG8_STAGE(PG8_SA(1, 1), a1 + hstep, voffA);
            PG8_WAIT_L(8); PG8_BAR; PG8_WAIT_L(0); PG8_MMA(0, 0, At, B0); PG8_BAR; PG8_SCHED;
            PG8_LDB(B1, 0, 1); PG8_STAGE(PG8_SB(0, 0), b2, voffB);
            PG8_BAR; PG8_WAIT_L(0); PG8_MMA(0, 1, At, B1); PG8_BAR;
            PG8_LDA(At, 0, 1); PG8_STAGE(PG8_SA(0, 0), a2, voffA);
            PG8_BAR; PG8_WAIT_L(0); PG8_MMA(1, 0, At, B0); PG8_BAR; PG8_SCHED;
            PG8_STAGE(PG8_SB(0, 1), b2 + hstep, voffB);
            PG8_WAIT_V(6); PG8_BAR; PG8_MMA(1, 1, At, B1); PG8_BAR;
            PG8_LDB(B0, 1, 0); PG8_SCHED; PG8_LDA(At, 1, 0); PG8_STAGE(PG8_SA(0, 1), a2 + hstep, voffA);
            PG8_WAIT_L(8); PG8_BAR; PG8_WAIT_L(0); PG8_MMA(0, 0, At, B0); PG8_BAR; PG8_SCHED;
            PG8_LDB(B1, 1, 1); PG8_STAGE(PG8_SB(1, 0), b3, voffB);
            PG8_BAR; PG8_WAIT_L(0); PG8_MMA(0, 1, At, B1); PG8_BAR;
            PG8_LDA(At, 1, 1); PG8_STAGE(PG8_SA(1, 0), a3, voffA);
            PG8_BAR; PG8_WAIT_L(0); PG8_MMA(1, 0, At, B0); PG8_BAR; PG8_SCHED;
            PG8_STAGE(PG8_SB(1, 1), b3 + hstep, voffB);
            PG8_WAIT_V(6); PG8_BAR; PG8_MMA(1, 1, At, B1); PG8_BAR;
            }
        }
        if constexpr (ALIGN_EPI) { if (wr == 0) PG8_BAR; }
        if constexpr (!Epi::AFTER_DRAIN) { E(acc, cur, wr, wc, fr, fq); S.done(cur); }
        if (!has_next) break;
#pragma unroll
        for (int a = 0; a < 2; ++a)
#pragma unroll
            for (int b = 0; b < 2; ++b)
#pragma unroll
                for (int m = 0; m < 4; ++m)
#pragma unroll
                    for (int n = 0; n < 2; ++n) acc[a][b][m][n] = (f32x4){0.f, 0.f, 0.f, 0.f};
        cur = nxt; cA = nA; cB = nB; ++ui;
        if constexpr (ALIGN_EPI) { if (wr == 1) PG8_BAR; }
    }
    PG8_WAIT_V(0);
    if constexpr (!ALIGN_EPI) { if (wr == 0) PG8_BAR; }
    PG8_BAR;
#undef PG8_SA
#undef PG8_SB
#undef PG8_STAGE
#undef PG8_LDA
#undef PG8_LDB
#undef PG8_MMA
#undef PG8_WAIT_V
#undef PG8_WAIT_L
#undef PG8_BAR
#undef PG8_SCHED
}
}

#define LAS __attribute__((address_space(3)))
typedef unsigned short bf16;
typedef float f32x4 __attribute__((ext_vector_type(4)));
typedef float f32x2 __attribute__((ext_vector_type(2)));
typedef unsigned u32x4 __attribute__((ext_vector_type(4)));
typedef unsigned u32x2 __attribute__((ext_vector_type(2)));
typedef short bf16x8 __attribute__((ext_vector_type(8)));

constexpr int D = 1024, NB = 32, T_P = 2048, NDB = 8, T_S = 16, PASTLEN = 4096;
constexpr int MP = NB * T_P;
constexpr int MS = NDB * T_S;
constexpr int MR = MP + MS;
constexpr int MPAD = 257 * 256;
constexpr int INW = 2176, INWP = 2304, DFF = 2816, NGU = 2 * DFF;
constexpr int PW = 256, CW = 384, SW = 384, P2W = 1408;
constexpr float EPS = 1e-6f;
constexpr int NMODR = NB + NDB;
constexpr int KCH = 8;

constexpr size_t O_YP = 0, O_YS = (size_t)MP * D, O_POOLP = O_YS + (size_t)MS * D, O_CONVP = O_POOLP + 2 * 32 * 15 * 256,
                 O_SCP = O_CONVP + 2 * 32 * 30 * 384, O_POOLS = O_SCP + 2 * 32 * 2 * 384, O_CONVS = O_POOLS + 2 * 8 * 15 * 256, O_SCS = O_CONVS + 2 * 8 * 30 * 384;
constexpr size_t MiB = 1u << 20;
constexpr size_t WL_IN = 0, WL_OUT = (size_t)INWP * D * 2, WL_GU = WL_OUT + (size_t)D * D * 2, WL_DN = WL_GU + (size_t)NGU * D * 2, WL_SZ = WL_DN + (size_t)D * DFF * 2;
static_assert(WL_SZ == 23 * MiB, "weight block");
constexpr size_t WS_W = 2 * MiB, WS_PART = 48 * MiB, WS_H = 64 * MiB, WS_Y = 193 * MiB, WS_P = 322 * MiB, WS_CAT = 612 * MiB, WS_ACT = WS_P, WS_XB = 741 * MiB, WS_END = 870 * MiB;
static_assert(WS_PART + (size_t)2 * NMODR * 6144 * 4 <= WS_H && WS_H + (size_t)MPAD * D * 2 <= WS_Y && WS_Y + (size_t)MPAD * D * 2 <= WS_P && WS_P + (size_t)MPAD * INWP * 2 <= WS_CAT && WS_CAT + (size_t)MPAD * D * 2 <= WS_XB && WS_ACT + (size_t)MPAD * DFF * 2 <= WS_XB && WS_XB + (size_t)MR * D * 2 <= WS_END, "ws map");

constexpr int LDS_BYTES = 147456;

struct Args { const float* in[25]; float* out; unsigned char* ws; int ph_lo, ph_hi; };
enum { I_XP = 0, I_XS, I_CP, I_CS, I_SPOOL, I_SCONV, I_SSC, I_WADA, I_BADA, I_GPREMIX, I_GPOSTMIX, I_GPREFFN, I_GPOSTFFN, I_WIN, I_WPOOL, I_SPOOLW, I_WDW, I_BDW, I_LNG, I_LNB, I_WSC, I_WOUT, I_WGATE, I_WUP, I_WDOWN };

__device__ __forceinline__ unsigned f2bf(float f) { unsigned u = __builtin_bit_cast(unsigned, f); return (u + 0x7fffu + ((u >> 16) & 1u)) >> 16; }
__device__ __forceinline__ unsigned pk2(float lo, float hi) { unsigned r; asm("v_cvt_pk_bf16_f32 %0, %1, %2" : "=v"(r) : "v"(lo), "v"(hi)); return r; }
__device__ __forceinline__ float bflo(unsigned u) { return __builtin_bit_cast(float, u << 16); }
__device__ __forceinline__ float bfhi(unsigned u) { return __builtin_bit_cast(float, u & 0xffff0000u); }
__device__ __forceinline__ float wave_sum(float v) {
#pragma unroll
    for (int o = 1; o < 64; o <<= 1) v += __shfl_xor(v, o);
    return v;
}
__device__ __forceinline__ float sigmoid_f(float g) { return __builtin_amdgcn_rcpf(1.0f + __builtin_amdgcn_exp2f(-1.44269504089f * g)); }
__device__ __forceinline__ float silu_acc(float g) { return g * __builtin_amdgcn_rcpf(1.0f + __builtin_amdgcn_exp2f(-1.44269504089f * g)); }


#define XB_TMO      128
#define XB_XCNT(j)  (256  + 64 * (j))
#define XB_XSUB(j)  (1280 + 64 * (j))
#define XB_XGEN(j)  (2304 + 64 * (j))
#define XB_TOP      3328
#define XB_TOPGEN   3392
#define XCD_BAR_WORDS 3456
#define XB_SPIN_CAP (1u << 22)
__device__ __forceinline__ unsigned xb_ld(unsigned* p)              { return __hip_atomic_load(p, __ATOMIC_RELAXED, __HIP_MEMORY_SCOPE_AGENT); }
__device__ __forceinline__ unsigned xb_add(unsigned* p, unsigned v) { return __hip_atomic_fetch_add(p, v, __ATOMIC_RELAXED, __HIP_MEMORY_SCOPE_AGENT); }
__device__ __forceinline__ unsigned xb_xcc_id() { return (unsigned)__builtin_amdgcn_s_getreg((3 << 11) | 20) & 0xFu; }
#define XB_SPIN(cond, bar) do { unsigned _sp = 0; while (cond) { __builtin_amdgcn_s_sleep(1); \
    if ((++_sp & 255u) == 0u) { if (xb_ld(&(bar)[XB_TMO])) break; if (_sp > XB_SPIN_CAP) { atomicAdd(&(bar)[XB_TMO], 1u); break; } } } } while (0)
struct XcdBarrier { unsigned* bar; unsigned x; volatile LAS unsigned* st; };
__device__ __forceinline__ XcdBarrier xcd_barrier_post(unsigned* bar, volatile LAS unsigned* st) {
    XcdBarrier b; b.bar = bar; b.x = xb_xcc_id(); b.st = st;
    if (threadIdx.x == 0) (void)xb_add(&bar[XB_XCNT(b.x)], 1u);
    return b;
}
__device__ __forceinline__ void xcd_barrier_complete(unsigned* bar, unsigned x, unsigned& nloc, unsigned& nx) {
    const unsigned G = gridDim.x * gridDim.y * gridDim.z;
    unsigned sum, cnt, mine, sp = 0u;
    for (;;) {
        sum = 0u; cnt = 0u; mine = 0u;
#pragma unroll
        for (unsigned j = 0; j < 16; ++j) { const unsigned c = xb_ld(&bar[XB_XCNT(j)]); sum += c; cnt += (c > 0u) ? 1u : 0u; mine = (j == x) ? c : mine; }
        if (sum == G) break;
        __builtin_amdgcn_s_sleep(1);
        if ((++sp & 255u) == 0u) { if (xb_ld(&bar[XB_TMO])) break; if (sp > XB_SPIN_CAP) { atomicAdd(&bar[XB_TMO], 1u); break; } }
    }
    nloc = mine > 0u ? mine : 1u; nx = cnt > 0u ? cnt : 1u;
}
__device__ __forceinline__ void xcd_barrier(const XcdBarrier& b) {
    asm volatile("s_waitcnt vmcnt(0)" ::: "memory");
    __syncthreads();
    if (threadIdx.x == 0) {
        unsigned* bar = b.bar;
        __builtin_amdgcn_s_waitcnt(0);
        unsigned nloc = b.st[0], nx = b.st[1];
        if (nloc == 0u) { xcd_barrier_complete(bar, b.x, nloc, nx); b.st[0] = nloc; b.st[1] = nx; }
        const unsigned old = xb_add(&bar[XB_XSUB(b.x)], 1u);
        const unsigned gen = old / nloc;
        if (old + 1u == (gen + 1u) * nloc) {
            __builtin_amdgcn_fence(__ATOMIC_RELEASE, "agent");
            asm volatile("s_waitcnt vmcnt(0)" ::: "memory");
            const unsigned og = xb_add(&bar[XB_TOP], 1u);
            const unsigned tg = og / nx;
            if (og + 1u == (tg + 1u) * nx) xb_add(&bar[XB_TOPGEN], 1u);
            else XB_SPIN(xb_ld(&bar[XB_TOPGEN]) == tg, bar);
            __builtin_amdgcn_fence(__ATOMIC_ACQUIRE, "agent");
            xb_add(&bar[XB_XGEN(b.x)], 1u);
            asm volatile("s_waitcnt vmcnt(0)" ::: "memory");
        } else {
            XB_SPIN(xb_ld(&bar[XB_XGEN(b.x)]) == gen, bar);
            __builtin_amdgcn_fence(__ATOMIC_ACQUIRE, "agent");
            asm volatile("s_waitcnt vmcnt(0)" ::: "memory");
        }
    }
    __syncthreads();
}

__device__ __forceinline__ void p0_transpose_item(const float* W, int N, bf16* WT, int Kp, int dest_row0, int k0, int n0, LAS float* scr, int lane) {
    float tv[32];
#pragma unroll
    for (int i = 0; i < 32; ++i) { const int kk = 2 * i + (lane >> 5); tv[i] = W[(size_t)(k0 + kk) * N + n0 + (lane & 31)]; }
#pragma unroll
    for (int i = 0; i < 32; ++i) { const int kk = 2 * i + (lane >> 5); scr[kk * 33 + (lane & 31)] = tv[i]; }
    asm volatile("s_waitcnt lgkmcnt(0)" ::: "memory");
    const int c = lane & 7;
#pragma unroll
    for (int j = 0; j < 4; ++j) { const int n = (lane >> 3) + 8 * j; const LAS float* s = scr + (8 * c) * 33 + n;
        u32x4 o; o.x = pk2(s[0 * 33], s[1 * 33]); o.y = pk2(s[2 * 33], s[3 * 33]); o.z = pk2(s[4 * 33], s[5 * 33]); o.w = pk2(s[6 * 33], s[7 * 33]);
        *(u32x4*)(WT + (size_t)(dest_row0 + n) * Kp + k0 + 8 * c) = o; }
    asm volatile("s_waitcnt lgkmcnt(0)" ::: "memory");
}

__device__ __forceinline__ void p0_prologue(const Args& a, LAS unsigned char* lds) {
    int tid = threadIdx.x; asm volatile("" : "+v"(tid));
    const int lane = tid & 63, wave = __builtin_amdgcn_readfirstlane(tid >> 6);
    LAS float* scr = (LAS float*)(lds + wave * 16384);
    const int gw = blockIdx.x * 8 + wave, NGW = gridDim.x * 8;
    constexpr int NMODWG = 192;
    float* modp = (float*)(a.ws + WS_PART);
    for (int wi = blockIdx.x; wi < NMODWG; wi += gridDim.x) {
        const int cb = wi % 96, l = wi / 96;
        LAS float* sc = (LAS float*)(lds + wave * 10240);
        float acc[NMODR];
#pragma unroll
        for (int r = 0; r < NMODR; ++r) acc[r] = 0.f;
        const float* wp = a.in[I_WADA] + (size_t)l * D * 6144 + cb * 64;
#pragma unroll 1
        for (int half = 0; half < 2; ++half) {
            const int kb = wave * 128 + half * 64;
            int ln = lane; asm volatile("" : "+v"(ln));
#pragma unroll 8
            for (int r = 0; r < NMODR; ++r) { const float cv = (r < NB) ? a.in[I_CP][r * D + kb + ln] : a.in[I_CS][(r - NB) * D + kb + ln]; sc[r * 64 + ln] = silu_acc(cv); }
            asm volatile("s_waitcnt lgkmcnt(0)" ::: "memory");
#pragma unroll 1
            for (int k0 = 0; k0 < 64; k0 += 16) {
                int ko = (kb + k0) * 6144 + lane; asm volatile("" : "+v"(ko));
                float w[16];
#pragma unroll
                for (int i = 0; i < 16; ++i) w[i] = wp[ko + i * 6144];
#pragma unroll
                for (int r = 0; r < NMODR; ++r) {
                    const LAS f32x4* sp = (const LAS f32x4*)(sc + r * 64 + k0);
                    const f32x4 s0 = sp[0], s1 = sp[1], s2 = sp[2], s3 = sp[3];
                    acc[r] += ((s0[0] * w[0] + s0[1] * w[1]) + (s0[2] * w[2] + s0[3] * w[3])) + ((s1[0] * w[4] + s1[1] * w[5]) + (s1[2] * w[6] + s1[3] * w[7]))
                            + ((s2[0] * w[8] + s2[1] * w[9]) + (s2[2] * w[10] + s2[3] * w[11])) + ((s3[0] * w[12] + s3[1] * w[13]) + (s3[2] * w[14] + s3[3] * w[15]));
                    if ((r & 3) == 3) asm volatile("" ::: "memory"); }
            }
            asm volatile("s_waitcnt lgkmcnt(0)" ::: "memory");
        }
#pragma unroll
        for (int r = 0; r < NMODR; ++r) sc[r * 64 + lane] = acc[r];
        __syncthreads();
        for (int o = tid; o < NMODR * 64; o += 512) { float v = a.in[I_BADA][l * 6144 + cb * 64 + (o & 63)];
#pragma unroll
            for (int w8 = 0; w8 < 8; ++w8) v += ((const LAS float*)lds)[w8 * 2560 + o];
            modp[((size_t)l * NMODR + (o >> 6)) * 6144 + cb * 64 + (o & 63)] = v; }
        __syncthreads();
    }
    constexpr int I_IN = 16 * (INW / 32), I_OUT = 16 * (D / 32), I_G = 16 * (DFF / 32), I_DN = (DFF / 64) * (D / 32), I_PADZ = 128;
    constexpr int PER_L = I_IN + I_OUT + 2 * I_G + I_DN + I_PADZ;
    unsigned* qctr = (unsigned*)a.ws + 3520;
    (void)gw; (void)NGW; int qbase = 0;
    for (int qi = 0;; ++qi) {
        int itb;
        if ((qi & 7) == 0) { unsigned itq = 0; if (lane == 0) { itq = __hip_atomic_load(qctr, __ATOMIC_RELAXED, __HIP_MEMORY_SCOPE_AGENT); if (itq < (unsigned)(2 * PER_L)) itq = atomicAdd(qctr, 8u); } itb = __builtin_amdgcn_readfirstlane((int)itq); qbase = itb; }
        const int it0 = qbase + (qi & 7);
        if (it0 >= 2 * PER_L) { if ((qi & 7) == 7 || qbase >= 2 * PER_L) break; else continue; }
        const int l = it0 / PER_L; int r = it0 % PER_L;
        bf16* wl = (bf16*)(a.ws + WS_W + (size_t)l * WL_SZ);
        if (r < I_IN) { const int nblk = INW / 32, kb = r / nblk, nb = r % nblk, n0 = nb * 32; int dr;
            if (n0 < 256) dr = n0;
            else if (n0 < 640) { const int j = n0 - 256; dr = 256 * (1 + (j >> 7)) + (j & 127); }
            else if (n0 < 1024) { const int j = n0 - 640; dr = 256 * (1 + (j >> 7)) + 128 + (j & 127); }
            else if (n0 < 1408) { const int j = n0 - 1024; dr = 256 * (4 + (j >> 7)) + (j & 127); }
            else if (n0 < 1792) { dr = 1792 + (n0 - 1408); }
            else { const int j = n0 - 1792; dr = 256 * (4 + (j >> 7)) + 128 + (j & 127); }
            p0_transpose_item(a.in[I_WIN] + (size_t)l * D * INW, INW, (bf16*)((char*)wl + WL_IN), D, dr, kb * 64, n0, scr, lane); continue; } r -= I_IN;
        if (r < I_OUT) { const int nblk = D / 32, kb = r / nblk, nb = r % nblk; p0_transpose_item(a.in[I_WOUT] + (size_t)l * D * D, D, (bf16*)((char*)wl + WL_OUT), D, nb * 32, kb * 64, nb * 32, scr, lane); continue; } r -= I_OUT;
        if (r < 2 * I_G) { const int up = r >= I_G; if (up) r -= I_G; const int nblk = DFF / 32, kb = r / nblk, nb = r % nblk, n0 = nb * 32;
            p0_transpose_item(a.in[up ? I_WUP : I_WGATE] + (size_t)l * D * DFF, DFF, (bf16*)((char*)wl + WL_GU), D, (n0 >> 7) * 256 + up * 128 + (n0 & 127), kb * 64, n0, scr, lane); continue; } r -= 2 * I_G;
        if (r < I_DN) { const int nblk = D / 32, kb = r / nblk, nb = r % nblk; p0_transpose_item(a.in[I_WDOWN] + (size_t)l * DFF * D, D, (bf16*)((char*)wl + WL_DN), DFF, nb * 32, kb * 64, nb * 32, scr, lane); continue; } r -= I_DN;
        { u32x4* z = (u32x4*)((char*)wl + WL_IN + (size_t)(INW + r) * D * 2); z[lane] = (u32x4){0u, 0u, 0u, 0u}; z[lane + 64] = (u32x4){0u, 0u, 0u, 0u}; }
    }
}

__device__ __forceinline__ void load_mod(const Args& a, int l, int r, int which, int lane, f32x4 (&v)[4]) {
    const float* modp = (const float*)(a.ws + WS_PART) + ((size_t)l * NMODR + r) * 6144 + which * 1024;
#pragma unroll
    for (int j = 0; j < 4; ++j) v[j] = *(const f32x4*)(modp + 256 * j + 4 * lane);
}
__device__ __forceinline__ void load_vec(const float* g, int lane, f32x4 (&v)[4]) {
#pragma unroll
    for (int j = 0; j < 4; ++j) v[j] = *(const f32x4*)(g + 256 * j + 4 * lane);
}
template <int MODE, bool XBF>
__device__ __forceinline__ void rows_do(const float* xin, const bf16* xinb, float* xout, bf16* xoutb, const bf16* Y, bf16* H, int nrows, const f32x4 (&GB)[4], const f32x4 (&GA)[4], const f32x4 (&SH)[4], int lane) {
    constexpr int R = 2;
    f32x4 xcf[R][4], xnf[R][4]; u32x2 xcb[R][4], xnb[R][4], yc[R][4], yn[R][4];
#pragma unroll
    for (int rr = 0; rr < R; ++rr) { const int ir = (rr < nrows) ? rr : nrows - 1;
#pragma unroll
        for (int j = 0; j < 4; ++j) {
            if (XBF) xcb[rr][j] = *(const u32x2*)(xinb + (size_t)ir * D + 256 * j + 4 * lane); else xcf[rr][j] = *(const f32x4*)(xin + (size_t)ir * D + 256 * j + 4 * lane);
            if (MODE != 0) yc[rr][j] = *(const u32x2*)(Y + (size_t)ir * D + 256 * j + 4 * lane); } }
    for (int i = 0; i < nrows; i += R) {
#pragma unroll
        for (int rr = 0; rr < R; ++rr) { const int ip = (i + R + rr < nrows) ? i + R + rr : nrows - 1;
#pragma unroll
            for (int j = 0; j < 4; ++j) {
                if (XBF) xnb[rr][j] = *(const u32x2*)(xinb + (size_t)ip * D + 256 * j + 4 * lane); else xnf[rr][j] = *(const f32x4*)(xin + (size_t)ip * D + 256 * j + 4 * lane);
                if (MODE != 0) yn[rr][j] = *(const u32x2*)(Y + (size_t)ip * D + 256 * j + 4 * lane); } }
        f32x4 x[R][4];
#pragma unroll
        for (int rr = 0; rr < R; ++rr)
#pragma unroll
            for (int j = 0; j < 4; ++j) { if (XBF) x[rr][j] = (f32x4){bflo(xcb[rr][j].x), bfhi(xcb[rr][j].x), bflo(xcb[rr][j].y), bfhi(xcb[rr][j].y)}; else x[rr][j] = xcf[rr][j]; }
        const bool v1 = (i + 1 < nrows);
        if (MODE != 0) {
            f32x4 y[R][4]; float ss[R];
#pragma unroll
            for (int rr = 0; rr < R; ++rr) { ss[rr] = 0.f;
#pragma unroll
                for (int j = 0; j < 4; ++j) { y[rr][j] = (f32x4){bflo(yc[rr][j].x), bfhi(yc[rr][j].x), bflo(yc[rr][j].y), bfhi(yc[rr][j].y)}; ss[rr] += (y[rr][j][0] * y[rr][j][0] + y[rr][j][1] * y[rr][j][1]) + (y[rr][j][2] * y[rr][j][2] + y[rr][j][3] * y[rr][j][3]); } }
#pragma unroll
            for (int o = 1; o < 64; o <<= 1) {
#pragma unroll
                for (int rr = 0; rr < R; ++rr) ss[rr] += __shfl_xor(ss[rr], o); }
#pragma unroll
            for (int rr = 0; rr < R; ++rr) { const float rs = __builtin_amdgcn_rsqf(ss[rr] * (1.0f / D) + EPS);
#pragma unroll
                for (int j = 0; j < 4; ++j) x[rr][j] += GB[j] * (y[rr][j] * rs); }
        }
        float rs2[R];
        if (MODE != 2) {
            float ss[R];
#pragma unroll
            for (int rr = 0; rr < R; ++rr) { ss[rr] = 0.f;
#pragma unroll
                for (int j = 0; j < 4; ++j) ss[rr] += (x[rr][j][0] * x[rr][j][0] + x[rr][j][1] * x[rr][j][1]) + (x[rr][j][2] * x[rr][j][2] + x[rr][j][3] * x[rr][j][3]); }
#pragma unroll
            for (int o = 1; o < 64; o <<= 1) {
#pragma unroll
                for (int rr = 0; rr < R; ++rr) ss[rr] += __shfl_xor(ss[rr], o); }
#pragma unroll
            for (int rr = 0; rr < R; ++rr) rs2[rr] = __builtin_amdgcn_rsqf(ss[rr] * (1.0f / D) + EPS);
        }
#pragma unroll
        for (int rr = 0; rr < R; ++rr) {
            const int ir = (rr == 0 || v1) ? i + rr : i;
#pragma unroll
            for (int j = 0; j < 4; ++j) {
                if (MODE == 2) *(f32x4*)(xout + (size_t)ir * D + 256 * j + 4 * lane) = x[rr][j];
                if (MODE == 1) { u32x2 o; o.x = pk2(x[rr][j][0], x[rr][j][1]); o.y = pk2(x[rr][j][2], x[rr][j][3]); *(u32x2*)(xoutb + (size_t)ir * D + 256 * j + 4 * lane) = o; }
                if (MODE != 2) { const f32x4 h = (x[rr][j] * rs2[rr]) * GA[j] + SH[j]; u32x2 o; o.x = pk2(h[0], h[1]); o.y = pk2(h[2], h[3]); *(u32x2*)(H + (size_t)ir * D + 256 * j + 4 * lane) = o; }
            }
        }
#pragma unroll
        for (int rr = 0; rr < R; ++rr)
#pragma unroll
            for (int j = 0; j < 4; ++j) { if (XBF) xcb[rr][j] = xnb[rr][j]; else xcf[rr][j] = xnf[rr][j]; if (MODE != 0) yc[rr][j] = yn[rr][j]; }
    }
}
template <int MODE>
__device__ __forceinline__ void row_phase(const Args& a, bool x_from_input, int lb, int wgt, const float* gpost, int lh, int wsh, const float* gpre) {
    int tid = threadIdx.x; asm volatile("" : "+v"(tid));
    const int lane = tid & 63, wave = __builtin_amdgcn_readfirstlane(tid >> 6);
    const int gw = blockIdx.x * 8 + wave, NGW = gridDim.x * 8;
    const bf16* Y = (const bf16*)(a.ws + WS_Y); bf16* H = (bf16*)(a.ws + WS_H); bf16* XB = (bf16*)(a.ws + WS_XB);
    const int nchunk = MP / 32 + MS;
    for (int ch = gw; ch < nchunk; ch += NGW) {
        int row0, nrows, r;
        if (ch < MP / 32) { row0 = ch * 32; nrows = 32; r = row0 / T_P; } else { const int j = ch - MP / 32; row0 = MP + j; nrows = 1; r = NB + j / T_S; }
        f32x4 GB[4], GA[4], SH[4];
        if (MODE != 0) { f32x4 gt[4], gp[4]; load_mod(a, lb, r, wgt, lane, gt); load_vec(gpost, lane, gp);
#pragma unroll
            for (int j = 0; j < 4; ++j) GB[j] = gt[j] * gp[j]; }
        if (MODE != 2) { f32x4 sc[4], gp[4]; load_mod(a, lh, r, wsh + 1, lane, sc); load_mod(a, lh, r, wsh, lane, SH); load_vec(gpre, lane, gp);
#pragma unroll
            for (int j = 0; j < 4; ++j) GA[j] = gp[j] * (1.0f + sc[j]); }
        const float* xin = (row0 < MP ? a.in[I_XP] + (size_t)row0 * D : a.in[I_XS] + (size_t)(row0 - MP) * D);
        if (MODE == 0 || (MODE == 1 && x_from_input)) rows_do<MODE, false>(xin, XB + (size_t)row0 * D, a.out + (size_t)row0 * D, XB + (size_t)row0 * D, Y + (size_t)row0 * D, H + (size_t)row0 * D, nrows, GB, GA, SH, lane);
        else rows_do<(MODE == 0 ? 1 : MODE), true>(xin, XB + (size_t)row0 * D, a.out + (size_t)row0 * D, XB + (size_t)row0 * D, Y + (size_t)row0 * D, H + (size_t)row0 * D, nrows, GB, GA, SH, lane);
    }
}

template <int N, int SZ>
__device__ __forceinline__ void tr_reduce_step(float (&v)[SZ], int lane) {
    constexpr int Hh = N / 2;
    const bool up = (lane & Hh) != 0;
#pragma unroll
    for (int i = 0; i < Hh; ++i) { const float send = up ? v[i] : v[i + Hh]; const float keep = up ? v[i + Hh] : v[i]; v[i] = keep + __shfl_xor(send, Hh); }
}
template <int R, int N> struct ConvLoop {
    static __device__ __forceinline__ void run(f32x2 (&z)[32], const f32x2 (&w)[31], const LAS unsigned* up) {
        const unsigned v = up[R * 192]; const f32x2 uv = {bflo(v), bfhi(v)};
#pragma unroll
        for (int i = (R - 30 > 0 ? R - 30 : 0); i <= (R < 31 ? R : 31); ++i) z[i] += w[R - i] * uv;
        if ((R & 7) == 7) asm volatile("" ::: "memory");
        ConvLoop<R + 1, N>::run(z, w, up);
    }
};
template <int N> struct ConvLoop<N, N> { static __device__ __forceinline__ void run(f32x2 (&)[32], const f32x2 (&)[31], const LAS unsigned*) {} };

constexpr int MIX_UC = 0, MIX_XA = 73728, XA_PITCH = 528, MIX_ST = MIX_XA + 79 * XA_PITCH;
static_assert(MIX_ST + 6 * 64 * 4 <= 131072, "mixer LDS");

__device__ __forceinline__ void mixer_phase(const Args& a, int l, LAS unsigned char* lds, int mode = 7) {
    const bf16* P = (const bf16*)(a.ws + WS_P); bf16* CAT = (bf16*)(a.ws + WS_CAT);
    LAS bf16* Uc = (LAS bf16*)(lds + MIX_UC);
    LAS unsigned char* XaB = lds + MIX_XA;
    LAS float* ST = (LAS float*)(lds + MIX_ST);
    const int NU = MP / 64 + NDB;
    for (int u = blockIdx.x; u < NU; u += gridDim.x) {
        int tid = threadIdx.x; asm volatile("" : "+v"(tid));
        const int lane = tid & 63, wave = __builtin_amdgcn_readfirstlane(tid >> 6);
        int rowbase, T, t0, start, b; bool smp;
        if (u < MP / 64) {
            int uu = u;
            if (gridDim.x == 256) { const int k_ = u >> 8, c_ = u & 255; uu = (8 * k_ + (c_ & 7)) * 32 + (((c_ >> 3) + 8 * k_) & 31); }
            b = uu / 32; t0 = (uu % 32) * 64; T = T_P; start = 0; rowbase = b * T_P; smp = false; }
        else { b = u - MP / 64; t0 = 0; T = T_S; start = PASTLEN; rowbase = MP + b * T_S; smp = true; }
        const int nbat = smp ? NDB : NB;
        float* pool_out = a.out + (smp ? O_POOLS : O_POOLP) + ((size_t)l * nbat + b) * 15 * 256;
        float* conv_out = a.out + (smp ? O_CONVS : O_CONVP) + ((size_t)l * nbat + b) * 30 * 384;
        float* sc_out = a.out + (smp ? O_SCS : O_SCP) + ((size_t)l * nbat + b) * 2 * 384;
        const float* st_pool = a.in[I_SPOOL] + ((size_t)l * NDB + b) * 15 * 256;
        const float* st_conv = a.in[I_SCONV] + ((size_t)l * NDB + b) * 30 * 384;
        const float* st_sc = a.in[I_SSC] + ((size_t)l * NDB + b) * 2 * 384;
        const int seg = tid / 48, oc = tid - seg * 48, cc = oc * 8;
        u32x4 va[12], vb[5];
        if (tid < 384) {
#pragma unroll
            for (int q = 0; q < 12; ++q) { const int r = seg + 8 * q, t = t0 - 30 + r;
                va[q] = (u32x4){0u, 0u, 0u, 0u};
                if (r < 94 && t >= 0 && t < T) va[q] = *(const u32x4*)(P + (size_t)(rowbase + t) * P2W + 256 + cc); }
        }
#pragma unroll
        for (int q = 0; q < 5; ++q) { const int i = tid + 512 * q, r = i >> 5, o = i & 31, t = t0 - 15 + r;
            vb[q] = (u32x4){0u, 0u, 0u, 0u};
            if (i < 79 * 32 && t >= 0 && t < T) vb[q] = *(const u32x4*)(P + (size_t)(rowbase + t) * P2W + o * 8); }
        if (smp) {
            if (tid < 384) {
#pragma unroll
                for (int q = 0; q < 4; ++q) { const int r = seg + 8 * q, t = r - 30;
                    if (t < 0) { const f32x4 p0 = *(const f32x4*)(st_conv + (30 + t) * 384 + cc), p1 = *(const f32x4*)(st_conv + (30 + t) * 384 + cc + 4);
                        va[q].x = pk2(p0[0], p0[1]); va[q].y = pk2(p0[2], p0[3]); va[q].z = pk2(p1[0], p1[1]); va[q].w = pk2(p1[2], p1[3]); } }
            }
#pragma unroll
            for (int q = 0; q < 1; ++q) { const int i = tid, r = i >> 5, o = i & 31, t = r - 15, c = o * 8;
                if (t < 0) { const f32x4 p0 = *(const f32x4*)(st_pool + (15 + t) * 256 + c), p1 = *(const f32x4*)(st_pool + (15 + t) * 256 + c + 4);
                    vb[q].x = pk2(p0[0], p0[1]); vb[q].y = pk2(p0[2], p0[3]); vb[q].z = pk2(p1[0], p1[1]); vb[q].w = pk2(p1[2], p1[3]); } }
        }
        if (tid < 384) {
#pragma unroll
            for (int q = 0; q < 12; ++q) { const int r = seg + 8 * q; if (r < 94) *(LAS u32x4*)(Uc + r * 384 + cc) = va[q]; }
        }
#pragma unroll
        for (int q = 0; q < 5; ++q) { const int i = tid + 512 * q, r = i >> 5, o = i & 31; if (i < 79 * 32) *(LAS u32x4*)(XaB + r * XA_PITCH + o * 16) = vb[q]; }
        if (t0 + 64 >= T && !smp) {
            u32x4 cw[3], pw, sw;
#pragma unroll
            for (int q = 0; q < 3; ++q) { const int i = tid + 512 * q, sr = i / 48, o = i - sr * 48; cw[q] = (u32x4){0u, 0u, 0u, 0u};
                if (i < 30 * 48) cw[q] = *(const u32x4*)(P + (size_t)(rowbase + T - 30 + sr) * P2W + 256 + o * 8); }
            pw = (u32x4){0u, 0u, 0u, 0u}; sw = (u32x4){0u, 0u, 0u, 0u};
            if (tid < 15 * 32) pw = *(const u32x4*)(P + (size_t)(rowbase + T - 15 + (tid >> 5)) * P2W + (tid & 31) * 8);
            if (tid < 2 * 48) sw = *(const u32x4*)(P + (size_t)(rowbase + T - 2 + tid / 48) * P2W + 640 + (tid % 48) * 8);
#pragma unroll
            for (int q = 0; q < 3; ++q) { const int i = tid + 512 * q, sr = i / 48, o = i - sr * 48; const u32x4 w = cw[q];
                if (i < 30 * 48) { float* d = conv_out + sr * 384 + o * 8; *(f32x4*)d = (f32x4){bflo(w.x), bfhi(w.x), bflo(w.y), bfhi(w.y)}; *(f32x4*)(d + 4) = (f32x4){bflo(w.z), bfhi(w.z), bflo(w.w), bfhi(w.w)}; } }
            if (tid < 15 * 32) { float* d = pool_out + (tid >> 5) * 256 + (tid & 31) * 8; *(f32x4*)d = (f32x4){bflo(pw.x), bfhi(pw.x), bflo(pw.y), bfhi(pw.y)}; *(f32x4*)(d + 4) = (f32x4){bflo(pw.z), bfhi(pw.z), bflo(pw.w), bfhi(pw.w)}; }
            if (tid < 2 * 48) { float* d = sc_out + (tid / 48) * 384 + (tid % 48) * 8; *(f32x4*)d = (f32x4){bflo(sw.x), bfhi(sw.x), bflo(sw.y), bfhi(sw.y)}; *(f32x4*)(d + 4) = (f32x4){bflo(sw.z), bfhi(sw.z), bflo(sw.w), bfhi(sw.w)}; }
        } else if (t0 + 64 >= T) {
            for (int i = tid; i < 30 * 48; i += 512) { const int sr = i / 48, o = i - sr * 48, t = T - 30 + sr, c = o * 8; float* d = conv_out + sr * 384 + c;
                if (t >= 0) { const u32x4 w = *(const u32x4*)(P + (size_t)(rowbase + t) * P2W + 256 + c);
                    *(f32x4*)d = (f32x4){bflo(w.x), bfhi(w.x), bflo(w.y), bfhi(w.y)}; *(f32x4*)(d + 4) = (f32x4){bflo(w.z), bfhi(w.z), bflo(w.w), bfhi(w.w)}; }
                else { *(f32x4*)d = *(const f32x4*)(st_conv + (30 + t) * 384 + c); *(f32x4*)(d + 4) = *(const f32x4*)(st_conv + (30 + t) * 384 + c + 4); } }
            for (int i = tid; i < 15 * 32; i += 512) { const int sr = i >> 5, o = i & 31, t = T - 15 + sr, c = o * 8; float* d = pool_out + sr * 256 + c;
                if (t >= 0) { const u32x4 w = *(const u32x4*)(P + (size_t)(rowbase + t) * P2W + c);
                    *(f32x4*)d = (f32x4){bflo(w.x), bfhi(w.x), bflo(w.y), bfhi(w.y)}; *(f32x4*)(d + 4) = (f32x4){bflo(w.z), bfhi(w.z), bflo(w.w), bfhi(w.w)}; }
                else { *(f32x4*)d = *(const f32x4*)(st_pool + (15 + t) * 256 + c); *(f32x4*)(d + 4) = *(const f32x4*)(st_pool + (15 + t) * 256 + c + 4); } }
            for (int i = tid; i < 2 * 48; i += 512) { const int sr = i / 48, o = i - sr * 48, t = T - 2 + sr, c = o * 8; float* d = sc_out + sr * 384 + c;
                const u32x4 w = *(const u32x4*)(P + (size_t)(rowbase + t) * P2W + 640 + c);
                *(f32x4*)d = (f32x4){bflo(w.x), bfhi(w.x), bflo(w.y), bfhi(w.y)}; *(f32x4*)(d + 4) = (f32x4){bflo(w.z), bfhi(w.z), bflo(w.w), bfhi(w.w)}; }
        }
        if (tid < 384) {
            float w0[8], w1[8], w2[8];
            { const float* ws = a.in[I_WSC] + (size_t)l * 3 * 384 + cc;
#pragma unroll
              for (int e = 0; e < 8; ++e) { w0[e] = ws[e]; w1[e] = ws[384 + e]; w2[e] = ws[768 + e]; } }
            float up2[8], up1[8];
#pragma unroll
            for (int ps = 0; ps < 2; ++ps) {
                u32x4 vu[6], vg[4];
#pragma unroll
                for (int d = (ps ? 2 : 0); d < 6; ++d) { const int t = t0 + 8 * seg + 4 * ps + d - 2; vu[d] = (u32x4){0u, 0u, 0u, 0u};
                    if (t >= 0 && t < T) vu[d] = *(const u32x4*)(P + (size_t)(rowbase + t) * P2W + 640 + cc); }
#pragma unroll
                for (int d = 0; d < 4; ++d) { const int t = t0 + 8 * seg + 4 * ps + d; vg[d] = (u32x4){0u, 0u, 0u, 0u};
                    if (t < T) vg[d] = *(const u32x4*)(P + (size_t)(rowbase + t) * P2W + 1024 + cc); }
#pragma unroll
                for (int d = (ps ? 2 : 0); d < 6; ++d) {
                    const int t = t0 + 8 * seg + 4 * ps + d - 2;
                    float uc[8];
#pragma unroll
                    for (int e = 0; e < 4; ++e) { uc[2 * e] = bflo(vu[d][e]); uc[2 * e + 1] = bfhi(vu[d][e]); }
                    if (ps == 0 && d < 2 && smp && t < 0) { const f32x4 p0 = *(const f32x4*)(st_sc + (2 + t) * 384 + cc), p1 = *(const f32x4*)(st_sc + (2 + t) * 384 + cc + 4);
#pragma unroll
                        for (int e = 0; e < 4; ++e) { uc[e] = p0[e]; uc[4 + e] = p1[e]; } }
                    if (d >= 2) {
                        const u32x4 bv = vg[d - 2];
                        float y[8];
#pragma unroll
                        for (int e = 0; e < 4; ++e) {
                            y[2 * e] = bflo(bv[e]) * (w0[2 * e] * up2[2 * e] + w1[2 * e] * up1[2 * e] + w2[2 * e] * uc[2 * e]);
                            y[2 * e + 1] = bfhi(bv[e]) * (w0[2 * e + 1] * up2[2 * e + 1] + w1[2 * e + 1] * up1[2 * e + 1] + w2[2 * e + 1] * uc[2 * e + 1]); }
                        { u32x4 w; w.x = pk2(y[0], y[1]); w.y = pk2(y[2], y[3]); w.z = pk2(y[4], y[5]); w.w = pk2(y[6], y[7]);
                          *(u32x4*)(CAT + (size_t)(t < T ? rowbase + t : MR + (t & 63)) * D + 640 + cc) = w; }
                    }
#pragma unroll
                    for (int e = 0; e < 8; ++e) { if (ps == 1 || d >= 1) up2[e] = up1[e]; up1[e] = uc[e]; }
                }
            }
        }
        __syncthreads();
        f32x2 z[32];
        int tid2 = tid; asm volatile("" : "+v"(tid2));
        const int half = (tid2 >= 192) ? 1 : 0, p = tid2 - 192 * half;
        const bool rows_live = (t0 + 32 * half) < T;
        if (wave < 6 && (mode & 2) && rows_live) {
            f32x2 w[31];
            const float* wd = a.in[I_WDW] + (size_t)l * 31 * 384 + 2 * p;
#pragma unroll
            for (int j = 0; j < 31; ++j) w[j] = *(const f32x2*)(wd + j * 384);
            const f32x2 bb = *(const f32x2*)(a.in[I_BDW] + l * 384 + 2 * p);
#pragma unroll
            for (int i = 0; i < 32; ++i) z[i] = bb;
            const LAS unsigned* up = (const LAS unsigned*)Uc + (32 * half) * 192 + p;
            ConvLoop<0, 62>::run(z, w, up);
            float sv[32];
            { const bool up = (lane & 32) != 0;
#pragma unroll
              for (int i = 0; i < 32; ++i) { const f32x2 zl = z[i >> 1], zh = z[16 + (i >> 1)];
                  const float va_ = (i & 1) ? (zl[0] * zl[0] + zl[1] * zl[1]) : (zl[0] + zl[1]), vb_ = (i & 1) ? (zh[0] * zh[0] + zh[1] * zh[1]) : (zh[0] + zh[1]);
                  const float send = up ? va_ : vb_, keep = up ? vb_ : va_; sv[i] = keep + __shfl_xor(send, 32);
                  if ((i & 7) == 7) asm volatile("" ::: "memory"); } }
            tr_reduce_step<32>(sv, lane); tr_reduce_step<16>(sv, lane); tr_reduce_step<8>(sv, lane); tr_reduce_step<4>(sv, lane); tr_reduce_step<2>(sv, lane);
            ST[wave * 64 + lane] = sv[0];
        } else if (mode & 2) {
            const int fr = tid2 & 15, fq = (tid2 & 63) >> 4;
#pragma unroll 1
            for (int gi = 0; gi < 2; ++gi) {
                const int g = (wave == 6) ? (gi ? 3 : 0) : (gi ? 2 : 1), win = 2 << g;
                bf16x8 Wf[4][2];
#pragma unroll
                for (int nt = 0; nt < 4; ++nt)
#pragma unroll
                    for (int kk = 0; kk < 2; ++kk) { const float* wp = a.in[I_WPOOL] + (((size_t)l * 4 + g) * 64 + 32 * kk + 8 * fq) * 64 + 16 * nt + fr;
                        u32x4 q; q.x = pk2(wp[0], wp[64]); q.y = pk2(wp[128], wp[192]); q.z = pk2(wp[256], wp[320]); q.w = pk2(wp[384], wp[448]);
                        Wf[nt][kk] = __builtin_bit_cast(bf16x8, q); }
                f32x4 spv[4];
#pragma unroll
                for (int nt = 0; nt < 4; ++nt) spv[nt] = *(const f32x4*)(a.in[I_SPOOLW] + l * 256 + 64 * g + 16 * nt + 4 * fq);
#pragma unroll 1
                for (int mt = 0; mt < 4; ++mt) {
                    if (t0 + 16 * mt >= T) break;
                    const int i = 16 * mt + fr, r = i + 15;
                    const int pos = t0 + i + start; const float cnt = (float)((pos + 1 < win) ? pos + 1 : win); const float inv = 1.0f / cnt;
                    bf16x8 Af[2];
#pragma unroll
                    for (int kk = 0; kk < 2; ++kk) {
                        const LAS unsigned char* base = XaB + r * XA_PITCH + (64 * g + 32 * kk + 8 * fq) * 2;
                        float s[8];
#pragma unroll
                        for (int e = 0; e < 8; ++e) s[e] = 0.f;
                        for (int d = 0; d < win; ++d) { const u32x4 v = *(const LAS u32x4*)(base - d * XA_PITCH);
#pragma unroll
                            for (int e = 0; e < 4; ++e) { s[2 * e] += bflo(v[e]); s[2 * e + 1] += bfhi(v[e]); } }
                        const u32x4 cv = *(const LAS u32x4*)base;
                        u32x4 q;
#pragma unroll
                        for (int e = 0; e < 4; ++e) q[e] = pk2(s[2 * e] * inv - bflo(cv[e]), s[2 * e + 1] * inv - bfhi(cv[e]));
                        Af[kk] = __builtin_bit_cast(bf16x8, q);
                    }
                    const bool valid = (t0 + i) < T;
#pragma unroll
                    for (int nt = 0; nt < 4; ++nt) {
                        f32x4 acc = {0.f, 0.f, 0.f, 0.f};
                        acc = __builtin_amdgcn_mfma_f32_16x16x32_bf16(Wf[nt][0], Af[0], acc, 0, 0, 0);
                        acc = __builtin_amdgcn_mfma_f32_16x16x32_bf16(Wf[nt][1], Af[1], acc, 0, 0, 0);
                        const f32x4 sp = spv[nt];
                        u32x2 o; o.x = pk2(acc[0] * sp[0], acc[1] * sp[1]); o.y = pk2(acc[2] * sp[2], acc[3] * sp[3]);
                        *(u32x2*)(CAT + (size_t)(valid ? rowbase + t0 + i : MR + i) * D + 64 * g + 16 * nt + 4 * fq) = o;
                    }
                }
            }
        }
        __syncthreads();
        if (wave < 6 && (mode & 4) && rows_live) {
            f32x2 lg = *(const f32x2*)(a.in[I_LNG] + l * 384 + 2 * p), lb = *(const f32x2*)(a.in[I_LNB] + l * 384 + 2 * p);
            asm volatile("" : "+v"(lg), "+v"(lb));
            const float tot = ST[(3 * half) * 64 + lane] + ST[(3 * half + 1) * 64 + lane] + ST[(3 * half + 2) * 64 + lane];
            const float oth = __shfl_xor(tot, 1);
            const float s1 = (lane & 1) ? oth : tot, s2 = (lane & 1) ? tot : oth;
            const float mu_l = s1 * (1.0f / 384.0f); float var_l = s2 * (1.0f / 384.0f) - mu_l * mu_l; var_l = var_l > 0.f ? var_l : 0.f;
            const float rstd_l = __builtin_amdgcn_rsqf(var_l + EPS);
            const int trow = t0 + 32 * half;
            bf16* crow = CAT + (size_t)(rowbase + trow) * D + 256 + 2 * p;
            bf16* cdummy = CAT + (size_t)(MR + 32 * half) * D + 256 + 2 * p;
#pragma unroll
            for (int i = 0; i < 32; ++i) {
                const float mu = __builtin_bit_cast(float, __builtin_amdgcn_readlane(__builtin_bit_cast(int, mu_l), 2 * i));
                const float rstd = __builtin_bit_cast(float, __builtin_amdgcn_readlane(__builtin_bit_cast(int, rstd_l), 2 * i));
                const f32x2 sc2 = lg * rstd, of2 = lb - sc2 * mu;
                const f32x2 y = z[i] * sc2 + of2;
                *(unsigned*)((trow + i < T ? crow + (size_t)i * D : cdummy + (size_t)i * D)) = pk2(y[0] * sigmoid_f(y[0]), y[1] * sigmoid_f(y[1]));
            }
        }
    }
    __syncthreads();
}


__device__ __forceinline__ void sample_gemm(int kind, const bf16* A, const bf16* Bt, int NT, int K, bf16* O, int ldc) {
    int tid = threadIdx.x; asm volatile("" : "+v"(tid));
    const int lane = tid & 63, wave = __builtin_amdgcn_readfirstlane(tid >> 6), fr = lane & 15, fq = lane >> 4;
    const int gw = blockIdx.x * 8 + wave, NGW = gridDim.x * 8, ntask = NT * 64;
    for (int task = gw; task < ntask; task += NGW) {
        const int mt = task & 7, sb = (task >> 3) & 7, pn = task >> 6;
        const bf16* ap = A + (size_t)(mt * 16 + fr) * K + 8 * fq;
        const bf16* bp0 = Bt + (size_t)(256 * pn + 16 * sb + fr) * K + 8 * fq;
        const bf16* bp1 = bp0 + (size_t)128 * K;
        f32x4 acc0 = {0.f, 0.f, 0.f, 0.f}, acc1 = {0.f, 0.f, 0.f, 0.f};
        bf16x8 fa[4], fb0[4], fb1[4], ga[4], gb0[4], gb1[4];
#pragma unroll
        for (int j = 0; j < 4; ++j) { fa[j] = *(const bf16x8*)(ap + 32 * j); fb0[j] = *(const bf16x8*)(bp0 + 32 * j); fb1[j] = *(const bf16x8*)(bp1 + 32 * j); }
#pragma unroll 1
        for (int k0 = 0; k0 < K; k0 += 256) {
#pragma unroll
            for (int j = 0; j < 4; ++j) { ga[j] = *(const bf16x8*)(ap + k0 + 128 + 32 * j); gb0[j] = *(const bf16x8*)(bp0 + k0 + 128 + 32 * j); gb1[j] = *(const bf16x8*)(bp1 + k0 + 128 + 32 * j); }
#pragma unroll
            for (int j = 0; j < 4; ++j) { acc0 = __builtin_amdgcn_mfma_f32_16x16x32_bf16(fb0[j], fa[j], acc0, 0, 0, 0); acc1 = __builtin_amdgcn_mfma_f32_16x16x32_bf16(fb1[j], fa[j], acc1, 0, 0, 0); }
            const int kn = (k0 + 256 < K) ? k0 + 256 : k0;
#pragma unroll
            for (int j = 0; j < 4; ++j) { fa[j] = *(const bf16x8*)(ap + kn + 32 * j); fb0[j] = *(const bf16x8*)(bp0 + kn + 32 * j); fb1[j] = *(const bf16x8*)(bp1 + kn + 32 * j); }
#pragma unroll
            for (int j = 0; j < 4; ++j) { acc0 = __builtin_amdgcn_mfma_f32_16x16x32_bf16(gb0[j], ga[j], acc0, 0, 0, 0); acc1 = __builtin_amdgcn_mfma_f32_16x16x32_bf16(gb1[j], ga[j], acc1, 0, 0, 0); }
        }
        bf16* orow = O + (size_t)(mt * 16 + fr) * ldc + 16 * sb + 4 * fq;
        int mode = 0, col = 256 * pn;
        if (kind == 0) { if (pn == 0) col = 0; else if (pn >= 7) { col = 1024 + (pn - 7) * 256; if (pn == 8) mode = 1; } else if (pn <= 3) { mode = 2; col = 256 + (pn - 1) * 128; } else { mode = 3; col = 640 + (pn - 4) * 128; } }
        else if (kind == 2) { mode = 4; col = 128 * pn; }
        if (mode <= 1) {
            u32x2 o; o.x = pk2(acc0[0], acc0[1]); o.y = pk2(acc0[2], acc0[3]); *(u32x2*)(orow + col) = o;
            if (mode == 0) { u32x2 q; q.x = pk2(acc1[0], acc1[1]); q.y = pk2(acc1[2], acc1[3]); *(u32x2*)(orow + col + 128) = q; }
        } else {
            f32x4 r;
#pragma unroll
            for (int e = 0; e < 4; ++e) r[e] = (mode == 2) ? acc0[e] * sigmoid_f(acc1[e]) : (mode == 3) ? acc0[e] * acc1[e] : acc0[e] * sigmoid_f(acc0[e]) * acc1[e];
            u32x2 o; o.x = pk2(r[0], r[1]); o.y = pk2(r[2], r[3]); *(u32x2*)(orow + col) = o;
        }
    }
}

constexpr int NPH = 16;
__global__ void __launch_bounds__(512) mega_fwd(Args a) {
    extern __shared__ __attribute__((aligned(16))) unsigned char lds_raw[];
    LAS unsigned char* lds = (LAS unsigned char*)lds_raw;
    cg::grid_group grid = cg::this_grid();
#if ONE_LAUNCH
    volatile LAS unsigned* xst = (volatile LAS unsigned*)(lds + 131072 + 256);
    if (threadIdx.x < 2) xst[threadIdx.x] = 0u;
    __syncthreads();
    const XcdBarrier xbar = xcd_barrier_post((unsigned*)a.ws, xst);
#endif
    bf16* H = (bf16*)(a.ws + WS_H); bf16* Y = (bf16*)(a.ws + WS_Y); bf16* P = (bf16*)(a.ws + WS_P); bf16* CAT = (bf16*)(a.ws + WS_CAT); bf16* ACT = (bf16*)(a.ws + WS_ACT);
#ifdef SYNC_PROBE
    for (int i_ = 0; i_ < SYNC_PROBE; ++i_) grid.sync();
#endif
    for (int ph = a.ph_lo; ph < a.ph_hi; ++ph) {
#ifdef DUP_MASK
      const int kk_ = ph < 2 ? ph + 7 : (ph - 2) % 7;
      const int nrep_ = ((DUP_MASK >> kk_) & 1) ? 2 : 1;
      for (int rep_ = 0; rep_ < nrep_; ++rep_) {
        if (rep_) grid.sync();
#endif
        if (ph == 0) {
#ifndef SKIP_P0
            p0_prologue(a, lds);
#endif
        }
        else if (ph == 1) {
#ifndef SKIP_ROW
            row_phase<0>(a, true, 0, 0, nullptr, 0, 0, a.in[I_GPREMIX]);
#endif
        }
        else {
            const int l = (ph - 2) / 7, k = (ph - 2) % 7;
            const unsigned char* wl = a.ws + WS_W + (size_t)l * WL_SZ;
            if (k == 0 || k == 2 || k == 4 || k == 5) {
                const bf16* sA; const bf16* sB; bf16* sO; int sNT, sK, sld, skind;
                if (k == 0) {
                    pg8::Gemm g{H, (const bf16*)(wl + WL_IN), MP, INWP, D}; pg8::EpiInProj E{P, P2W};
                    pg8::StaticOrder S; S.init(g.M, g.N, gridDim.x, blockIdx.x);
                    pg8::gemm_phase<pg8::EpiInProj, pg8::StaticOrder, true, true>(lds, g, S, E);
                    sA = H; sB = g.Bt; sO = P; sNT = INWP / 256; sK = D; sld = P2W; skind = 0;
                } else if (k == 4) {
#ifndef SKIP_G3
                    pg8::Gemm g{H, (const bf16*)(wl + WL_GU), MP, NGU, D}; pg8::EpiSwiGLU E{ACT, DFF};
                    pg8::StaticOrder S; S.init(g.M, g.N, gridDim.x, blockIdx.x);
                    pg8::gemm_phase<pg8::EpiSwiGLU, pg8::StaticOrder, true, true>(lds, g, S, E);
#endif
                    sA = H; sB = (const bf16*)(wl + WL_GU); sO = ACT; sNT = NGU / 256; sK = D; sld = DFF; skind = 2;
                } else {
#ifndef SKIP_G1
                    pg8::Gemm g; pg8::EpiBf16 E;
                    if (k == 2) { g = pg8::Gemm{CAT, (const bf16*)(wl + WL_OUT), MP, D, D}; E = pg8::EpiBf16{Y, D}; }
                    else { g = pg8::Gemm{ACT, (const bf16*)(wl + WL_DN), MP, D, DFF}; E = pg8::EpiBf16{Y, D}; }
                    pg8::StaticOrder S; S.init(g.M, g.N, gridDim.x, blockIdx.x);
                    pg8::gemm_phase<pg8::EpiBf16, pg8::StaticOrder, true, true>(lds, g, S, E);
#endif
                    sA = (k == 2) ? CAT : ACT; sB = (const bf16*)(wl + (k == 2 ? WL_OUT : WL_DN)); sO = Y; sNT = D / 256; sK = (k == 2) ? D : DFF; sld = D; skind = 1;
                }
                sample_gemm(skind, sA + (size_t)MP * sK, sB, sNT, sK, sO + (size_t)MP * sld, sld);
            } else if (k == 1) {
#ifndef SKIP_MIX
#ifdef MIX_PROBE
                for (int rep = 0; rep < 2; ++rep) { int md = rep ? 7 : MIX_PROBE; asm volatile("" : "+s"(md)); mixer_phase(a, l, lds, md); if (rep == 0) grid.sync(); }
#else
                mixer_phase(a, l, lds);
#endif
#endif
            }
            else if (k == 3) {
#ifndef SKIP_ROW
                row_phase<1>(a, l == 0, l, 2, a.in[I_GPOSTMIX] + l * D, l, 3, a.in[I_GPREFFN] + l * D);
#endif
            }
            else {
#ifndef SKIP_ROW
                if (l == 0) row_phase<1>(a, false, 0, 5, a.in[I_GPOSTFFN], 1, 0, a.in[I_GPREMIX] + D);
                else row_phase<2>(a, false, 1, 5, a.in[I_GPOSTFFN] + D, 1, 0, nullptr);
#endif
            }
        }
#ifdef DUP_MASK
      }
#endif
#if ONE_LAUNCH
        if (ph + 1 < a.ph_hi) { if (a.ph_lo != 0) grid.sync(); else xcd_barrier(xbar); }
#else
        if (ph + 1 < a.ph_hi) grid.sync();
#endif
    }
}

extern "C" void kernel_launch(void* const* d_in, const int* in_sizes, int n_in, void* d_out, int out_size, void* d_ws, size_t ws_size, hipStream_t stream) {
    static int grid = 0;
    if (grid == 0) {
        if (n_in != 25 || ws_size < WS_END) { fprintf(stderr, "kernel_launch: unexpected n_in %d / ws_size %zu\n", n_in, ws_size); grid = -1; return; }
        int dev = 0, cus = 0, per_cu = 0;
        hipGetDevice(&dev); hipDeviceGetAttribute(&cus, hipDeviceAttributeMultiprocessorCount, dev);
        if (hipFuncSetAttribute((const void*)mega_fwd, hipFuncAttributeMaxDynamicSharedMemorySize, LDS_BYTES) != hipSuccess) { fprintf(stderr, "kernel_launch: hipFuncSetAttribute failed\n"); grid = -1; return; }
        if (hipOccupancyMaxActiveBlocksPerMultiprocessor(&per_cu, (const void*)mega_fwd, 512, LDS_BYTES) != hipSuccess || per_cu < 1) { fprintf(stderr, "kernel_launch: occupancy query gave %d\n", per_cu); per_cu = 1; }
        (void)hipGetLastError();
        grid = cus;
    }
    if (grid < 0) return;
    Args a{};
    for (int i = 0; i < 25; ++i) a.in[i] = (const float*)d_in[i];
    a.out = (float*)d_out; a.ws = (unsigned char*)d_ws;
#if ONE_LAUNCH
    if (hipMemsetAsync(d_ws, 0, 16384, stream) != hipSuccess) { fprintf(stderr, "kernel_launch: memset of the barrier words failed\n"); return; }
    a.ph_lo = 0; a.ph_hi = NPH;
    void* args[] = {&a};
    hipError_t e = hipLaunchCooperativeKernel((const void*)mega_fwd, dim3(grid), dim3(512), args, LDS_BYTES, stream);
    if (e != hipSuccess) fprintf(stderr, "cooperative launch failed: %s (grid %d)\n", hipGetErrorString(e), grid);
#else
    (void)hipMemsetAsync(d_ws, 0, 16384, stream);
    for (int ph = 0; ph < NPH; ++ph) { a.ph_lo = ph; a.ph_hi = ph + 1; hipLaunchKernelGGL(mega_fwd, dim3(grid), dim3(512), LDS_BYTES, stream, a); }
#endif
}
```

```cpp
#include <hip/hip_runtime.h>
#include <hip/hip_cooperative_groups.h>
#include <cstdio>
#include <cstdint>
namespace cg = cooperative_groups;

#ifndef ONE_LAUNCH
#define ONE_LAUNCH 1
#endif

namespace pg8 {
#define PG8_LAS __attribute__((address_space(3)))
typedef unsigned short bf16_t;
typedef short bf16x8 __attribute__((ext_vector_type(8)));
typedef float f32x4 __attribute__((ext_vector_type(4)));
typedef unsigned u32x4 __attribute__((ext_vector_type(4)));
constexpr int BM = 256, BK = 64, HALF = 128, HTB = HALF * BK * 2, STAGE_BYTES = 8 * HTB, NXCD = 8, WGM = 4;

__host__ __device__ __forceinline__ int lds_byte(int r, int c) { const int st = (r >> 4) * 2 + (c >> 5), rr = r & 15, cc = c & 31, ob = rr * 64 + cc * 2; return st * 1024 + (ob ^ (((ob >> 9) & 1) << 5)); }
__host__ __device__ __forceinline__ void stage_rc(int b, int& R, int& C) { const int st = b / 1024, sb = b % 1024, swz = sb ^ (((sb >> 9) & 1) << 5); R = (st >> 1) * 16 + swz / 64; C = (st & 1) * 32 + (swz % 64) / 2; }
__host__ __device__ __forceinline__ int perm32(int rho) { const int n = rho >> 4, i = rho & 15; return 8 * (i >> 2) + 4 * n + (i & 3); }

struct Unit { int pm, pn; };
struct Gemm { const bf16_t* A; const bf16_t* Bt; int M, N, K; };

struct StaticOrder {
    int nM, nN, nwg, G, c;
    __host__ __device__ void init(int M, int N, int G_, int c_) { nM = M / BM; nN = N / BM; nwg = nM * nN; G = G_; c = c_; }
    __host__ __device__ bool next(int i, Unit& u) const {
        const long L = (long)i * G + c; if (L >= nwg) return false;
        int wgid = (int)L; { const int q = nwg / NXCD, r = nwg % NXCD, xcd = wgid % NXCD, off = wgid / NXCD; wgid = (xcd < r ? xcd * (q + 1) : r * (q + 1) + (xcd - r) * q) + off; }
        const int nig = WGM * nN, gid = wgid / nig, fm = gid * WGM, gsz = (nM - fm) < WGM ? (nM - fm) : WGM;
        u.pm = fm + ((wgid % nig) % gsz); u.pn = (wgid % nig) / gsz; return true;
    }
    __device__ __forceinline__ void a_ready(const Unit&) const {}
    __device__ __forceinline__ void done(const Unit&) const {}
};

__device__ __forceinline__ unsigned cvt_pk_bf16(float lo, float hi) { unsigned r; asm volatile("v_cvt_pk_bf16_f32 %0, %1, %2" : "=v"(r) : "v"(lo), "v"(hi)); return r; }

struct EpiBf16 {
    static constexpr bool PERM = true, AFTER_DRAIN = false;
    bf16_t* O; int ldc;
    __device__ __forceinline__ void operator()(const f32x4 (&acc)[2][2][4][2], const Unit& u, int wr, int wc, int fr, int fq) const {
        const int row0 = u.pm * BM + wr * 64 + fr; const int col0 = u.pn * BM + wc * 32 + 8 * fq;
#pragma unroll
        for (int ai = 0; ai < 2; ++ai)
#pragma unroll
            for (int m = 0; m < 4; ++m) { bf16_t* rowp = O + (size_t)(row0 + ai * HALF + m * 16) * ldc + col0;
#pragma unroll
                for (int bj = 0; bj < 2; ++bj) { const f32x4 v0 = acc[ai][bj][m][0], v1 = acc[ai][bj][m][1];
                    u32x4 w; w.x = cvt_pk_bf16(v0[0], v0[1]); w.y = cvt_pk_bf16(v0[2], v0[3]); w.z = cvt_pk_bf16(v1[0], v1[1]); w.w = cvt_pk_bf16(v1[2], v1[3]);
                    *(u32x4*)(rowp + bj * HALF) = w; } }
    }
};
__device__ __forceinline__ float silu_f(float g) { return g * __builtin_amdgcn_rcpf(1.0f + __builtin_amdgcn_exp2f(-1.44269504089f * g)); }
struct EpiSwiGLU {
    static constexpr bool PERM = true, AFTER_DRAIN = false;
    bf16_t* O; int ldc;
    __device__ __forceinline__ void operator()(const f32x4 (&acc)[2][2][4][2], const Unit& u, int wr, int wc, int fr, int fq) const {
        const int row0 = u.pm * BM + wr * 64 + fr; const int col0 = u.pn * HALF + wc * 32 + 8 * fq;
#pragma unroll
        for (int ai = 0; ai < 2; ++ai)
#pragma unroll
            for (int m = 0; m < 4; ++m) { bf16_t* rowp = O + (size_t)(row0 + ai * HALF + m * 16) * ldc + col0;
                const f32x4 g0 = acc[ai][0][m][0], g1 = acc[ai][0][m][1], u0 = acc[ai][1][m][0], u1 = acc[ai][1][m][1];
                u32x4 w;
                w.x = cvt_pk_bf16(silu_f(g0[0]) * u0[0], silu_f(g0[1]) * u0[1]); w.y = cvt_pk_bf16(silu_f(g0[2]) * u0[2], silu_f(g0[3]) * u0[3]);
                w.z = cvt_pk_bf16(silu_f(g1[0]) * u1[0], silu_f(g1[1]) * u1[1]); w.w = cvt_pk_bf16(silu_f(g1[2]) * u1[2], silu_f(g1[3]) * u1[3]);
                *(u32x4*)rowp = w; asm volatile("" ::: "memory"); }
    }
};

__device__ __forceinline__ float sigm_f(float g) { return __builtin_amdgcn_rcpf(1.0f + __builtin_amdgcn_exp2f(-1.44269504089f * g)); }
struct EpiInProj {
    static constexpr bool PERM = true, AFTER_DRAIN = false;
    bf16_t* O; int ldc;
    __device__ __forceinline__ void operator()(const f32x4 (&acc)[2][2][4][2], const Unit& u, int wr, int wc, int fr, int fq) const {
        const int row0 = u.pm * BM + wr * 64 + fr; const int cl = wc * 32 + 8 * fq; const int pn = u.pn;
        if (pn == 0 || pn >= 7) {
            const int col0 = (pn == 0 ? 0 : 1024 + (pn - 7) * 256) + cl;
#pragma unroll
            for (int ai = 0; ai < 2; ++ai)
#pragma unroll
                for (int m = 0; m < 4; ++m) { bf16_t* rowp = O + (size_t)(row0 + ai * HALF + m * 16) * ldc + col0;
#pragma unroll
                    for (int bj = 0; bj < 2; ++bj) { const f32x4 v0 = acc[ai][bj][m][0], v1 = acc[ai][bj][m][1];
                        u32x4 w; w.x = cvt_pk_bf16(v0[0], v0[1]); w.y = cvt_pk_bf16(v0[2], v0[3]); w.z = cvt_pk_bf16(v1[0], v1[1]); w.w = cvt_pk_bf16(v1[2], v1[3]);
                        if (bj == 0 || pn != 8) *(u32x4*)(rowp + bj * HALF) = w; } }
        } else {
            const bool glu = pn <= 3; const int col0 = (glu ? 256 + (pn - 1) * 128 : 640 + (pn - 4) * 128) + cl;
#pragma unroll
            for (int ai = 0; ai < 2; ++ai)
#pragma unroll
                for (int m = 0; m < 4; ++m) { bf16_t* rowp = O + (size_t)(row0 + ai * HALF + m * 16) * ldc + col0;
                    const f32x4 a0 = acc[ai][0][m][0], a1 = acc[ai][0][m][1]; f32x4 g0 = acc[ai][1][m][0], g1 = acc[ai][1][m][1];
                    if (glu) {
#pragma unroll
                        for (int e = 0; e < 4; ++e) { g0[e] = sigm_f(g0[e]); g1[e] = sigm_f(g1[e]); } }
                    u32x4 w; w.x = cvt_pk_bf16(a0[0] * g0[0], a0[1] * g0[1]); w.y = cvt_pk_bf16(a0[2] * g0[2], a0[3] * g0[3]);
                    w.z = cvt_pk_bf16(a1[0] * g1[0], a1[1] * g1[1]); w.w = cvt_pk_bf16(a1[2] * g1[2], a1[3] * g1[3]);
                    *(u32x4*)rowp = w; asm volatile("" ::: "memory"); }
        }
    }
};

template <class Epi, class Sched, bool ALIGN_EPI = false, bool SP2 = false>
__device__ __forceinline__ void gemm_phase(PG8_LAS unsigned char* lds, const Gemm g, const Sched& S, const Epi& E) {
    int tid_ = threadIdx.x; asm volatile("" : "+v"(tid_));
    const int tid = tid_, wid = __builtin_amdgcn_readfirstlane(tid >> 6), lane = tid & 63, wr = wid >> 2, wc = wid & 3, fr = lane & 15, fq = lane >> 4;
    const int K = g.K, nt = K / BK;
    unsigned voffA[2], voffB[2];
#pragma unroll
    for (int i = 0; i < 2; ++i) { int R, C; stage_rc(tid * 16 + i * 8192, R, C); const int Rb = Epi::PERM ? ((R & ~31) + perm32(R & 31)) : R;
        voffA[i] = (unsigned)(R * K + C) * 2u; voffB[i] = (unsigned)(Rb * K + C) * 2u; }
    const size_t kstep = (size_t)(BK * 2);
    const size_t hstep = (size_t)HALF * K * 2;
    const size_t tstep = 2 * hstep;
    const unsigned ldsw = (unsigned)wid * 1024u;
    const int aoff = lds_byte(wr * 64 + fr, fq * 8), boff = lds_byte(wc * 32 + fr, fq * 8);
#define PG8_SA(b, h) (((b) * 2 + (h)) * HTB)
#define PG8_SB(b, h) ((4 + (b) * 2 + (h)) * HTB)
#define PG8_STAGE(bufoff, gbase, voff) do { _Pragma("unroll") for (int _i = 0; _i < 2; ++_i) \
        __builtin_amdgcn_global_load_lds((const unsigned*)((const char*)(gbase) + (voff)[_i]), (PG8_LAS unsigned*)(lds + (bufoff) + ldsw + _i * 8192), 16, 0, 0); } while (0)
#define PG8_LDA(dst, b, h) do { _Pragma("unroll") for (int m = 0; m < 4; ++m) _Pragma("unroll") for (int k = 0; k < 2; ++k) dst[m][k] = *(const PG8_LAS bf16x8*)(lds + PG8_SA(b, h) + aoff + m * 2048 + k * 1024); } while (0)
#define PG8_LDB(dst, b, h) do { _Pragma("unroll") for (int n = 0; n < 2; ++n) _Pragma("unroll") for (int k = 0; k < 2; ++k) dst[n][k] = *(const PG8_LAS bf16x8*)(lds + PG8_SB(b, h) + boff + n * 2048 + k * 1024); } while (0)
#define PG8_MMA(ai, bj, At, Bt) do { __builtin_amdgcn_s_setprio(1); _Pragma("unroll") for (int m = 0; m < 4; ++m) _Pragma("unroll") for (int n = 0; n < 2; ++n) _Pragma("unroll") for (int k = 0; k < 2; ++k) \
        acc[ai][bj][m][n] = __builtin_amdgcn_mfma_f32_16x16x32_bf16(Bt[n][k], At[m][k], acc[ai][bj][m][n], 0, 0, 0); __builtin_amdgcn_s_setprio(0); } while (0)
#define PG8_WAIT_V(n) asm volatile("s_waitcnt vmcnt(" #n ")" ::: "memory")
#define PG8_WAIT_L(n) asm volatile("s_waitcnt lgkmcnt(" #n ")" ::: "memory")
#define PG8_BAR __builtin_amdgcn_s_barrier()
#define PG8_SCHED __builtin_amdgcn_sched_barrier(0)
    Unit cur, nxt; int ui = 0;
    if (!S.next(0, cur)) return;
#ifdef STAGGER_TICKS
    {
        const unsigned long long t0_ = __builtin_amdgcn_s_memrealtime(); const unsigned long long dl_ = (unsigned long long)((blockIdx.x >> 3) & 7) * STAGGER_TICKS;
        while (__builtin_amdgcn_s_memrealtime() - t0_ < dl_) __builtin_amdgcn_s_sleep(8);
    }
#endif
    f32x4 acc[2][2][4][2];
#pragma unroll
    for (int a = 0; a < 2; ++a)
#pragma unroll
        for (int b = 0; b < 2; ++b)
#pragma unroll
            for (int m = 0; m < 4; ++m)
#pragma unroll
                for (int n = 0; n < 2; ++n) acc[a][b][m][n] = (f32x4){0.f, 0.f, 0.f, 0.f};
    bf16x8 At[4][2], B0[2][2], B1[2][2];
    const char* cA = (const char*)g.A + (size_t)cur.pm * tstep; const char* cB = (const char*)g.Bt + (size_t)cur.pn * tstep;
    S.a_ready(cur);
    if constexpr (SP2) {
        PG8_STAGE(PG8_SB(0, 0), cB, voffB); PG8_STAGE(PG8_SB(0, 1), cB + hstep, voffB); PG8_STAGE(PG8_SA(0, 0), cA, voffA); PG8_STAGE(PG8_SA(0, 1), cA + hstep, voffA);
        if (wr == 1) PG8_BAR;
        PG8_WAIT_V(2); PG8_BAR;
        PG8_STAGE(PG8_SB(1, 0), cB + kstep, voffB); PG8_STAGE(PG8_SA(1, 0), cA + kstep, voffA); PG8_STAGE(PG8_SB(1, 1), cB + hstep + kstep, voffB);
        PG8_WAIT_V(6); PG8_BAR;
    } else {
        PG8_STAGE(PG8_SB(0, 0), cB, voffB); PG8_STAGE(PG8_SA(0, 0), cA, voffA); PG8_STAGE(PG8_SB(0, 1), cB + hstep, voffB); PG8_STAGE(PG8_SA(0, 1), cA + hstep, voffA);
        if (wr == 1) PG8_BAR;
        PG8_WAIT_V(4); PG8_BAR;
        PG8_STAGE(PG8_SB(1, 0), cB + kstep, voffB); PG8_STAGE(PG8_SA(1, 0), cA + kstep, voffA); PG8_STAGE(PG8_SB(1, 1), cB + hstep + kstep, voffB);
        PG8_WAIT_V(6); PG8_BAR;
    }
    for (;;) {
        const bool has_next = S.next(ui + 1, nxt);
        const char* nA = has_next ? (const char*)g.A + (size_t)nxt.pm * tstep : cA; const char* nB = has_next ? (const char*)g.Bt + (size_t)nxt.pn * tstep : cB;
        for (int t = 0; t < nt; t += 2) {
            const bool last = (t == nt - 2);
            const char* a1 = cA + (size_t)(t + 1) * kstep;
            const char* a2 = last ? nA : cA + (size_t)(t + 2) * kstep; const char* b2 = last ? nB : cB + (size_t)(t + 2) * kstep;
            const char* a3 = a2 + kstep; const char* b3 = b2 + kstep;
            if (last && has_next) S.a_ready(nxt);
            if constexpr (SP2) {
            PG8_LDB(B0, 0, 0); PG8_LDB(B1, 0, 1); PG8_SCHED; PG8_LDA(At, 0, 0); PG8_STAGE(PG8_SA(1, 1), a1 + hstep, voffA);
            PG8_WAIT_V(8); PG8_WAIT_L(0); PG8_BAR; PG8_MMA(0, 0, At, B0); PG8_MMA(0, 1, At, B1); PG8_BAR; PG8_SCHED;
            PG8_LDA(At, 0, 1); PG8_STAGE(PG8_SB(0, 0), b2, voffB); PG8_STAGE(PG8_SB(0, 1), b2 + hstep, voffB); PG8_STAGE(PG8_SA(0, 0), a2, voffA);
            PG8_WAIT_V(8); PG8_WAIT_L(0); PG8_BAR; PG8_MMA(1, 0, At, B0); PG8_MMA(1, 1, At, B1); PG8_BAR; PG8_SCHED;
            PG8_LDB(B0, 1, 0); PG8_LDB(B1, 1, 1); PG8_SCHED; PG8_LDA(At, 1, 0); PG8_STAGE(PG8_SA(0, 1), a2 + hstep, voffA);
            PG8_WAIT_V(8); PG8_WAIT_L(0); PG8_BAR; PG8_MMA(0, 0, At, B0); PG8_MMA(0, 1, At, B1); PG8_BAR; PG8_SCHED;
            PG8_LDA(At, 1, 1); PG8_STAGE(PG8_SB(1, 0), b3, voffB); PG8_STAGE(PG8_SB(1, 1), b3 + hstep, voffB); PG8_STAGE(PG8_SA(1, 0), a3, voffA);
            PG8_WAIT_V(8); PG8_WAIT_L(0); PG8_BAR; PG8_MMA(1, 0, At, B0); PG8_MMA(1, 1, At, B1); PG8_BAR; PG8_SCHED;
            } else {
            PG8_LDB(B0, 0, 0); PG8_SCHED; PG8_LDA(At, 0, 0); PG8_STAGE(PG8_SA(1, 1), a1 + hstep, voffA);
            PG8_WAIT_L(8); PG8_BAR; PG8_WAIT_L(0); PG8_MMA(0, 0, At, B0); PG8_BAR; PG8_SCHED;
            PG8_LDB(B1, 0, 1); PG8_STAGE(PG8_SB(0, 0), b2, voffB);
            PG8_BAR; PG8_WAIT_L(0); PG8_MMA(0, 1, At, B1); PG8_BAR;
            PG8_LDA(At, 0, 1); PG8_STAGE(PG8_SA(0, 0), a2, voffA);
            PG8_BAR; PG8_WAIT_L(0); PG8_MMA(1, 0, At, B0); PG8_BAR; PG8_SCHED;
            PG8_STAGE(PG8_SB(0, 1), b2 + hstep, voffB);
            PG8_WAIT_V(6); PG8_BAR; PG8_MMA(1, 1, At, B1); PG8_BAR;
            PG8_LDB(B0, 1, 0); PG8_SCHED; PG8_LDA(At, 1, 0); PG8_STAGE(PG8_SA(0, 1), a2 + hstep, voffA);
            PG8_WAIT_L(8); PG8_BAR; PG8_WAIT_L(0); PG8_MMA(0, 0, At, B0); PG8_BAR; PG8_SCHED;
            PG8_LDB(B1, 1, 1); PG8_STAGE(PG8_SB(1, 0), b3, voffB);
            PG8_BAR; PG8_WAIT_L(0); PG8_MMA(0, 1, At, B1); PG8_BAR;
            PG8_LDA(At, 1, 1); PG8_STAGE(PG8_SA(1, 0), a3, voffA);
            PG8_BAR; PG8_WAIT_L(0); PG8_MMA(1, 0, At, B0); PG8_BAR; PG8_SCHED;
            PG8_STAGE(PG8_SB(1, 1), b3 + hstep, voffB);
            PG8_WAIT_V(6); PG8_BAR; PG8_MMA(1, 1, At, B1); PG8_BAR;
            }
        }
        if constexpr (ALIGN_EPI) { if (wr == 0) PG8_BAR; }
        if constexpr (!Epi::AFTER_DRAIN) { E(acc, cur, wr, wc, fr, fq); S.done(cur); }
        if (!has_next) break;
#pragma unroll
        for (int a = 0; a < 2; ++a)
#pragma unroll
            for (int b = 0; b < 2; ++b)
#pragma unroll
                for (int m = 0; m < 4; ++m)
#pragma unroll
                    for (int n = 0; n < 2; ++n) acc[a][b][m][n] = (f32x4){0.f, 0.f, 0.f, 0.f};
        cur = nxt; cA = nA; cB = nB; ++ui;
        if constexpr (ALIGN_EPI) { if (wr == 1) PG8_BAR; }
    }
    PG8_WAIT_V(0);
    if constexpr (!ALIGN_EPI) { if (wr == 0) PG8_BAR; }
    PG8_BAR;
#undef PG8_SA
#undef PG8_SB
#undef PG8_STAGE
#undef PG8_LDA
#undef PG8_LDB
#undef PG8_MMA
#undef PG8_WAIT_V
#undef PG8_WAIT_L
#undef PG8_BAR
#undef PG8_SCHED
}
}

#define LAS __attribute__((address_space(3)))
typedef unsigned short bf16;
typedef float f32x4 __attribute__((ext_vector_type(4)));
typedef float f32x2 __attribute__((ext_vector_type(2)));
typedef unsigned u32x4 __attribute__((ext_vector_type(4)));
typedef unsigned u32x2 __attribute__((ext_vector_type(2)));
typedef short bf16x8 __attribute__((ext_vector_type(8)));

constexpr int D = 1024, NB = 32, T_P = 2048, NDB = 8, T_S = 16, PASTLEN = 4096;
constexpr int MP = NB * T_P;
constexpr int MS = NDB * T_S;
constexpr int MR = MP + MS;
constexpr int MPAD = 257 * 256;
constexpr int INW = 2176, INWP = 2304, DFF = 2816, NGU = 2 * DFF;
constexpr int PW = 256, CW = 384, SW = 384, P2W = 1408;
constexpr float EPS = 1e-6f;
constexpr int NMODR = NB + NDB;
constexpr int KCH = 8;

constexpr size_t O_YP = 0, O_YS = (size_t)MP * D, O_POOLP = O_YS + (size_t)MS * D, O_CONVP = O_POOLP + 2 * 32 * 15 * 256,
                 O_SCP = O_CONVP + 2 * 32 * 30 * 384, O_POOLS = O_SCP + 2 * 32 * 2 * 384, O_CONVS = O_POOLS + 2 * 8 * 15 * 256, O_SCS = O_CONVS + 2 * 8 * 30 * 384;
constexpr size_t MiB = 1u << 20;
constexpr size_t WL_IN = 0, WL_OUT = (size_t)INWP * D * 2, WL_GU = WL_OUT + (size_t)D * D * 2, WL_DN = WL_GU + (size_t)NGU * D * 2, WL_SZ = WL_DN + (size_t)D * DFF * 2;
static_assert(WL_SZ == 23 * MiB, "weight block");
constexpr size_t WS_W = 2 * MiB, WS_PART = 48 * MiB, WS_H = 64 * MiB, WS_Y = 193 * MiB, WS_P = 322 * MiB, WS_CAT = 612 * MiB, WS_ACT = WS_P, WS_XB = 741 * MiB, WS_END = 870 * MiB;
static_assert(WS_PART + (size_t)2 * NMODR * 6144 * 4 <= WS_H && WS_H + (size_t)MPAD * D * 2 <= WS_Y && WS_Y + (size_t)MPAD * D * 2 <= WS_P && WS_P + (size_t)MPAD * INWP * 2 <= WS_CAT && WS_CAT + (size_t)MPAD * D * 2 <= WS_XB && WS_ACT + (size_t)MPAD * DFF * 2 <= WS_XB && WS_XB + (size_t)MR * D * 2 <= WS_END, "ws map");

constexpr int LDS_BYTES = 147456;

struct Args { const float* in[25]; float* out; unsigned char* ws; int ph_lo, ph_hi; };
enum { I_XP = 0, I_XS, I_CP, I_CS, I_SPOOL, I_SCONV, I_SSC, I_WADA, I_BADA, I_GPREMIX, I_GPOSTMIX, I_GPREFFN, I_GPOSTFFN, I_WIN, I_WPOOL, I_SPOOLW, I_WDW, I_BDW, I_LNG, I_LNB, I_WSC, I_WOUT, I_WGATE, I_WUP, I_WDOWN };

__device__ __forceinline__ unsigned f2bf(float f) { unsigned u = __builtin_bit_cast(unsigned, f); return (u + 0x7fffu + ((u >> 16) & 1u)) >> 16; }
__device__ __forceinline__ unsigned pk2(float lo, float hi) { unsigned r; asm("v_cvt_pk_bf16_f32 %0, %1, %2" : "=v"(r) : "v"(lo), "v"(hi)); return r; }
__device__ __forceinline__ float bflo(unsigned u) { return __builtin_bit_cast(float, u << 16); }
__device__ __forceinline__ float bfhi(unsigned u) { return __builtin_bit_cast(float, u & 0xffff0000u); }
__device__ __forceinline__ float wave_sum(float v) {
#pragma unroll
    for (int o = 1; o < 64; o <<= 1) v += __shfl_xor(v, o);
    return v;
}
__device__ __forceinline__ float sigmoid_f(float g) { return __builtin_amdgcn_rcpf(1.0f + __builtin_amdgcn_exp2f(-1.44269504089f * g)); }
__device__ __forceinline__ float silu_acc(float g) { return g * __builtin_amdgcn_rcpf(1.0f + __builtin_amdgcn_exp2f(-1.44269504089f * g)); }


#define XB_TMO      128
#define XB_XCNT(j)  (256  + 64 * (j))
#define XB_XSUB(j)  (1280 + 64 * (j))
#define XB_XGEN(j)  (2304 + 64 * (j))
#define XB_TOP      3328
#define XB_TOPGEN   3392
#define XCD_BAR_WORDS 3456
#define XB_SPIN_CAP (1u << 22)
__device__ __forceinline__ unsigned xb_ld(unsigned* p)              { return __hip_atomic_load(p, __ATOMIC_RELAXED, __HIP_MEMORY_SCOPE_AGENT); }
__device__ __forceinline__ unsigned xb_add(unsigned* p, unsigned v) { return __hip_atomic_fetch_add(p, v, __ATOMIC_RELAXED, __HIP_MEMORY_SCOPE_AGENT); }
__device__ __forceinline__ unsigned xb_xcc_id() { return (unsigned)__builtin_amdgcn_s_getreg((3 << 11) | 20) & 0xFu; }
#define XB_SPIN(cond, bar) do { unsigned _sp = 0; while (cond) { __builtin_amdgcn_s_sleep(1); \
    if ((++_sp & 255u) == 0u) { if (xb_ld(&(bar)[XB_TMO])) break; if (_sp > XB_SPIN_CAP) { atomicAdd(&(bar)[XB_TMO], 1u); break; } } } } while (0)
struct XcdBarrier { unsigned* bar; unsigned x; volatile LAS unsigned* st; };
__device__ __forceinline__ XcdBarrier xcd_barrier_post(unsigned* bar, volatile LAS unsigned* st) {
    XcdBarrier b; b.bar = bar; b.x = xb_xcc_id(); b.st = st;
    if (threadIdx.x == 0) (void)xb_add(&bar[XB_XCNT(b.x)], 1u);
    return b;
}
__device__ __forceinline__ void xcd_barrier_complete(unsigned* bar, unsigned x, unsigned& nloc, unsigned& nx) {
    const unsigned G = gridDim.x * gridDim.y * gridDim.z;
    unsigned sum, cnt, mine, sp = 0u;
    for (;;) {
        sum = 0u; cnt = 0u; mine = 0u;
#pragma unroll
        for (unsigned j = 0; j < 16; ++j) { const unsigned c = xb_ld(&bar[XB_XCNT(j)]); sum += c; cnt += (c > 0u) ? 1u : 0u; mine = (j == x) ? c : mine; }
        if (sum == G) break;
        __builtin_amdgcn_s_sleep(1);
        if ((++sp & 255u) == 0u) { if (xb_ld(&bar[XB_TMO])) break; if (sp > XB_SPIN_CAP) { atomicAdd(&bar[XB_TMO], 1u); break; } }
    }
    nloc = mine > 0u ? mine : 1u; nx = cnt > 0u ? cnt : 1u;
}
__device__ __forceinline__ void xcd_barrier(const XcdBarrier& b) {
    asm volatile("s_waitcnt vmcnt(0)" ::: "memory");
    __syncthreads();
    if (threadIdx.x == 0) {
        unsigned* bar = b.bar;
        __builtin_amdgcn_s_waitcnt(0);
        unsigned nloc = b.st[0], nx = b.st[1];
        if (nloc == 0u) { xcd_barrier_complete(bar, b.x, nloc, nx); b.st[0] = nloc; b.st[1] = nx; }
        const unsigned old = xb_add(&bar[XB_XSUB(b.x)], 1u);
        const unsigned gen = old / nloc;
        if (old + 1u == (gen + 1u) * nloc) {
            __builtin_amdgcn_fence(__ATOMIC_RELEASE, "agent");
            asm volatile("s_waitcnt vmcnt(0)" ::: "memory");
            const unsigned og = xb_add(&bar[XB_TOP], 1u);
            const unsigned tg = og / nx;
            if (og + 1u == (tg + 1u) * nx) xb_add(&bar[XB_TOPGEN], 1u);
            else XB_SPIN(xb_ld(&bar[XB_TOPGEN]) == tg, bar);
            __builtin_amdgcn_fence(__ATOMIC_ACQUIRE, "agent");
            xb_add(&bar[XB_XGEN(b.x)], 1u);
            asm volatile("s_waitcnt vmcnt(0)" ::: "memory");
        } else {
            XB_SPIN(xb_ld(&bar[XB_XGEN(b.x)]) == gen, bar);
            __builtin_amdgcn_fence(__ATOMIC_ACQUIRE, "agent");
            asm volatile("s_waitcnt vmcnt(0)" ::: "memory");
        }
    }
    __syncthreads();
}

__device__ __forceinline__ void p0_transpose_item(const float* W, int N, bf16* WT, int Kp, int dest_row0, int k0, int n0, LAS float* scr, int lane) {
    float tv[32];
#pragma unroll
    for (int i = 0; i < 32; ++i) { const int kk = 2 * i + (lane >> 5); tv[i] = W[(size_t)(k0 + kk) * N + n0 + (lane & 31)]; }
#pragma unroll
    for (int i = 0; i < 32; ++i) { const int kk = 2 * i + (lane >> 5); scr[kk * 33 + (lane & 31)] = tv[i]; }
    asm volatile("s_waitcnt lgkmcnt(0)" ::: "memory");
    const int c = lane & 7;
#pragma unroll
    for (int j = 0; j < 4; ++j) { const int n = (lane >> 3) + 8 * j; const LAS float* s = scr + (8 * c) * 33 + n;
        u32x4 o; o.x = pk2(s[0 * 33], s[1 * 33]); o.y = pk2(s[2 * 33], s[3 * 33]); o.z = pk2(s[4 * 33], s[5 * 33]); o.w = pk2(s[6 * 33], s[7 * 33]);
        *(u32x4*)(WT + (size_t)(dest_row0 + n) * Kp + k0 + 8 * c) = o; }
    asm volatile("s_waitcnt lgkmcnt(0)" ::: "memory");
}

__device__ __forceinline__ void p0_prologue(const Args& a, LAS unsigned char* lds) {
    int tid = threadIdx.x; asm volatile("" : "+v"(tid));
    const int lane = tid & 63, wave = __builtin_amdgcn_readfirstlane(tid >> 6);
    LAS float* scr = (LAS float*)(lds + wave * 16384);
    const int gw = blockIdx.x * 8 + wave, NGW = gridDim.x * 8;
    constexpr int NMODWG = 192;
    float* modp = (float*)(a.ws + WS_PART);
    for (int wi = blockIdx.x; wi < NMODWG; wi += gridDim.x) {
        const int cb = wi % 96, l = wi / 96;
        LAS float* sc = (LAS float*)(lds + wave * 10240);
        float acc[NMODR];
#pragma unroll
        for (int r = 0; r < NMODR; ++r) acc[r] = 0.f;
        const float* wp = a.in[I_WADA] + (size_t)l * D * 6144 + cb * 64;
#pragma unroll 1
        for (int half = 0; half < 2; ++half) {
            const int kb = wave * 128 + half * 64;
            int ln = lane; asm volatile("" : "+v"(ln));
            float cvv[NMODR];
#pragma unroll
            for (int r = 0; r < NMODR; ++r) cvv[r] = (r < NB) ? a.in[I_CP][r * D + kb + ln] : a.in[I_CS][(r - NB) * D + kb + ln];
#pragma unroll
            for (int r = 0; r < NMODR; ++r) sc[r * 64 + ln] = silu_acc(cvv[r]);
            asm volatile("s_waitcnt lgkmcnt(0)" ::: "memory");
#pragma unroll 1
            for (int k0 = 0; k0 < 64; k0 += 16) {
                int ko = (kb + k0) * 6144 + lane; asm volatile("" : "+v"(ko));
                float w[16];
#pragma unroll
                for (int i = 0; i < 16; ++i) w[i] = wp[ko + i * 6144];
#pragma unroll
                for (int r = 0; r < NMODR; ++r) {
                    const LAS f32x4* sp = (const LAS f32x4*)(sc + r * 64 + k0);
                    const f32x4 s0 = sp[0], s1 = sp[1], s2 = sp[2], s3 = sp[3];
                    acc[r] += ((s0[0] * w[0] + s0[1] * w[1]) + (s0[2] * w[2] + s0[3] * w[3])) + ((s1[0] * w[4] + s1[1] * w[5]) + (s1[2] * w[6] + s1[3] * w[7]))
                            + ((s2[0] * w[8] + s2[1] * w[9]) + (s2[2] * w[10] + s2[3] * w[11])) + ((s3[0] * w[12] + s3[1] * w[13]) + (s3[2] * w[14] + s3[3] * w[15]));
                    if ((r & 3) == 3) asm volatile("" ::: "memory"); }
            }
            asm volatile("s_waitcnt lgkmcnt(0)" ::: "memory");
        }
#pragma unroll
        for (int r = 0; r < NMODR; ++r) sc[r * 64 + lane] = acc[r];
        __syncthreads();
        for (int o = tid; o < NMODR * 64; o += 512) { float v = a.in[I_BADA][l * 6144 + cb * 64 + (o & 63)];
#pragma unroll
            for (int w8 = 0; w8 < 8; ++w8) v += ((const LAS float*)lds)[w8 * 2560 + o];
            modp[((size_t)l * NMODR + (o >> 6)) * 6144 + cb * 64 + (o & 63)] = v; }
        __syncthreads();
    }
    constexpr int I_IN = 16 * (INW / 32), I_OUT = 16 * (D / 32), I_G = 16 * (DFF / 32), I_DN = (DFF / 64) * (D / 32), I_PADZ = 128;
    constexpr int PER_L = I_IN + I_OUT + 2 * I_G + I_DN + I_PADZ;
    unsigned* qctr = (unsigned*)a.ws + 3520;
    (void)gw; (void)NGW; int qbase = 0;
    for (int qi = 0;; ++qi) {
        int itb;
        if ((qi & 7) == 0) { unsigned itq = 0; if (lane == 0) { itq = __hip_atomic_load(qctr, __ATOMIC_RELAXED, __HIP_MEMORY_SCOPE_AGENT); if (itq < (unsigned)(2 * PER_L)) itq = atomicAdd(qctr, 8u); } itb = __builtin_amdgcn_readfirstlane((int)itq); qbase = itb; }
        const int it0 = qbase + (qi & 7);
        if (it0 >= 2 * PER_L) { if ((qi & 7) == 7 || qbase >= 2 * PER_L) break; else continue; }
        const int l = it0 / PER_L; int r = it0 % PER_L;
        bf16* wl = (bf16*)(a.ws + WS_W + (size_t)l * WL_SZ);
        if (r < I_IN) { const int nblk = INW / 32, kb = r / nblk, nb = r % nblk, n0 = nb * 32; int dr;
            if (n0 < 256) dr = n0;
            else if (n0 < 640) { const int j = n0 - 256; dr = 256 * (1 + (j >> 7)) + (j & 127); }
            else if (n0 < 1024) { const int j = n0 - 640; dr = 256 * (1 + (j >> 7)) + 128 + (j & 127); }
            else if (n0 < 1408) { const int j = n0 - 1024; dr = 256 * (4 + (j >> 7)) + (j & 127); }
            else if (n0 < 1792) { dr = 1792 + (n0 - 1408); }
            else { const int j = n0 - 1792; dr = 256 * (4 + (j >> 7)) + 128 + (j & 127); }
            p0_transpose_item(a.in[I_WIN] + (size_t)l * D * INW, INW, (bf16*)((char*)wl + WL_IN), D, dr, kb * 64, n0, scr, lane); continue; } r -= I_IN;
        if (r < I_OUT) { const int nblk = D / 32, kb = r / nblk, nb = r % nblk; p0_transpose_item(a.in[I_WOUT] + (size_t)l * D * D, D, (bf16*)((char*)wl + WL_OUT), D, nb * 32, kb * 64, nb * 32, scr, lane); continue; } r -= I_OUT;
        if (r < 2 * I_G) { const int up = r >= I_G; if (up) r -= I_G; const int nblk = DFF / 32, kb = r / nblk, nb = r % nblk, n0 = nb * 32;
            p0_transpose_item(a.in[up ? I_WUP : I_WGATE] + (size_t)l * D * DFF, DFF, (bf16*)((char*)wl + WL_GU), D, (n0 >> 7) * 256 + up * 128 + (n0 & 127), kb * 64, n0, scr, lane); continue; } r -= 2 * I_G;
        if (r < I_DN) { const int nblk = D / 32, kb = r / nblk, nb = r % nblk; p0_transpose_item(a.in[I_WDOWN] + (size_t)l * DFF * D, D, (bf16*)((char*)wl + WL_DN), DFF, nb * 32, kb * 64, nb * 32, scr, lane); continue; } r -= I_DN;
        { u32x4* z = (u32x4*)((char*)wl + WL_IN + (size_t)(INW + r) * D * 2); z[lane] = (u32x4){0u, 0u, 0u, 0u}; z[lane + 64] = (u32x4){0u, 0u, 0u, 0u}; }
    }
}

__device__ __forceinline__ void load_mod(const Args& a, int l, int r, int which, int lane, f32x4 (&v)[4]) {
    const float* modp = (const float*)(a.ws + WS_PART) + ((size_t)l * NMODR + r) * 6144 + which * 1024;
#pragma unroll
    for (int j = 0; j < 4; ++j) v[j] = *(const f32x4*)(modp + 256 * j + 4 * lane);
}
__device__ __forceinline__ void load_vec(const float* g, int lane, f32x4 (&v)[4]) {
#pragma unroll
    for (int j = 0; j < 4; ++j) v[j] = *(const f32x4*)(g + 256 * j + 4 * lane);
}
template <int MODE, bool XBF>
__device__ __forceinline__ void rows_do(const float* xin, const bf16* xinb, float* xout, bf16* xoutb, const bf16* Y, bf16* H, int nrows, const f32x4 (&GB)[4], const f32x4 (&GA)[4], const f32x4 (&SH)[4], int lane) {
    constexpr int R = 2;
    f32x4 xcf[R][4], xnf[R][4]; u32x2 xcb[R][4], xnb[R][4], yc[R][4], yn[R][4];
#pragma unroll
    for (int rr = 0; rr < R; ++rr) { const int ir = (rr < nrows) ? rr : nrows - 1;
#pragma unroll
        for (int j = 0; j < 4; ++j) {
            if (XBF) xcb[rr][j] = *(const u32x2*)(xinb + (size_t)ir * D + 256 * j + 4 * lane); else xcf[rr][j] = *(const f32x4*)(xin + (size_t)ir * D + 256 * j + 4 * lane);
            if (MODE != 0) yc[rr][j] = *(const u32x2*)(Y + (size_t)ir * D + 256 * j + 4 * lane); } }
    for (int i = 0; i < nrows; i += R) {
#pragma unroll
        for (int rr = 0; rr < R; ++rr) { const int ip = (i + R + rr < nrows) ? i + R + rr : nrows - 1;
#pragma unroll
            for (int j = 0; j < 4; ++j) {
                if (XBF) xnb[rr][j] = *(const u32x2*)(xinb + (size_t)ip * D + 256 * j + 4 * lane); else xnf[rr][j] = *(const f32x4*)(xin + (size_t)ip * D + 256 * j + 4 * lane);
                if (MODE != 0) yn[rr][j] = *(const u32x2*)(Y + (size_t)ip * D + 256 * j + 4 * lane); } }
        f32x4 x[R][4];
#pragma unroll
        for (int rr = 0; rr < R; ++rr)
#pragma unroll
            for (int j = 0; j < 4; ++j) { if (XBF) x[rr][j] = (f32x4){bflo(xcb[rr][j].x), bfhi(xcb[rr][j].x), bflo(xcb[rr][j].y), bfhi(xcb[rr][j].y)}; else x[rr][j] = xcf[rr][j]; }
        const bool v1 = (i + 1 < nrows);
        if (MODE != 0) {
            f32x4 y[R][4]; float ss[R];
#pragma unroll
            for (int rr = 0; rr < R; ++rr) { ss[rr] = 0.f;
#pragma unroll
                for (int j = 0; j < 4; ++j) { y[rr][j] = (f32x4){bflo(yc[rr][j].x), bfhi(yc[rr][j].x), bflo(yc[rr][j].y), bfhi(yc[rr][j].y)}; ss[rr] += (y[rr][j][0] * y[rr][j][0] + y[rr][j][1] * y[rr][j][1]) + (y[rr][j][2] * y[rr][j][2] + y[rr][j][3] * y[rr][j][3]); } }
#pragma unroll
            for (int o = 1; o < 64; o <<= 1) {
#pragma unroll
                for (int rr = 0; rr < R; ++rr) ss[rr] += __shfl_xor(ss[rr], o); }
#pragma unroll
            for (int rr = 0; rr < R; ++rr) { const float rs = __builtin_amdgcn_rsqf(ss[rr] * (1.0f / D) + EPS);
#pragma unroll
                for (int j = 0; j < 4; ++j) x[rr][j] += GB[j] * (y[rr][j] * rs); }
        }
        float rs2[R];
        if (MODE != 2) {
            float ss[R];
#pragma unroll
            for (int rr = 0; rr < R; ++rr) { ss[rr] = 0.f;
#pragma unroll
                for (int j = 0; j < 4; ++j) ss[rr] += (x[rr][j][0] * x[rr][j][0] + x[rr][j][1] * x[rr][j][1]) + (x[rr][j][2] * x[rr][j][2] + x[rr][j][3] * x[rr][j][3]); }
#pragma unroll
            for (int o = 1; o < 64; o <<= 1) {
#pragma unroll
                for (int rr = 0; rr < R; ++rr) ss[rr] += __shfl_xor(ss[rr], o); }
#pragma unroll
            for (int rr = 0; rr < R; ++rr) rs2[rr] = __builtin_amdgcn_rsqf(ss[rr] * (1.0f / D) + EPS);
        }
#pragma unroll
        for (int rr = 0; rr < R; ++rr) {
            const int ir = (rr == 0 || v1) ? i + rr : i;
#pragma unroll
            for (int j = 0; j < 4; ++j) {
                if (MODE == 2) *(f32x4*)(xout + (size_t)ir * D + 256 * j + 4 * lane) = x[rr][j];
                if (MODE == 1) { u32x2 o; o.x = pk2(x[rr][j][0], x[rr][j][1]); o.y = pk2(x[rr][j][2], x[rr][j][3]); *(u32x2*)(xoutb + (size_t)ir * D + 256 * j + 4 * lane) = o; }
                if (MODE != 2) { const f32x4 h = (x[rr][j] * rs2[rr]) * GA[j] + SH[j]; u32x2 o; o.x = pk2(h[0], h[1]); o.y = pk2(h[2], h[3]); *(u32x2*)(H + (size_t)ir * D + 256 * j + 4 * lane) = o; }
            }
        }
#pragma unroll
        for (int rr = 0; rr < R; ++rr)
#pragma unroll
            for (int j = 0; j < 4; ++j) { if (XBF) xcb[rr][j] = xnb[rr][j]; else xcf[rr][j] = xnf[rr][j]; if (MODE != 0) yc[rr][j] = yn[rr][j]; }
    }
}
template <int MODE>
__device__ __forceinline__ void row_phase(const Args& a, bool x_from_input, int lb, int wgt, const float* gpost, int lh, int wsh, const float* gpre) {
    int tid = threadIdx.x; asm volatile("" : "+v"(tid));
    const int lane = tid & 63, wave = __builtin_amdgcn_readfirstlane(tid >> 6);
    const int gw = blockIdx.x * 8 + wave, NGW = gridDim.x * 8;
    const bf16* Y = (const bf16*)(a.ws + WS_Y); bf16* H = (bf16*)(a.ws + WS_H); bf16* XB = (bf16*)(a.ws + WS_XB);
    const int nchunk = MP / 32 + MS;
    for (int ch = gw; ch < nchunk; ch += NGW) {
        int row0, nrows, r;
        if (ch < MP / 32) { row0 = ch * 32; nrows = 32; r = row0 / T_P; } else { const int j = ch - MP / 32; row0 = MP + j; nrows = 1; r = NB + j / T_S; }
        f32x4 GB[4], GA[4], SH[4];
        if (MODE != 0) { f32x4 gt[4], gp[4]; load_mod(a, lb, r, wgt, lane, gt); load_vec(gpost, lane, gp);
#pragma unroll
            for (int j = 0; j < 4; ++j) GB[j] = gt[j] * gp[j]; }
        if (MODE != 2) { f32x4 sc[4], gp[4]; load_mod(a, lh, r, wsh + 1, lane, sc); load_mod(a, lh, r, wsh, lane, SH); load_vec(gpre, lane, gp);
#pragma unroll
            for (int j = 0; j < 4; ++j) GA[j] = gp[j] * (1.0f + sc[j]); }
        const float* xin = (row0 < MP ? a.in[I_XP] + (size_t)row0 * D : a.in[I_XS] + (size_t)(row0 - MP) * D);
        if (MODE == 0 || (MODE == 1 && x_from_input)) rows_do<MODE, false>(xin, XB + (size_t)row0 * D, a.out + (size_t)row0 * D, XB + (size_t)row0 * D, Y + (size_t)row0 * D, H + (size_t)row0 * D, nrows, GB, GA, SH, lane);
        else rows_do<(MODE == 0 ? 1 : MODE), true>(xin, XB + (size_t)row0 * D, a.out + (size_t)row0 * D, XB + (size_t)row0 * D, Y + (size_t)row0 * D, H + (size_t)row0 * D, nrows, GB, GA, SH, lane);
    }
}

template <int N, int SZ>
__device__ __forceinline__ void tr_reduce_step(float (&v)[SZ], int lane) {
    constexpr int Hh = N / 2;
    const bool up = (lane & Hh) != 0;
#pragma unroll
    for (int i = 0; i < Hh; ++i) { const float send = up ? v[i] : v[i + Hh]; const float keep = up ? v[i + Hh] : v[i]; v[i] = keep + __shfl_xor(send, Hh); }
}
template <int R, int N> struct ConvLoop {
    static __device__ __forceinline__ void run(f32x2 (&z)[32], const f32x2 (&w)[31], const LAS unsigned* up) {
        const unsigned v = up[R * 192]; const f32x2 uv = {bflo(v), bfhi(v)};
#pragma unroll
        for (int i = (R - 30 > 0 ? R - 30 : 0); i <= (R < 31 ? R : 31); ++i) z[i] += w[R - i] * uv;
        if ((R & 7) == 7) asm volatile("" ::: "memory");
        ConvLoop<R + 1, N>::run(z, w, up);
    }
};
template <int N> struct ConvLoop<N, N> { static __device__ __forceinline__ void run(f32x2 (&)[32], const f32x2 (&)[31], const LAS unsigned*) {} };

constexpr int MIX_UC = 0, MIX_XA = 73728, XA_PITCH = 528, MIX_ST = MIX_XA + 79 * XA_PITCH;
static_assert(MIX_ST + 6 * 64 * 4 <= 131072, "mixer LDS");

__device__ __forceinline__ void mixer_phase(const Args& a, int l, LAS unsigned char* lds, int mode = 7) {
    const bf16* P = (const bf16*)(a.ws + WS_P); bf16* CAT = (bf16*)(a.ws + WS_CAT);
    LAS bf16* Uc = (LAS bf16*)(lds + MIX_UC);
    LAS unsigned char* XaB = lds + MIX_XA;
    LAS float* ST = (LAS float*)(lds + MIX_ST);
    const int NU = MP / 64 + NDB;
    for (int u = blockIdx.x; u < NU; u += gridDim.x) {
        int tid = threadIdx.x; asm volatile("" : "+v"(tid));
        const int lane = tid & 63, wave = __builtin_amdgcn_readfirstlane(tid >> 6);
        int rowbase, T, t0, start, b; bool smp;
        if (u < MP / 64) {
            int uu = u;
            if (gridDim.x == 256) { const int k_ = u >> 8, c_ = u & 255; uu = (8 * k_ + (c_ & 7)) * 32 + (((c_ >> 3) + 8 * k_) & 31); }
            b = uu / 32; t0 = (uu % 32) * 64; T = T_P; start = 0; rowbase = b * T_P; smp = false; }
        else { b = u - MP / 64; t0 = 0; T = T_S; start = PASTLEN; rowbase = MP + b * T_S; smp = true; }
        const int nbat = smp ? NDB : NB;
        float* pool_out = a.out + (smp ? O_POOLS : O_POOLP) + ((size_t)l * nbat + b) * 15 * 256;
        float* conv_out = a.out + (smp ? O_CONVS : O_CONVP) + ((size_t)l * nbat + b) * 30 * 384;
        float* sc_out = a.out + (smp ? O_SCS : O_SCP) + ((size_t)l * nbat + b) * 2 * 384;
        const float* st_pool = a.in[I_SPOOL] + ((size_t)l * NDB + b) * 15 * 256;
        const float* st_conv = a.in[I_SCONV] + ((size_t)l * NDB + b) * 30 * 384;
        const float* st_sc = a.in[I_SSC] + ((size_t)l * NDB + b) * 2 * 384;
        const int seg = tid / 48, oc = tid - seg * 48, cc = oc * 8;
        u32x4 va[12], vb[5];
        if (tid < 384) {
#pragma unroll
            for (int q = 0; q < 12; ++q) { const int r = seg + 8 * q, t = t0 - 30 + r;
                va[q] = (u32x4){0u, 0u, 0u, 0u};
                if (r < 94 && t >= 0 && t < T) va[q] = *(const u32x4*)(P + (size_t)(rowbase + t) * P2W + 256 + cc); }
        }
#pragma unroll
        for (int q = 0; q < 5; ++q) { const int i = tid + 512 * q, r = i >> 5, o = i & 31, t = t0 - 15 + r;
            vb[q] = (u32x4){0u, 0u, 0u, 0u};
            if (i < 79 * 32 && t >= 0 && t < T) vb[q] = *(const u32x4*)(P + (size_t)(rowbase + t) * P2W + o * 8); }
        if (smp) {
            if (tid < 384) {
#pragma unroll
                for (int q = 0; q < 4; ++q) { const int r = seg + 8 * q, t = r - 30;
                    if (t < 0) { const f32x4 p0 = *(const f32x4*)(st_conv + (30 + t) * 384 + cc), p1 = *(const f32x4*)(st_conv + (30 + t) * 384 + cc + 4);
                        va[q].x = pk2(p0[0], p0[1]); va[q].y = pk2(p0[2], p0[3]); va[q].z = pk2(p1[0], p1[1]); va[q].w = pk2(p1[2], p1[3]); } }
            }
#pragma unroll
            for (int q = 0; q < 1; ++q) { const int i = tid, r = i >> 5, o = i & 31, t = r - 15, c = o * 8;
                if (t < 0) { const f32x4 p0 = *(const f32x4*)(st_pool + (15 + t) * 256 + c), p1 = *(const f32x4*)(st_pool + (15 + t) * 256 + c + 4);
                    vb[q].x = pk2(p0[0], p0[1]); vb[q].y = pk2(p0[2], p0[3]); vb[q].z = pk2(p1[0], p1[1]); vb[q].w = pk2(p1[2], p1[3]); } }
        }
        if (tid < 384) {
#pragma unroll
            for (int q = 0; q < 12; ++q) { const int r = seg + 8 * q; if (r < 94) *(LAS u32x4*)(Uc + r * 384 + cc) = va[q]; }
        }
#pragma unroll
        for (int q = 0; q < 5; ++q) { const int i = tid + 512 * q, r = i >> 5, o = i & 31; if (i < 79 * 32) *(LAS u32x4*)(XaB + r * XA_PITCH + o * 16) = vb[q]; }
        if (t0 + 64 >= T && !smp) {
            u32x4 cw[3], pw, sw;
#pragma unroll
            for (int q = 0; q < 3; ++q) { const int i = tid + 512 * q, sr = i / 48, o = i - sr * 48; cw[q] = (u32x4){0u, 0u, 0u, 0u};
                if (i < 30 * 48) cw[q] = *(const u32x4*)(P + (size_t)(rowbase + T - 30 + sr) * P2W + 256 + o * 8); }
            pw = (u32x4){0u, 0u, 0u, 0u}; sw = (u32x4){0u, 0u, 0u, 0u};
            if (tid < 15 * 32) pw = *(const u32x4*)(P + (size_t)(rowbase + T - 15 + (tid >> 5)) * P2W + (tid & 31) * 8);
            if (tid < 2 * 48) sw = *(const u32x4*)(P + (size_t)(rowbase + T - 2 + tid / 48) * P2W + 640 + (tid % 48) * 8);
#pragma unroll
            for (int q = 0; q < 3; ++q) { const int i = tid + 512 * q, sr = i / 48, o = i - sr * 48; const u32x4 w = cw[q];
                if (i < 30 * 48) { float* d = conv_out + sr * 384 + o * 8; *(f32x4*)d = (f32x4){bflo(w.x), bfhi(w.x), bflo(w.y), bfhi(w.y)}; *(f32x4*)(d + 4) = (f32x4){bflo(w.z), bfhi(w.z), bflo(w.w), bfhi(w.w)}; } }
            if (tid < 15 * 32) { float* d = pool_out + (tid >> 5) * 256 + (tid & 31) * 8; *(f32x4*)d = (f32x4){bflo(pw.x), bfhi(pw.x), bflo(pw.y), bfhi(pw.y)}; *(f32x4*)(d + 4) = (f32x4){bflo(pw.z), bfhi(pw.z), bflo(pw.w), bfhi(pw.w)}; }
            if (tid < 2 * 48) { float* d = sc_out + (tid / 48) * 384 + (tid % 48) * 8; *(f32x4*)d = (f32x4){bflo(sw.x), bfhi(sw.x), bflo(sw.y), bfhi(sw.y)}; *(f32x4*)(d + 4) = (f32x4){bflo(sw.z), bfhi(sw.z), bflo(sw.w), bfhi(sw.w)}; }
        } else if (t0 + 64 >= T) {
            for (int i = tid; i < 30 * 48; i += 512) { const int sr = i / 48, o = i - sr * 48, t = T - 30 + sr, c = o * 8; float* d = conv_out + sr * 384 + c;
                if (t >= 0) { const u32x4 w = *(const u32x4*)(P + (size_t)(rowbase + t) * P2W + 256 + c);
                    *(f32x4*)d = (f32x4){bflo(w.x), bfhi(w.x), bflo(w.y), bfhi(w.y)}; *(f32x4*)(d + 4) = (f32x4){bflo(w.z), bfhi(w.z), bflo(w.w), bfhi(w.w)}; }
                else { *(f32x4*)d = *(const f32x4*)(st_conv + (30 + t) * 384 + c); *(f32x4*)(d + 4) = *(const f32x4*)(st_conv + (30 + t) * 384 + c + 4); } }
            for (int i = tid; i < 15 * 32; i += 512) { const int sr = i >> 5, o = i & 31, t = T - 15 + sr, c = o * 8; float* d = pool_out + sr * 256 + c;
                if (t >= 0) { const u32x4 w = *(const u32x4*)(P + (size_t)(rowbase + t) * P2W + c);
                    *(f32x4*)d = (f32x4){bflo(w.x), bfhi(w.x), bflo(w.y), bfhi(w.y)}; *(f32x4*)(d + 4) = (f32x4){bflo(w.z), bfhi(w.z), bflo(w.w), bfhi(w.w)}; }
                else { *(f32x4*)d = *(const f32x4*)(st_pool + (15 + t) * 256 + c); *(f32x4*)(d + 4) = *(const f32x4*)(st_pool + (15 + t) * 256 + c + 4); } }
            for (int i = tid; i < 2 * 48; i += 512) { const int sr = i / 48, o = i - sr * 48, t = T - 2 + sr, c = o * 8; float* d = sc_out + sr * 384 + c;
                const u32x4 w = *(const u32x4*)(P + (size_t)(rowbase + t) * P2W + 640 + c);
                *(f32x4*)d = (f32x4){bflo(w.x), bfhi(w.x), bflo(w.y), bfhi(w.y)}; *(f32x4*)(d + 4) = (f32x4){bflo(w.z), bfhi(w.z), bflo(w.w), bfhi(w.w)}; }
        }
        if (tid < 384) {
            float w0[8], w1[8], w2[8];
            { const float* ws = a.in[I_WSC] + (size_t)l * 3 * 384 + cc;
#pragma unroll
              for (int e = 0; e < 8; ++e) { w0[e] = ws[e]; w1[e] = ws[384 + e]; w2[e] = ws[768 + e]; } }
            float up2[8], up1[8];
#pragma unroll
            for (int ps = 0; ps < 2; ++ps) {
                u32x4 vu[6], vg[4];
#pragma unroll
                for (int d = (ps ? 2 : 0); d < 6; ++d) { const int t = t0 + 8 * seg + 4 * ps + d - 2; vu[d] = (u32x4){0u, 0u, 0u, 0u};
                    if (t >= 0 && t < T) vu[d] = *(const u32x4*)(P + (size_t)(rowbase + t) * P2W + 640 + cc); }
#pragma unroll
                for (int d = 0; d < 4; ++d) { const int t = t0 + 8 * seg + 4 * ps + d; vg[d] = (u32x4){0u, 0u, 0u, 0u};
                    if (t < T) vg[d] = *(const u32x4*)(P + (size_t)(rowbase + t) * P2W + 1024 + cc); }
#pragma unroll
                for (int d = (ps ? 2 : 0); d < 6; ++d) {
                    const int t = t0 + 8 * seg + 4 * ps + d - 2;
                    float uc[8];
#pragma unroll
                    for (int e = 0; e < 4; ++e) { uc[2 * e] = bflo(vu[d][e]); uc[2 * e + 1] = bfhi(vu[d][e]); }
                    if (ps == 0 && d < 2 && smp && t < 0) { const f32x4 p0 = *(const f32x4*)(st_sc + (2 + t) * 384 + cc), p1 = *(const f32x4*)(st_sc + (2 + t) * 384 + cc + 4);
#pragma unroll
                        for (int e = 0; e < 4; ++e) { uc[e] = p0[e]; uc[4 + e] = p1[e]; } }
                    if (d >= 2) {
                        const u32x4 bv = vg[d - 2];
                        float y[8];
#pragma unroll
                        for (int e = 0; e < 4; ++e) {
                            y[2 * e] = bflo(bv[e]) * (w0[2 * e] * up2[2 * e] + w1[2 * e] * up1[2 * e] + w2[2 * e] * uc[2 * e]);
                            y[2 * e + 1] = bfhi(bv[e]) * (w0[2 * e + 1] * up2[2 * e + 1] + w1[2 * e + 1] * up1[2 * e + 1] + w2[2 * e + 1] * uc[2 * e + 1]); }
                        { u32x4 w; w.x = pk2(y[0], y[1]); w.y = pk2(y[2], y[3]); w.z = pk2(y[4], y[5]); w.w = pk2(y[6], y[7]);
                          *(u32x4*)(CAT + (size_t)(t < T ? rowbase + t : MR + (t & 63)) * D + 640 + cc) = w; }
                    }
#pragma unroll
                    for (int e = 0; e < 8; ++e) { if (ps == 1 || d >= 1) up2[e] = up1[e]; up1[e] = uc[e]; }
                }
            }
        }
        __syncthreads();
        f32x2 z[32];
        int tid2 = tid; asm volatile("" : "+v"(tid2));
        const int half = (tid2 >= 192) ? 1 : 0, p = tid2 - 192 * half;
        const bool rows_live = (t0 + 32 * half) < T;
        if (wave < 6 && (mode & 2) && rows_live) {
            f32x2 w[31];
            const float* wd = a.in[I_WDW] + (size_t)l * 31 * 384 + 2 * p;
#pragma unroll
            for (int j = 0; j < 31; ++j) w[j] = *(const f32x2*)(wd + j * 384);
            const f32x2 bb = *(const f32x2*)(a.in[I_BDW] + l * 384 + 2 * p);
#pragma unroll
            for (int i = 0; i < 32; ++i) z[i] = bb;
            const LAS unsigned* up = (const LAS unsigned*)Uc + (32 * half) * 192 + p;
            ConvLoop<0, 62>::run(z, w, up);
            float sv[32];
            { const bool up = (lane & 32) != 0;
#pragma unroll
              for (int i = 0; i < 32; ++i) { const f32x2 zl = z[i >> 1], zh = z[16 + (i >> 1)];
                  const float va_ = (i & 1) ? (zl[0] * zl[0] + zl[1] * zl[1]) : (zl[0] + zl[1]), vb_ = (i & 1) ? (zh[0] * zh[0] + zh[1] * zh[1]) : (zh[0] + zh[1]);
                  const float send = up ? va_ : vb_, keep = up ? vb_ : va_; sv[i] = keep + __shfl_xor(send, 32);
                  if ((i & 7) == 7) asm volatile("" ::: "memory"); } }
            tr_reduce_step<32>(sv, lane); tr_reduce_step<16>(sv, lane); tr_reduce_step<8>(sv, lane); tr_reduce_step<4>(sv, lane); tr_reduce_step<2>(sv, lane);
            ST[wave * 64 + lane] = sv[0];
        } else if (mode & 2) {
            const int fr = tid2 & 15, fq = (tid2 & 63) >> 4;
#pragma unroll 1
            for (int gi = 0; gi < 2; ++gi) {
                const int g = (wave == 6) ? (gi ? 3 : 0) : (gi ? 2 : 1), win = 2 << g;
                bf16x8 Wf[4][2];
#pragma unroll
                for (int nt = 0; nt < 4; ++nt)
#pragma unroll
                    for (int kk = 0; kk < 2; ++kk) { const float* wp = a.in[I_WPOOL] + (((size_t)l * 4 + g) * 64 + 32 * kk + 8 * fq) * 64 + 16 * nt + fr;
                        u32x4 q; q.x = pk2(wp[0], wp[64]); q.y = pk2(wp[128], wp[192]); q.z = pk2(wp[256], wp[320]); q.w = pk2(wp[384], wp[448]);
                        Wf[nt][kk] = __builtin_bit_cast(bf16x8, q); }
                f32x4 spv[4];
#pragma unroll
                for (int nt = 0; nt < 4; ++nt) spv[nt] = *(const f32x4*)(a.in[I_SPOOLW] + l * 256 + 64 * g + 16 * nt + 4 * fq);
#pragma unroll 1
                for (int mt = 0; mt < 4; ++mt) {
                    if (t0 + 16 * mt >= T) break;
                    const int i = 16 * mt + fr, r = i + 15;
                    const int pos = t0 + i + start; const float cnt = (float)((pos + 1 < win) ? pos + 1 : win); const float inv = 1.0f / cnt;
                    bf16x8 Af[2];
#pragma unroll
                    for (int kk = 0; kk < 2; ++kk) {
                        const LAS unsigned char* base = XaB + r * XA_PITCH + (64 * g + 32 * kk + 8 * fq) * 2;
                        float s[8];
#pragma unroll
                        for (int e = 0; e < 8; ++e) s[e] = 0.f;
                        for (int d = 0; d < win; ++d) { const u32x4 v = *(const LAS u32x4*)(base - d * XA_PITCH);
#pragma unroll
                            for (int e = 0; e < 4; ++e) { s[2 * e] += bflo(v[e]); s[2 * e + 1] += bfhi(v[e]); } }
                        const u32x4 cv = *(const LAS u32x4*)base;
                        u32x4 q;
#pragma unroll
                        for (int e = 0; e < 4; ++e) q[e] = pk2(s[2 * e] * inv - bflo(cv[e]), s[2 * e + 1] * inv - bfhi(cv[e]));
                        Af[kk] = __builtin_bit_cast(bf16x8, q);
                    }
                    const bool valid = (t0 + i) < T;
#pragma unroll
                    for (int nt = 0; nt < 4; ++nt) {
                        f32x4 acc = {0.f, 0.f, 0.f, 0.f};
                        acc = __builtin_amdgcn_mfma_f32_16x16x32_bf16(Wf[nt][0], Af[0], acc, 0, 0, 0);
                        acc = __builtin_amdgcn_mfma_f32_16x16x32_bf16(Wf[nt][1], Af[1], acc, 0, 0, 0);
                        const f32x4 sp = spv[nt];
                        u32x2 o; o.x = pk2(acc[0] * sp[0], acc[1] * sp[1]); o.y = pk2(acc[2] * sp[2], acc[3] * sp[3]);
                        *(u32x2*)(CAT + (size_t)(valid ? rowbase + t0 + i : MR + i) * D + 64 * g + 16 * nt + 4 * fq) = o;
                    }
                }
            }
        }
        __syncthreads();
        if (wave < 6 && (mode & 4) && rows_live) {
            f32x2 lg = *(const f32x2*)(a.in[I_LNG] + l * 384 + 2 * p), lb = *(const f32x2*)(a.in[I_LNB] + l * 384 + 2 * p);
            asm volatile("" : "+v"(lg), "+v"(lb));
            const float tot = ST[(3 * half) * 64 + lane] + ST[(3 * half + 1) * 64 + lane] + ST[(3 * half + 2) * 64 + lane];
            const float oth = __shfl_xor(tot, 1);
            const float s1 = (lane & 1) ? oth : tot, s2 = (lane & 1) ? tot : oth;
            const float mu_l = s1 * (1.0f / 384.0f); float var_l = s2 * (1.0f / 384.0f) - mu_l * mu_l; var_l = var_l > 0.f ? var_l : 0.f;
            const float rstd_l = __builtin_amdgcn_rsqf(var_l + EPS);
            const int trow = t0 + 32 * half;
            bf16* crow = CAT + (size_t)(rowbase + trow) * D + 256 + 2 * p;
            bf16* cdummy = CAT + (size_t)(MR + 32 * half) * D + 256 + 2 * p;
#pragma unroll
            for (int i = 0; i < 32; ++i) {
                const float mu = __builtin_bit_cast(float, __builtin_amdgcn_readlane(__builtin_bit_cast(int, mu_l), 2 * i));
                const float rstd = __builtin_bit_cast(float, __builtin_amdgcn_readlane(__builtin_bit_cast(int, rstd_l), 2 * i));
                const f32x2 sc2 = lg * rstd, of2 = lb - sc2 * mu;
                const f32x2 y = z[i] * sc2 + of2;
                *(unsigned*)((trow + i < T ? crow + (size_t)i * D : cdummy + (size_t)i * D)) = pk2(y[0] * sigmoid_f(y[0]), y[1] * sigmoid_f(y[1]));
            }
        }
    }
    __syncthreads();
}


__device__ __forceinline__ void sample_gemm(int kind, const bf16* A, const bf16* Bt, int NT, int K, bf16* O, int ldc) {
    int tid = threadIdx.x; asm volatile("" : "+v"(tid));
    const int lane = tid & 63, wave = __builtin_amdgcn_readfirstlane(tid >> 6), fr = lane & 15, fq = lane >> 4;
    const int gw = blockIdx.x * 8 + wave, NGW = gridDim.x * 8, ntask = NT * 64;
    for (int task = gw; task < ntask; task += NGW) {
        const int mt = task & 7, sb = (task >> 3) & 7, pn = task >> 6;
        const bf16* ap = A + (size_t)(mt * 16 + fr) * K + 8 * fq;
        const bf16* bp0 = Bt + (size_t)(256 * pn + 16 * sb + fr) * K + 8 * fq;
        const bf16* bp1 = bp0 + (size_t)128 * K;
        f32x4 acc0 = {0.f, 0.f, 0.f, 0.f}, acc1 = {0.f, 0.f, 0.f, 0.f};
        bf16x8 fa[4], fb0[4], fb1[4], ga[4], gb0[4], gb1[4];
#pragma unroll
        for (int j = 0; j < 4; ++j) { fa[j] = *(const bf16x8*)(ap + 32 * j); fb0[j] = *(const bf16x8*)(bp0 + 32 * j); fb1[j] = *(const bf16x8*)(bp1 + 32 * j); }
#pragma unroll 1
        for (int k0 = 0; k0 < K; k0 += 256) {
#pragma unroll
            for (int j = 0; j < 4; ++j) { ga[j] = *(const bf16x8*)(ap + k0 + 128 + 32 * j); gb0[j] = *(const bf16x8*)(bp0 + k0 + 128 + 32 * j); gb1[j] = *(const bf16x8*)(bp1 + k0 + 128 + 32 * j); }
#pragma unroll
            for (int j = 0; j < 4; ++j) { acc0 = __builtin_amdgcn_mfma_f32_16x16x32_bf16(fb0[j], fa[j], acc0, 0, 0, 0); acc1 = __builtin_amdgcn_mfma_f32_16x16x32_bf16(fb1[j], fa[j], acc1, 0, 0, 0); }
            const int kn = (k0 + 256 < K) ? k0 + 256 : k0;
#pragma unroll
            for (int j = 0; j < 4; ++j) { fa[j] = *(const bf16x8*)(ap + kn + 32 * j); fb0[j] = *(const bf16x8*)(bp0 + kn + 32 * j); fb1[j] = *(const bf16x8*)(bp1 + kn + 32 * j); }
#pragma unroll
            for (int j = 0; j < 4; ++j) { acc0 = __builtin_amdgcn_mfma_f32_16x16x32_bf16(gb0[j], ga[j], acc0, 0, 0, 0); acc1 = __builtin_amdgcn_mfma_f32_16x16x32_bf16(gb1[j], ga[j], acc1, 0, 0, 0); }
        }
        bf16* orow = O + (size_t)(mt * 16 + fr) * ldc + 16 * sb + 4 * fq;
        int mode = 0, col = 256 * pn;
        if (kind == 0) { if (pn == 0) col = 0; else if (pn >= 7) { col = 1024 + (pn - 7) * 256; if (pn == 8) mode = 1; } else if (pn <= 3) { mode = 2; col = 256 + (pn - 1) * 128; } else { mode = 3; col = 640 + (pn - 4) * 128; } }
        else if (kind == 2) { mode = 4; col = 128 * pn; }
        if (mode <= 1) {
            u32x2 o; o.x = pk2(acc0[0], acc0[1]); o.y = pk2(acc0[2], acc0[3]); *(u32x2*)(orow + col) = o;
            if (mode == 0) { u32x2 q; q.x = pk2(acc1[0], acc1[1]); q.y = pk2(acc1[2], acc1[3]); *(u32x2*)(orow + col + 128) = q; }
        } else {
            f32x4 r;
#pragma unroll
            for (int e = 0; e < 4; ++e) r[e] = (mode == 2) ? acc0[e] * sigmoid_f(acc1[e]) : (mode == 3) ? acc0[e] * acc1[e] : acc0[e] * sigmoid_f(acc0[e]) * acc1[e];
            u32x2 o; o.x = pk2(r[0], r[1]); o.y = pk2(r[2], r[3]); *(u32x2*)(orow + col) = o;
        }
    }
}

constexpr int NPH = 16;
__global__ void __launch_bounds__(512) mega_fwd(Args a) {
    extern __shared__ __attribute__((aligned(16))) unsigned char lds_raw[];
    LAS unsigned char* lds = (LAS unsigned char*)lds_raw;
    cg::grid_group grid = cg::this_grid();
#if ONE_LAUNCH
    volatile LAS unsigned* xst = (volatile LAS unsigned*)(lds + 131072 + 256);
    if (threadIdx.x < 2) xst[threadIdx.x] = 0u;
    __syncthreads();
    const XcdBarrier xbar = xcd_barrier_post((unsigned*)a.ws, xst);
#endif
    bf16* H = (bf16*)(a.ws + WS_H); bf16* Y = (bf16*)(a.ws + WS_Y); bf16* P = (bf16*)(a.ws + WS_P); bf16* CAT = (bf16*)(a.ws + WS_CAT); bf16* ACT = (bf16*)(a.ws + WS_ACT);
#ifdef SYNC_PROBE
    for (int i_ = 0; i_ < SYNC_PROBE; ++i_) grid.sync();
#endif
    for (int ph = a.ph_lo; ph < a.ph_hi; ++ph) {
#ifdef DUP_MASK
      const int kk_ = ph < 2 ? ph + 7 : (ph - 2) % 7;
      const int nrep_ = ((DUP_MASK >> kk_) & 1) ? 2 : 1;
      for (int rep_ = 0; rep_ < nrep_; ++rep_) {
        if (rep_) grid.sync();
#endif
        if (ph == 0) {
#ifndef SKIP_P0
            p0_prologue(a, lds);
#endif
        }
        else if (ph == 1) {
#ifndef SKIP_ROW
            row_phase<0>(a, true, 0, 0, nullptr, 0, 0, a.in[I_GPREMIX]);
#endif
        }
        else {
            const int l = (ph - 2) / 7, k = (ph - 2) % 7;
            const unsigned char* wl = a.ws + WS_W + (size_t)l * WL_SZ;
            if (k == 0 || k == 2 || k == 4 || k == 5) {
                const bf16* sA; const bf16* sB; bf16* sO; int sNT, sK, sld, skind;
                if (k == 0) {
                    pg8::Gemm g{H, (const bf16*)(wl + WL_IN), MP, INWP, D}; pg8::EpiInProj E{P, P2W};
                    pg8::StaticOrder S; S.init(g.M, g.N, gridDim.x, blockIdx.x);
                    pg8::gemm_phase<pg8::EpiInProj, pg8::StaticOrder, true, true>(lds, g, S, E);
                    sA = H; sB = g.Bt; sO = P; sNT = INWP / 256; sK = D; sld = P2W; skind = 0;
                } else if (k == 4) {
#ifndef SKIP_G3
                    pg8::Gemm g{H, (const bf16*)(wl + WL_GU), MP, NGU, D}; pg8::EpiSwiGLU E{ACT, DFF};
                    pg8::StaticOrder S; S.init(g.M, g.N, gridDim.x, blockIdx.x);
                    pg8::gemm_phase<pg8::EpiSwiGLU, pg8::StaticOrder, true, true>(lds, g, S, E);
#endif
                    sA = H; sB = (const bf16*)(wl + WL_GU); sO = ACT; sNT = NGU / 256; sK = D; sld = DFF; skind = 2;
                } else {
#ifndef SKIP_G1
                    pg8::Gemm g; pg8::EpiBf16 E;
                    if (k == 2) { g = pg8::Gemm{CAT, (const bf16*)(wl + WL_OUT), MP, D, D}; E = pg8::EpiBf16{Y, D}; }
                    else { g = pg8::Gemm{ACT, (const bf16*)(wl + WL_DN), MP, D, DFF}; E = pg8::EpiBf16{Y, D}; }
                    pg8::StaticOrder S; S.init(g.M, g.N, gridDim.x, blockIdx.x);
                    pg8::gemm_phase<pg8::EpiBf16, pg8::StaticOrder, true, true>(lds, g, S, E);
#endif
                    sA = (k == 2) ? CAT : ACT; sB = (const bf16*)(wl + (k == 2 ? WL_OUT : WL_DN)); sO = Y; sNT = D / 256; sK = (k == 2) ? D : DFF; sld = D; skind = 1;
                }
                sample_gemm(skind, sA + (size_t)MP * sK, sB, sNT, sK, sO + (size_t)MP * sld, sld);
            } else if (k == 1) {
#ifndef SKIP_MIX
#ifdef MIX_PROBE
                for (int rep = 0; rep < 2; ++rep) { int md = rep ? 7 : MIX_PROBE; asm volatile("" : "+s"(md)); mixer_phase(a, l, lds, md); if (rep == 0) grid.sync(); }
#else
                mixer_phase(a, l, lds);
#endif
#endif
            }
            else if (k == 3) {
#ifndef SKIP_ROW
                row_phase<1>(a, l == 0, l, 2, a.in[I_GPOSTMIX] + l * D, l, 3, a.in[I_GPREFFN] + l * D);
#endif
            }
            else {
#ifndef SKIP_ROW
                if (l == 0) row_phase<1>(a, false, 0, 5, a.in[I_GPOSTFFN], 1, 0, a.in[I_GPREMIX] + D);
                else row_phase<2>(a, false, 1, 5, a.in[I_GPOSTFFN] + D, 1, 0, nullptr);
#endif
            }
        }
#ifdef DUP_MASK
      }
#endif
#if ONE_LAUNCH
        if (ph + 1 < a.ph_hi) { if (a.ph_lo != 0) grid.sync(); else xcd_barrier(xbar); }
#else
        if (ph + 1 < a.ph_hi) grid.sync();
#endif
    }
}

extern "C" void kernel_launch(void* const* d_in, const int* in_sizes, int n_in, void* d_out, int out_size, void* d_ws, size_t ws_size, hipStream_t stream) {
    static int grid = 0;
    if (grid == 0) {
        if (n_in != 25 || ws_size < WS_END) { fprintf(stderr, "kernel_launch: unexpected n_in %d / ws_size %zu\n", n_in, ws_size); grid = -1; return; }
        int dev = 0, cus = 0, per_cu = 0;
        hipGetDevice(&dev); hipDeviceGetAttribute(&cus, hipDeviceAttributeMultiprocessorCount, dev);
        if (hipFuncSetAttribute((const void*)mega_fwd, hipFuncAttributeMaxDynamicSharedMemorySize, LDS_BYTES) != hipSuccess) { fprintf(stderr, "kernel_launch: hipFuncSetAttribute failed\n"); grid = -1; return; }
        if (hipOccupancyMaxActiveBlocksPerMultiprocessor(&per_cu, (const void*)mega_fwd, 512, LDS_BYTES) != hipSuccess || per_cu < 1) { fprintf(stderr, "kernel_launch: occupancy query gave %d\n", per_cu); per_cu = 1; }
        (void)hipGetLastError();
        grid = cus;
    }
    if (grid < 0) return;
    Args a{};
    for (int i = 0; i < 25; ++i) a.in[i] = (const float*)d_in[i];
    a.out = (float*)d_out; a.ws = (unsigned char*)d_ws;
#if ONE_LAUNCH
    if (hipMemsetAsync(d_ws, 0, 16384, stream) != hipSuccess) { fprintf(stderr, "kernel_launch: memset of the barrier words failed\n"); return; }
    a.ph_lo = 0; a.ph_hi = NPH;
    void* args[] = {&a};
    hipError_t e = hipLaunchCooperativeKernel((const void*)mega_fwd, dim3(grid), dim3(512), args, LDS_BYTES, stream);
    if (e != hipSuccess) fprintf(stderr, "cooperative launch failed: %s (grid %d)\n", hipGetErrorString(e), grid);
#else
    (void)hipMemsetAsync(d_ws, 0, 16384, stream);
    for (int ph = 0; ph < NPH; ++ph) { a.ph_lo = ph; a.ph_hi = ph + 1; hipLaunchKernelGGL(mega_fwd, dim3(grid), dim3(512), LDS_BYTES, stream, a); }
#endif
}
```

```cpp
#include <hip/hip_runtime.h>
#include <hip/hip_cooperative_groups.h>
#include <cstdio>
#include <cstdint>
namespace cg = cooperative_groups;

#ifndef ONE_LAUNCH
#define ONE_LAUNCH 1
#endif

namespace pg8 {
#define PG8_LAS __attribute__((address_space(3)))
typedef unsigned short bf16_t;
typedef short bf16x8 __attribute__((ext_vector_type(8)));
typedef float f32x4 __attribute__((ext_vector_type(4)));
typedef unsigned u32x4 __attribute__((ext_vector_type(4)));
constexpr int BM = 256, BK = 64, HALF = 128, HTB = HALF * BK * 2, STAGE_BYTES = 8 * HTB, NXCD = 8, WGM = 4;

__host__ __device__ __forceinline__ int lds_byte(int r, int c) { const int st = (r >> 4) * 2 + (c >> 5), rr = r & 15, cc = c & 31, ob = rr * 64 + cc * 2; return st * 1024 + (ob ^ (((ob >> 9) & 1) << 5)); }
__host__ __device__ __forceinline__ void stage_rc(int b, int& R, int& C) { const int st = b / 1024, sb = b % 1024, swz = sb ^ (((sb >> 9) & 1) << 5); R = (st >> 1) * 16 + swz / 64; C = (st & 1) * 32 + (swz % 64) / 2; }
__host__ __device__ __forceinline__ int perm32(int rho) { const int n = rho >> 4, i = rho & 15; return 8 * (i >> 2) + 4 * n + (i & 3); }

struct Unit { int pm, pn; };
struct Gemm { const bf16_t* A; const bf16_t* Bt; int M, N, K; };

struct StaticOrder {
    int nM, nN, nwg, G, c;
    __host__ __device__ void init(int M, int N, int G_, int c_) { nM = M / BM; nN = N / BM; nwg = nM * nN; G = G_; c = c_; }
    __host__ __device__ bool next(int i, Unit& u) const {
        const long L = (long)i * G + c; if (L >= nwg) return false;
        int wgid = (int)L; { const int q = nwg / NXCD, r = nwg % NXCD, xcd = wgid % NXCD, off = wgid / NXCD; wgid = (xcd < r ? xcd * (q + 1) : r * (q + 1) + (xcd - r) * q) + off; }
        const int nig = WGM * nN, gid = wgid / nig, fm = gid * WGM, gsz = (nM - fm) < WGM ? (nM - fm) : WGM;
        u.pm = fm + ((wgid % nig) % gsz); u.pn = (wgid % nig) / gsz; return true;
    }
    __device__ __forceinline__ void a_ready(const Unit&) const {}
    __device__ __forceinline__ void done(const Unit&) const {}
};

__device__ __forceinline__ unsigned cvt_pk_bf16(float lo, float hi) { unsigned r; asm volatile("v_cvt_pk_bf16_f32 %0, %1, %2" : "=v"(r) : "v"(lo), "v"(hi)); return r; }

struct EpiBf16 {
    static constexpr bool PERM = true, AFTER_DRAIN = false;
    bf16_t* O; int ldc;
    __device__ __forceinline__ void operator()(const f32x4 (&acc)[2][2][4][2], const Unit& u, int wr, int wc, int fr, int fq) const {
        const int row0 = u.pm * BM + wr * 64 + fr; const int col0 = u.pn * BM + wc * 32 + 8 * fq;
#pragma unroll
        for (int ai = 0; ai < 2; ++ai)
#pragma unroll
            for (int m = 0; m < 4; ++m) { bf16_t* rowp = O + (size_t)(row0 + ai * HALF + m * 16) * ldc + col0;
#pragma unroll
                for (int bj = 0; bj < 2; ++bj) { const f32x4 v0 = acc[ai][bj][m][0], v1 = acc[ai][bj][m][1];
                    u32x4 w; w.x = cvt_pk_bf16(v0[0], v0[1]); w.y = cvt_pk_bf16(v0[2], v0[3]); w.z = cvt_pk_bf16(v1[0], v1[1]); w.w = cvt_pk_bf16(v1[2], v1[3]);
                    *(u32x4*)(rowp + bj * HALF) = w; } }
    }
};
__device__ __forceinline__ float silu_f(float g) { return g * __builtin_amdgcn_rcpf(1.0f + __builtin_amdgcn_exp2f(-1.44269504089f * g)); }
struct EpiSwiGLU {
    static constexpr bool PERM = true, AFTER_DRAIN = false;
    bf16_t* O; int ldc;
    __device__ __forceinline__ void operator()(const f32x4 (&acc)[2][2][4][2], const Unit& u, int wr, int wc, int fr, int fq) const {
        const int row0 = u.pm * BM + wr * 64 + fr; const int col0 = u.pn * HALF + wc * 32 + 8 * fq;
#pragma unroll
        for (int ai = 0; ai < 2; ++ai)
#pragma unroll
            for (int m = 0; m < 4; ++m) { bf16_t* rowp = O + (size_t)(row0 + ai * HALF + m * 16) * ldc + col0;
                const f32x4 g0 = acc[ai][0][m][0], g1 = acc[ai][0][m][1], u0 = acc[ai][1][m][0], u1 = acc[ai][1][m][1];
                u32x4 w;
                w.x = cvt_pk_bf16(silu_f(g0[0]) * u0[0], silu_f(g0[1]) * u0[1]); w.y = cvt_pk_bf16(silu_f(g0[2]) * u0[2], silu_f(g0[3]) * u0[3]);
                w.z = cvt_pk_bf16(silu_f(g1[0]) * u1[0], silu_f(g1[1]) * u1[1]); w.w = cvt_pk_bf16(silu_f(g1[2]) * u1[2], silu_f(g1[3]) * u1[3]);
                *(u32x4*)rowp = w; asm volatile("" ::: "memory"); }
    }
};

__device__ __forceinline__ float sigm_f(float g) { return __builtin_amdgcn_rcpf(1.0f + __builtin_amdgcn_exp2f(-1.44269504089f * g)); }
struct EpiInProj {
    static constexpr bool PERM = true, AFTER_DRAIN = false;
    bf16_t* O; int ldc;
    __device__ __forceinline__ void operator()(const f32x4 (&acc)[2][2][4][2], const Unit& u, int wr, int wc, int fr, int fq) const {
        const int row0 = u.pm * BM + wr * 64 + fr; const int cl = wc * 32 + 8 * fq; const int pn = u.pn;
        if (pn == 0 || pn >= 7) {
            const int col0 = (pn == 0 ? 0 : 1024 + (pn - 7) * 256) + cl;
#pragma unroll
            for (int ai = 0; ai < 2; ++ai)
#pragma unroll
                for (int m = 0; m < 4; ++m) { bf16_t* rowp = O + (size_t)(row0 + ai * HALF + m * 16) * ldc + col0;
#pragma unroll
                    for (int bj = 0; bj < 2; ++bj) { const f32x4 v0 = acc[ai][bj][m][0], v1 = acc[ai][bj][m][1];
                        u32x4 w; w.x = cvt_pk_bf16(v0[0], v0[1]); w.y = cvt_pk_bf16(v0[2], v0[3]); w.z = cvt_pk_bf16(v1[0], v1[1]); w.w = cvt_pk_bf16(v1[2], v1[3]);
                        if (bj == 0 || pn != 8) *(u32x4*)(rowp + bj * HALF) = w; } }
        } else {
            const bool glu = pn <= 3; const int col0 = (glu ? 256 + (pn - 1) * 128 : 640 + (pn - 4) * 128) + cl;
#pragma unroll
            for (int ai = 0; ai < 2; ++ai)
#pragma unroll
                for (int m = 0; m < 4; ++m) { bf16_t* rowp = O + (size_t)(row0 + ai * HALF + m * 16) * ldc + col0;
                    const f32x4 a0 = acc[ai][0][m][0], a1 = acc[ai][0][m][1]; f32x4 g0 = acc[ai][1][m][0], g1 = acc[ai][1][m][1];
                    if (glu) {
#pragma unroll
                        for (int e = 0; e < 4; ++e) { g0[e] = sigm_f(g0[e]); g1[e] = sigm_f(g1[e]); } }
                    u32x4 w; w.x = cvt_pk_bf16(a0[0] * g0[0], a0[1] * g0[1]); w.y = cvt_pk_bf16(a0[2] * g0[2], a0[3] * g0[3]);
                    w.z = cvt_pk_bf16(a1[0] * g1[0], a1[1] * g1[1]); w.w = cvt_pk_bf16(a1[2] * g1[2], a1[3] * g1[3]);
                    *(u32x4*)rowp = w; asm volatile("" ::: "memory"); }
        }
    }
};

template <class Epi, class Sched, bool ALIGN_EPI = false, bool SP2 = false>
__device__ __forceinline__ void gemm_phase(PG8_LAS unsigned char* lds, const Gemm g, const Sched& S, const Epi& E) {
    int tid_ = threadIdx.x; asm volatile("" : "+v"(tid_));
    const int tid = tid_, wid = __builtin_amdgcn_readfirstlane(tid >> 6), lane = tid & 63, wr = wid >> 2, wc = wid & 3, fr = lane & 15, fq = lane >> 4;
    const int K = g.K, nt = K / BK;
    unsigned voffA[2], voffB[2];
#pragma unroll
    for (int i = 0; i < 2; ++i) { int R, C; stage_rc(tid * 16 + i * 8192, R, C); const int Rb = Epi::PERM ? ((R & ~31) + perm32(R & 31)) : R;
        voffA[i] = (unsigned)(R * K + C) * 2u; voffB[i] = (unsigned)(Rb * K + C) * 2u; }
    const size_t kstep = (size_t)(BK * 2);
    const size_t hstep = (size_t)HALF * K * 2;
    const size_t tstep = 2 * hstep;
    const unsigned ldsw = (unsigned)wid * 1024u;
    const int aoff = lds_byte(wr * 64 + fr, fq * 8), boff = lds_byte(wc * 32 + fr, fq * 8);
#define PG8_SA(b, h) (((b) * 2 + (h)) * HTB)
#define PG8_SB(b, h) ((4 + (b) * 2 + (h)) * HTB)
#define PG8_STAGE(bufoff, gbase, voff) do { _Pragma("unroll") for (int _i = 0; _i < 2; ++_i) \
        __builtin_amdgcn_global_load_lds((const unsigned*)((const char*)(gbase) + (voff)[_i]), (PG8_LAS unsigned*)(lds + (bufoff) + ldsw + _i * 8192), 16, 0, 0); } while (0)
#define PG8_LDA(dst, b, h) do { _Pragma("unroll") for (int m = 0; m < 4; ++m) _Pragma("unroll") for (int k = 0; k < 2; ++k) dst[m][k] = *(const PG8_LAS bf16x8*)(lds + PG8_SA(b, h) + aoff + m * 2048 + k * 1024); } while (0)
#define PG8_LDB(dst, b, h) do { _Pragma("unroll") for (int n = 0; n < 2; ++n) _Pragma("unroll") for (int k = 0; k < 2; ++k) dst[n][k] = *(const PG8_LAS bf16x8*)(lds + PG8_SB(b, h) + boff + n * 2048 + k * 1024); } while (0)
#define PG8_MMA(ai, bj, At, Bt) do { __builtin_amdgcn_s_setprio(1); _Pragma("unroll") for (int m = 0; m < 4; ++m) _Pragma("unroll") for (int n = 0; n < 2; ++n) _Pragma("unroll") for (int k = 0; k < 2; ++k) \
        acc[ai][bj][m][n] = __builtin_amdgcn_mfma_f32_16x16x32_bf16(Bt[n][k], At[m][k], acc[ai][bj][m][n], 0, 0, 0); __builtin_amdgcn_s_setprio(0); } while (0)
#define PG8_WAIT_V(n) asm volatile("s_waitcnt vmcnt(" #n ")" ::: "memory")
#define PG8_WAIT_L(n) asm volatile("s_waitcnt lgkmcnt(" #n ")" ::: "memory")
#define PG8_BAR __builtin_amdgcn_s_barrier()
#define PG8_SCHED __builtin_amdgcn_sched_barrier(0)
    Unit cur, nxt; int ui = 0;
    if (!S.next(0, cur)) return;
#ifdef STAGGER_TICKS
    {
        const unsigned long long t0_ = __builtin_amdgcn_s_memrealtime(); const unsigned long long dl_ = (unsigned long long)((blockIdx.x >> 3) & 7) * STAGGER_TICKS;
        while (__builtin_amdgcn_s_memrealtime() - t0_ < dl_) __builtin_amdgcn_s_sleep(8);
    }
#endif
    f32x4 acc[2][2][4][2];
#pragma unroll
    for (int a = 0; a < 2; ++a)
#pragma unroll
        for (int b = 0; b < 2; ++b)
#pragma unroll
            for (int m = 0; m < 4; ++m)
#pragma unroll
                for (int n = 0; n < 2; ++n) acc[a][b][m][n] = (f32x4){0.f, 0.f, 0.f, 0.f};
    bf16x8 At[4][2], B0[2][2], B1[2][2];
    const char* cA = (const char*)g.A + (size_t)cur.pm * tstep; const char* cB = (const char*)g.Bt + (size_t)cur.pn * tstep;
    S.a_ready(cur);
    if constexpr (SP2) {
        PG8_STAGE(PG8_SB(0, 0), cB, voffB); PG8_STAGE(PG8_SB(0, 1), cB + hstep, voffB); PG8_STAGE(PG8_SA(0, 0), cA, voffA); PG8_STAGE(PG8_SA(0, 1), cA + hstep, voffA);
        if (wr == 1) PG8_BAR;
        PG8_WAIT_V(2); PG8_BAR;
        PG8_STAGE(PG8_SB(1, 0), cB + kstep, voffB); PG8_STAGE(PG8_SA(1, 0), cA + kstep, voffA); PG8_STAGE(PG8_SB(1, 1), cB + hstep + kstep, voffB);
        PG8_WAIT_V(6); PG8_BAR;
    } else {
        PG8_STAGE(PG8_SB(0, 0), cB, voffB); PG8_STAGE(PG8_SA(0, 0), cA, voffA); PG8_STAGE(PG8_SB(0, 1), cB + hstep, voffB); PG8_STAGE(PG8_SA(0, 1), cA + hstep, voffA);
        if (wr == 1) PG8_BAR;
        PG8_WAIT_V(4); PG8_BAR;
        PG8_STAGE(PG8_SB(1, 0), cB + kstep, voffB); PG8_STAGE(PG8_SA(1, 0), cA + kstep, voffA); PG8_STAGE(PG8_SB(1, 1), cB + hstep + kstep, voffB);
        PG8_WAIT_V(6); PG8_BAR;
    }
    for (;;) {
        const bool has_next = S.next(ui + 1, nxt);
        const char* nA = has_next ? (const char*)g.A + (size_t)nxt.pm * tstep : cA; const char* nB = has_next ? (const char*)g.Bt + (size_t)nxt.pn * tstep : cB;
        for (int t = 0; t < nt; t += 2) {
            const bool last = (t == nt - 2);
            const char* a1 = cA + (size_t)(t + 1) * kstep;
            const char* a2 = last ? nA : cA + (size_t)(t + 2) * kstep; const char* b2 = last ? nB : cB + (size_t)(t + 2) * kstep;
            const char* a3 = a2 + kstep; const char* b3 = b2 + kstep;
            if (last && has_next) S.a_ready(nxt);
            if constexpr (SP2) {
            PG8_LDB(B0, 0, 0); PG8_LDB(B1, 0, 1); PG8_SCHED; PG8_LDA(At, 0, 0); PG8_STAGE(PG8_SA(1, 1), a1 + hstep, voffA);
            PG8_WAIT_V(8); PG8_WAIT_L(0); PG8_BAR; PG8_MMA(0, 0, At, B0); PG8_MMA(0, 1, At, B1); PG8_BAR; PG8_SCHED;
            PG8_LDA(At, 0, 1); PG8_STAGE(PG8_SB(0, 0), b2, voffB); PG8_STAGE(PG8_SB(0, 1), b2 + hstep, voffB); PG8_STAGE(PG8_SA(0, 0), a2, voffA);
            PG8_WAIT_V(8); PG8_WAIT_L(0); PG8_BAR; PG8_MMA(1, 0, At, B0); PG8_MMA(1, 1, At, B1); PG8_BAR; PG8_SCHED;
            PG8_LDB(B0, 1, 0); PG8_LDB(B1, 1, 1); PG8_SCHED; PG8_LDA(At, 1, 0); PG8_STAGE(PG8_SA(0, 1), a2 + hstep, voffA);
            PG8_WAIT_V(8); PG8_WAIT_L(0); PG8_BAR; PG8_MMA(0, 0, At, B0); PG8_MMA(0, 1, At, B1); PG8_BAR; PG8_SCHED;
            PG8_LDA(At, 1, 1); PG8_STAGE(PG8_SB(1, 0), b3, voffB); PG8_STAGE(PG8_SB(1, 1), b3 + hstep, voffB); PG8_STAGE(PG8_SA(1, 0), a3, voffA);
            PG8_WAIT_V(8); PG8_WAIT_L(0); PG8_BAR; PG8_MMA(1, 0, At, B0); PG8_MMA(1, 1, At, B1); PG8_BAR; PG8_SCHED;
            } else {
            PG8_LDB(B0, 0, 0); PG8_SCHED; PG8_LDA(At, 0, 0); PG8_STAGE(PG8_SA(1, 1), a1 + hstep, voffA);
            PG8_WAIT_L(8); PG8_BAR; PG8_WAIT_L(0); PG8_MMA(0, 0, At, B0); PG8_BAR; PG8_SCHED;
            PG8_LDB(B1, 0, 1); PG8_STAGE(PG8_SB(0, 0), b2, voffB);
            PG8_BAR; PG8_WAIT_L(0); PG8_MMA(0, 1, At, B1); PG8_BAR;
            PG8_LDA(At, 0, 1); PG8_STAGE(PG8_SA(0, 0), a2, voffA);
            PG8_BAR; PG8_WAIT_L(0); PG8_MMA(1, 0, At, B0); PG8_BAR; PG8_SCHED;
            PG8_STAGE(PG8_SB(0, 1), b2 + hstep, voffB);
            PG8_WAIT_V(6); PG8_BAR; PG8_MMA(1, 1, At, B1); PG8_BAR;
            PG8_LDB(B0, 1, 0); PG8_SCHED; PG8_LDA(At, 1, 0); PG8_STAGE(PG8_SA(0, 1), a2 + hstep, voffA);
            PG8_WAIT_L(8); PG8_BAR; PG8_WAIT_L(0); PG8_MMA(0, 0, At, B0); PG8_BAR; PG8_SCHED;
            PG8_LDB(B1, 1, 1); PG8_STAGE(PG8_SB(1, 0), b3, voffB);
            PG8_BAR; PG8_WAIT_L(0); PG8_MMA(0, 1, At, B1); PG8_BAR;
            PG8_LDA(At, 1, 1); PG8_STAGE(PG8_SA(1, 0), a3, voffA);
            PG8_BAR; PG8_WAIT_L(0); PG8_MMA(1, 0, At, B0); PG8_BAR; PG8_SCHED;
            PG8_STAGE(PG8_SB(1, 1), b3 + hstep, voffB);
            PG8_WAIT_V(6); PG8_BAR; PG8_MMA(1, 1, At, B1); PG8_BAR;
            }
        }
        if constexpr (ALIGN_EPI) { if (wr == 0) PG8_BAR; }
        if constexpr (!Epi::AFTER_DRAIN) { E(acc, cur, wr, wc, fr, fq); S.done(cur); }
        if (!has_next) break;
#pragma unroll
        for (int a = 0; a < 2; ++a)
#pragma unroll
            for (int b = 0; b < 2; ++b)
#pragma unroll
                for (int m = 0; m < 4; ++m)
#pragma unroll
                    for (int n = 0; n < 2; ++n) acc[a][b][m][n] = (f32x4){0.f, 0.f, 0.f, 0.f};
        cur = nxt; cA = nA; cB = nB; ++ui;
        if constexpr (ALIGN_EPI) { if (wr == 1) PG8_BAR; }
    }
    PG8_WAIT_V(0);
    if constexpr (!ALIGN_EPI) { if (wr == 0) PG8_BAR; }
    PG8_BAR;
#undef PG8_SA
#undef PG8_SB
#undef PG8_STAGE
#undef PG8_LDA
#undef PG8_LDB
#undef PG8_MMA
#undef PG8_WAIT_V
#undef PG8_WAIT_L
#undef PG8_BAR
#undef PG8_SCHED
}
}

#define LAS __attribute__((address_space(3)))
typedef unsigned short bf16;
typedef float f32x4 __attribute__((ext_vector_type(4)));
typedef float f32x2 __attribute__((ext_vector_type(2)));
typedef unsigned u32x4 __attribute__((ext_vector_type(4)));
typedef unsigned u32x2 __attribute__((ext_vector_type(2)));
typedef short bf16x8 __attribute__((ext_vector_type(8)));

constexpr int D = 1024, NB = 32, T_P = 2048, NDB = 8, T_S = 16, PASTLEN = 4096;
constexpr int MP = NB * T_P;
constexpr int MS = NDB * T_S;
constexpr int MR = MP + MS;
constexpr int MPAD = 257 * 256;
constexpr int INW = 2176, INWP = 2304, DFF = 2816, NGU = 2 * DFF;
constexpr int PW = 256, CW = 384, SW = 384, P2W = 1408;
constexpr float EPS = 1e-6f;
constexpr int NMODR = NB + NDB;
constexpr int KCH = 8;

constexpr size_t O_YP = 0, O_YS = (size_t)MP * D, O_POOLP = O_YS + (size_t)MS * D, O_CONVP = O_POOLP + 2 * 32 * 15 * 256,
                 O_SCP = O_CONVP + 2 * 32 * 30 * 384, O_POOLS = O_SCP + 2 * 32 * 2 * 384, O_CONVS = O_POOLS + 2 * 8 * 15 * 256, O_SCS = O_CONVS + 2 * 8 * 30 * 384;
constexpr size_t MiB = 1u << 20;
constexpr size_t WL_IN = 0, WL_OUT = (size_t)INWP * D * 2, WL_GU = WL_OUT + (size_t)D * D * 2, WL_DN = WL_GU + (size_t)NGU * D * 2, WL_SZ = WL_DN + (size_t)D * DFF * 2;
static_assert(WL_SZ == 23 * MiB, "weight block");
constexpr size_t WS_W = 2 * MiB, WS_PART = 48 * MiB, WS_H = 64 * MiB, WS_Y = 193 * MiB, WS_P = 322 * MiB, WS_CAT = 612 * MiB, WS_ACT = WS_P, WS_XB = 741 * MiB, WS_END = 870 * MiB;
static_assert(WS_PART + (size_t)2 * NMODR * 6144 * 4 <= WS_H && WS_H + (size_t)MPAD * D * 2 <= WS_Y && WS_Y + (size_t)MPAD * D * 2 <= WS_P && WS_P + (size_t)MPAD * INWP * 2 <= WS_CAT && WS_CAT + (size_t)MPAD * D * 2 <= WS_XB && WS_ACT + (size_t)MPAD * DFF * 2 <= WS_XB && WS_XB + (size_t)MR * D * 2 <= WS_END, "ws map");

constexpr int LDS_BYTES = 147456;

struct Args { const float* in[25]; float* out; unsigned char* ws; int ph_lo, ph_hi; };
enum { I_XP = 0, I_XS, I_CP, I_CS, I_SPOOL, I_SCONV, I_SSC, I_WADA, I_BADA, I_GPREMIX, I_GPOSTMIX, I_GPREFFN, I_GPOSTFFN, I_WIN, I_WPOOL, I_SPOOLW, I_WDW, I_BDW, I_LNG, I_LNB, I_WSC, I_WOUT, I_WGATE, I_WUP, I_WDOWN };

__device__ __forceinline__ unsigned f2bf(float f) { unsigned u = __builtin_bit_cast(unsigned, f); return (u + 0x7fffu + ((u >> 16) & 1u)) >> 16; }
__device__ __forceinline__ unsigned pk2(float lo, float hi) { unsigned r; asm("v_cvt_pk_bf16_f32 %0, %1, %2" : "=v"(r) : "v"(lo), "v"(hi)); return r; }
__device__ __forceinline__ float bflo(unsigned u) { return __builtin_bit_cast(float, u << 16); }
__device__ __forceinline__ float bfhi(unsigned u) { return __builtin_bit_cast(float, u & 0xffff0000u); }
__device__ __forceinline__ float wave_sum(float v) {
#pragma unroll
    for (int o = 1; o < 64; o <<= 1) v += __shfl_xor(v, o);
    return v;
}
__device__ __forceinline__ float sigmoid_f(float g) { return __builtin_amdgcn_rcpf(1.0f + __builtin_amdgcn_exp2f(-1.44269504089f * g)); }
__device__ __forceinline__ float silu_acc(float g) { return g * __builtin_amdgcn_rcpf(1.0f + __builtin_amdgcn_exp2f(-1.44269504089f * g)); }


#define XB_TMO      128
#define XB_XCNT(j)  (256  + 64 * (j))
#define XB_XSUB(j)  (1280 + 64 * (j))
#define XB_XGEN(j)  (2304 + 64 * (j))
#define XB_TOP      3328
#define XB_TOPGEN   3392
#define XCD_BAR_WORDS 3456
#define XB_SPIN_CAP (1u << 22)
__device__ __forceinline__ unsigned xb_ld(unsigned* p)              { return __hip_atomic_load(p, __ATOMIC_RELAXED, __HIP_MEMORY_SCOPE_AGENT); }
__device__ __forceinline__ unsigned xb_add(unsigned* p, unsigned v) { return __hip_atomic_fetch_add(p, v, __ATOMIC_RELAXED, __HIP_MEMORY_SCOPE_AGENT); }
__device__ __forceinline__ unsigned xb_xcc_id() { return (unsigned)__builtin_amdgcn_s_getreg((3 << 11) | 20) & 0xFu; }
#define XB_SPIN(cond, bar) do { unsigned _sp = 0; while (cond) { __builtin_amdgcn_s_sleep(1); \
    if ((++_sp & 255u) == 0u) { if (xb_ld(&(bar)[XB_TMO])) break; if (_sp > XB_SPIN_CAP) { atomicAdd(&(bar)[XB_TMO], 1u); break; } } } } while (0)
struct XcdBarrier { unsigned* bar; unsigned x; volatile LAS unsigned* st; };
__device__ __forceinline__ XcdBarrier xcd_barrier_post(unsigned* bar, volatile LAS unsigned* st) {
    XcdBarrier b; b.bar = bar; b.x = xb_xcc_id(); b.st = st;
    if (threadIdx.x == 0) (void)xb_add(&bar[XB_XCNT(b.x)], 1u);
    return b;
}
__device__ __forceinline__ void xcd_barrier_complete(unsigned* bar, unsigned x, unsigned& nloc, unsigned& nx) {
    const unsigned G = gridDim.x * gridDim.y * gridDim.z;
    unsigned sum, cnt, mine, sp = 0u;
    for (;;) {
        sum = 0u; cnt = 0u; mine = 0u;
#pragma unroll
        for (unsigned j = 0; j < 16; ++j) { const unsigned c = xb_ld(&bar[XB_XCNT(j)]); sum += c; cnt += (c > 0u) ? 1u : 0u; mine = (j == x) ? c : mine; }
        if (sum == G) break;
        __builtin_amdgcn_s_sleep(1);
        if ((++sp & 255u) == 0u) { if (xb_ld(&bar[XB_TMO])) break; if (sp > XB_SPIN_CAP) { atomicAdd(&bar[XB_TMO], 1u); break; } }
    }
    nloc = mine > 0u ? mine : 1u; nx = cnt > 0u ? cnt : 1u;
}
__device__ __forceinline__ void xcd_barrier(const XcdBarrier& b) {
    asm volatile("s_waitcnt vmcnt(0)" ::: "memory");
    __syncthreads();
    if (threadIdx.x == 0) {
        unsigned* bar = b.bar;
        __builtin_amdgcn_s_waitcnt(0);
        unsigned nloc = b.st[0], nx = b.st[1];
        if (nloc == 0u) { xcd_barrier_complete(bar, b.x, nloc, nx); b.st[0] = nloc; b.st[1] = nx; }
        const unsigned old = xb_add(&bar[XB_XSUB(b.x)], 1u);
        const unsigned gen = old / nloc;
        if (old + 1u == (gen + 1u) * nloc) {
            __builtin_amdgcn_fence(__ATOMIC_RELEASE, "agent");
            asm volatile("s_waitcnt vmcnt(0)" ::: "memory");
            const unsigned og = xb_add(&bar[XB_TOP], 1u);
            const unsigned tg = og / nx;
            if (og + 1u == (tg + 1u) * nx) xb_add(&bar[XB_TOPGEN], 1u);
            else XB_SPIN(xb_ld(&bar[XB_TOPGEN]) == tg, bar);
            __builtin_amdgcn_fence(__ATOMIC_ACQUIRE, "agent");
            xb_add(&bar[XB_XGEN(b.x)], 1u);
            asm volatile("s_waitcnt vmcnt(0)" ::: "memory");
        } else {
            XB_SPIN(xb_ld(&bar[XB_XGEN(b.x)]) == gen, bar);
            __builtin_amdgcn_fence(__ATOMIC_ACQUIRE, "agent");
            asm volatile("s_waitcnt vmcnt(0)" ::: "memory");
        }
    }
    __syncthreads();
}

__device__ __forceinline__ void p0_transpose_item(const float* W, int N, bf16* WT, int Kp, int dest_row0, int k0, int n0, LAS float* scr, int lane) {
    float tv[32];
#pragma unroll
    for (int i = 0; i < 32; ++i) { const int kk = 2 * i + (lane >> 5); tv[i] = W[(size_t)(k0 + kk) * N + n0 + (lane & 31)]; }
#pragma unroll
    for (int i = 0; i < 32; ++i) { const int kk = 2 * i + (lane >> 5); scr[kk * 33 + (lane & 31)] = tv[i]; }
    asm volatile("s_waitcnt lgkmcnt(0)" ::: "memory");
    const int c = lane & 7;
#pragma unroll
    for (int j = 0; j < 4; ++j) { const int n = (lane >> 3) + 8 * j; const LAS float* s = scr + (8 * c) * 33 + n;
        u32x4 o; o.x = pk2(s[0 * 33], s[1 * 33]); o.y = pk2(s[2 * 33], s[3 * 33]); o.z = pk2(s[4 * 33], s[5 * 33]); o.w = pk2(s[6 * 33], s[7 * 33]);
        *(u32x4*)(WT + (size_t)(dest_row0 + n) * Kp + k0 + 8 * c) = o; }
    asm volatile("s_waitcnt lgkmcnt(0)" ::: "memory");
}

__device__ __forceinline__ void p0_prologue(const Args& a, LAS unsigned char* lds) {
    int tid = threadIdx.x; asm volatile("" : "+v"(tid));
    const int lane = tid & 63, wave = __builtin_amdgcn_readfirstlane(tid >> 6);
    LAS float* scr = (LAS float*)(lds + wave * 16384);
    const int gw = blockIdx.x * 8 + wave, NGW = gridDim.x * 8;
    constexpr int NMODWG = 192;
    float* modp = (float*)(a.ws + WS_PART);
    for (int wi = blockIdx.x; wi < NMODWG; wi += gridDim.x) {
        const int cb = wi % 96, l = wi / 96;
        LAS float* sc = (LAS float*)(lds + wave * 10240);
        float acc[NMODR];
#pragma unroll
        for (int r = 0; r < NMODR; ++r) acc[r] = 0.f;
        const float* wp = a.in[I_WADA] + (size_t)l * D * 6144 + cb * 64;
#pragma unroll 1
        for (int half = 0; half < 2; ++half) {
            const int kb = wave * 128 + half * 64;
            int ln = lane; asm volatile("" : "+v"(ln));
            float cvv[NMODR];
#pragma unroll
            for (int r = 0; r < NMODR; ++r) cvv[r] = (r < NB) ? a.in[I_CP][r * D + kb + ln] : a.in[I_CS][(r - NB) * D + kb + ln];
#pragma unroll
            for (int r = 0; r < NMODR; ++r) sc[r * 64 + ln] = silu_acc(cvv[r]);
            asm volatile("s_waitcnt lgkmcnt(0)" ::: "memory");
#pragma unroll 1
            for (int k0 = 0; k0 < 64; k0 += 16) {
                int ko = (kb + k0) * 6144 + lane; asm volatile("" : "+v"(ko));
                float w[16];
#pragma unroll
                for (int i = 0; i < 16; ++i) w[i] = wp[ko + i * 6144];
#pragma unroll
                for (int r = 0; r < NMODR; ++r) {
                    const LAS f32x4* sp = (const LAS f32x4*)(sc + r * 64 + k0);
                    const f32x4 s0 = sp[0], s1 = sp[1], s2 = sp[2], s3 = sp[3];
                    acc[r] += ((s0[0] * w[0] + s0[1] * w[1]) + (s0[2] * w[2] + s0[3] * w[3])) + ((s1[0] * w[4] + s1[1] * w[5]) + (s1[2] * w[6] + s1[3] * w[7]))
                            + ((s2[0] * w[8] + s2[1] * w[9]) + (s2[2] * w[10] + s2[3] * w[11])) + ((s3[0] * w[12] + s3[1] * w[13]) + (s3[2] * w[14] + s3[3] * w[15]));
                    if ((r & 3) == 3) asm volatile("" ::: "memory"); }
            }
            asm volatile("s_waitcnt lgkmcnt(0)" ::: "memory");
        }
#pragma unroll
        for (int r = 0; r < NMODR; ++r) sc[r * 64 + lane] = acc[r];
        __syncthreads();
        for (int o = tid; o < NMODR * 64; o += 512) { float v = a.in[I_BADA][l * 6144 + cb * 64 + (o & 63)];
#pragma unroll
            for (int w8 = 0; w8 < 8; ++w8) v += ((const LAS float*)lds)[w8 * 2560 + o];
            modp[((size_t)l * NMODR + (o >> 6)) * 6144 + cb * 64 + (o & 63)] = v; }
        __syncthreads();
    }
    constexpr int I_IN = 16 * (INW / 32), I_OUT = 16 * (D / 32), I_G = 16 * (DFF / 32), I_DN = (DFF / 64) * (D / 32), I_PADZ = 128;
    constexpr int PER_L = I_IN + I_OUT + 2 * I_G + I_DN + I_PADZ;
    unsigned* qctr = (unsigned*)a.ws + 3520;
    (void)gw; (void)NGW; int qbase = 0;
    for (int qi = 0;; ++qi) {
        int itb;
        if ((qi & 7) == 0) { unsigned itq = 0; if (lane == 0) { itq = __hip_atomic_load(qctr, __ATOMIC_RELAXED, __HIP_MEMORY_SCOPE_AGENT); if (itq < (unsigned)(2 * PER_L)) itq = atomicAdd(qctr, 8u); } itb = __builtin_amdgcn_readfirstlane((int)itq); qbase = itb; }
        const int it0 = qbase + (qi & 7);
        if (it0 >= 2 * PER_L) { if ((qi & 7) == 7 || qbase >= 2 * PER_L) break; else continue; }
        const int l = it0 / PER_L; int r = it0 % PER_L;
        bf16* wl = (bf16*)(a.ws + WS_W + (size_t)l * WL_SZ);
        if (r < I_IN) { const int nblk = INW / 32, kb = r / nblk, nb = r % nblk, n0 = nb * 32; int dr;
            if (n0 < 256) dr = n0;
            else if (n0 < 640) { const int j = n0 - 256; dr = 256 * (1 + (j >> 7)) + (j & 127); }
            else if (n0 < 1024) { const int j = n0 - 640; dr = 256 * (1 + (j >> 7)) + 128 + (j & 127); }
            else if (n0 < 1408) { const int j = n0 - 1024; dr = 256 * (4 + (j >> 7)) + (j & 127); }
            else if (n0 < 1792) { dr = 1792 + (n0 - 1408); }
            else { const int j = n0 - 1792; dr = 256 * (4 + (j >> 7)) + 128 + (j & 127); }
            p0_transpose_item(a.in[I_WIN] + (size_t)l * D * INW, INW, (bf16*)((char*)wl + WL_IN), D, dr, kb * 64, n0, scr, lane); continue; } r -= I_IN;
        if (r < I_OUT) { const int nblk = D / 32, kb = r / nblk, nb = r % nblk; p0_transpose_item(a.in[I_WOUT] + (size_t)l * D * D, D, (bf16*)((char*)wl + WL_OUT), D, nb * 32, kb * 64, nb * 32, scr, lane); continue; } r -= I_OUT;
        if (r < 2 * I_G) { const int up = r >= I_G; if (up) r -= I_G; const int nblk = DFF / 32, kb = r / nblk, nb = r % nblk, n0 = nb * 32;
            p0_transpose_item(a.in[up ? I_WUP : I_WGATE] + (size_t)l * D * DFF, DFF, (bf16*)((char*)wl + WL_GU), D, (n0 >> 7) * 256 + up * 128 + (n0 & 127), kb * 64, n0, scr, lane); continue; } r -= 2 * I_G;
        if (r < I_DN) { const int nblk = D / 32, kb = r / nblk, nb = r % nblk; p0_transpose_item(a.in[I_WDOWN] + (size_t)l * DFF * D, D, (bf16*)((char*)wl + WL_DN), DFF, nb * 32, kb * 64, nb * 32, scr, lane); continue; } r -= I_DN;
        { u32x4* z = (u32x4*)((char*)wl + WL_IN + (size_t)(INW + r) * D * 2); z[lane] = (u32x4){0u, 0u, 0u, 0u}; z[lane + 64] = (u32x4){0u, 0u, 0u, 0u}; }
    }
}

__device__ __forceinline__ void load_mod(const Args& a, int l, int r, int which, int lane, f32x4 (&v)[4]) {
    const float* modp = (const float*)(a.ws + WS_PART) + ((size_t)l * NMODR + r) * 6144 + which * 1024;
#pragma unroll
    for (int j = 0; j < 4; ++j) v[j] = *(const f32x4*)(modp + 256 * j + 4 * lane);
}
__device__ __forceinline__ void load_vec(const float* g, int lane, f32x4 (&v)[4]) {
#pragma unroll
    for (int j = 0; j < 4; ++j) v[j] = *(const f32x4*)(g + 256 * j + 4 * lane);
}
template <int MODE, bool XBF>
__device__ __forceinline__ void rows_do(const float* xin, const bf16* xinb, float* xout, bf16* xoutb, const bf16* Y, bf16* H, int nrows, const f32x4 (&GB)[4], const f32x4 (&GA)[4], const f32x4 (&SH)[4], int lane) {
    constexpr int R = 2;
    f32x4 xcf[R][4], xnf[R][4]; u32x2 xcb[R][4], xnb[R][4], yc[R][4], yn[R][4];
#pragma unroll
    for (int rr = 0; rr < R; ++rr) { const int ir = (rr < nrows) ? rr : nrows - 1;
#pragma unroll
        for (int j = 0; j < 4; ++j) {
            if (XBF) xcb[rr][j] = *(const u32x2*)(xinb + (size_t)ir * D + 256 * j + 4 * lane); else xcf[rr][j] = *(const f32x4*)(xin + (size_t)ir * D + 256 * j + 4 * lane);
            if (MODE != 0) yc[rr][j] = *(const u32x2*)(Y + (size_t)ir * D + 256 * j + 4 * lane); } }
    for (int i = 0; i < nrows; i += R) {
#pragma unroll
        for (int rr = 0; rr < R; ++rr) { const int ip = (i + R + rr < nrows) ? i + R + rr : nrows - 1;
#pragma unroll
            for (int j = 0; j < 4; ++j) {
                if (XBF) xnb[rr][j] = *(const u32x2*)(xinb + (size_t)ip * D + 256 * j + 4 * lane); else xnf[rr][j] = *(const f32x4*)(xin + (size_t)ip * D + 256 * j + 4 * lane);
                if (MODE != 0) yn[rr][j] = *(const u32x2*)(Y + (size_t)ip * D + 256 * j + 4 * lane); } }
        f32x4 x[R][4];
#pragma unroll
        for (int rr = 0; rr < R; ++rr)
#pragma unroll
            for (int j = 0; j < 4; ++j) { if (XBF) x[rr][j] = (f32x4){bflo(xcb[rr][j].x), bfhi(xcb[rr][j].x), bflo(xcb[rr][j].y), bfhi(xcb[rr][j].y)}; else x[rr][j] = xcf[rr][j]; }
        const bool v1 = (i + 1 < nrows);
        if (MODE != 0) {
            f32x4 y[R][4]; float ss[R];
#pragma unroll
            for (int rr = 0; rr < R; ++rr) { ss[rr] = 0.f;
#pragma unroll
                for (int j = 0; j < 4; ++j) { y[rr][j] = (f32x4){bflo(yc[rr][j].x), bfhi(yc[rr][j].x), bflo(yc[rr][j].y), bfhi(yc[rr][j].y)}; ss[rr] += (y[rr][j][0] * y[rr][j][0] + y[rr][j][1] * y[rr][j][1]) + (y[rr][j][2] * y[rr][j][2] + y[rr][j][3] * y[rr][j][3]); } }
#pragma unroll
            for (int o = 1; o < 64; o <<= 1) {
#pragma unroll
                for (int rr = 0; rr < R; ++rr) ss[rr] += __shfl_xor(ss[rr], o); }
#pragma unroll
            for (int rr = 0; rr < R; ++rr) { const float rs = __builtin_amdgcn_rsqf(ss[rr] * (1.0f / D) + EPS);
#pragma unroll
                for (int j = 0; j < 4; ++j) x[rr][j] += GB[j] * (y[rr][j] * rs); }
        }
        float rs2[R];
        if (MODE != 2) {
            float ss[R];
#pragma unroll
            for (int rr = 0; rr < R; ++rr) { ss[rr] = 0.f;
#pragma unroll
                for (int j = 0; j < 4; ++j) ss[rr] += (x[rr][j][0] * x[rr][j][0] + x[rr][j][1] * x[rr][j][1]) + (x[rr][j][2] * x[rr][j][2] + x[rr][j][3] * x[rr][j][3]); }
#pragma unroll
            for (int o = 1; o < 64; o <<= 1) {
#pragma unroll
                for (int rr = 0; rr < R; ++rr) ss[rr] += __shfl_xor(ss[rr], o); }
#pragma unroll
            for (int rr = 0; rr < R; ++rr) rs2[rr] = __builtin_amdgcn_rsqf(ss[rr] * (1.0f / D) + EPS);
        }
#pragma unroll
        for (int rr = 0; rr < R; ++rr) {
            const int ir = (rr == 0 || v1) ? i + rr : i;
#pragma unroll
            for (int j = 0; j < 4; ++j) {
                if (MODE == 2) *(f32x4*)(xout + (size_t)ir * D + 256 * j + 4 * lane) = x[rr][j];
                if (MODE == 1) { u32x2 o; o.x = pk2(x[rr][j][0], x[rr][j][1]); o.y = pk2(x[rr][j][2], x[rr][j][3]); *(u32x2*)(xoutb + (size_t)ir * D + 256 * j + 4 * lane) = o; }
                if (MODE != 2) { const f32x4 h = (x[rr][j] * rs2[rr]) * GA[j] + SH[j]; u32x2 o; o.x = pk2(h[0], h[1]); o.y = pk2(h[2], h[3]); *(u32x2*)(H + (size_t)ir * D + 256 * j + 4 * lane) = o; }
            }
        }
#pragma unroll
        for (int rr = 0; rr < R; ++rr)
#pragma unroll
            for (int j = 0; j < 4; ++j) { if (XBF) xcb[rr][j] = xnb[rr][j]; else xcf[rr][j] = xnf[rr][j]; if (MODE != 0) yc[rr][j] = yn[rr][j]; }
    }
}
template <int MODE>
__device__ __forceinline__ void row_phase(const Args& a, bool x_from_input, int lb, int wgt, const float* gpost, int lh, int wsh, const float* gpre) {
    int tid = threadIdx.x; asm volatile("" : "+v"(tid));
    const int lane = tid & 63, wave = __builtin_amdgcn_readfirstlane(tid >> 6);
    const int gw = blockIdx.x * 8 + wave, NGW = gridDim.x * 8;
    const bf16* Y = (const bf16*)(a.ws + WS_Y); bf16* H = (bf16*)(a.ws + WS_H); bf16* XB = (bf16*)(a.ws + WS_XB);
    const int nchunk = MP / 32 + MS;
    for (int ch = gw; ch < nchunk; ch += NGW) {
        int row0, nrows, r;
        if (ch < MP / 32) { row0 = ch * 32; nrows = 32; r = row0 / T_P; } else { const int j = ch - MP / 32; row0 = MP + j; nrows = 1; r = NB + j / T_S; }
        f32x4 GB[4], GA[4], SH[4];
        if (MODE != 0) { f32x4 gt[4], gp[4]; load_mod(a, lb, r, wgt, lane, gt); load_vec(gpost, lane, gp);
#pragma unroll
            for (int j = 0; j < 4; ++j) GB[j] = gt[j] * gp[j]; }
        if (MODE != 2) { f32x4 sc[4], gp[4]; load_mod(a, lh, r, wsh + 1, lane, sc); load_mod(a, lh, r, wsh, lane, SH); load_vec(gpre, lane, gp);
#pragma unroll
            for (int j = 0; j < 4; ++j) GA[j] = gp[j] * (1.0f + sc[j]); }
        const float* xin = (row0 < MP ? a.in[I_XP] + (size_t)row0 * D : a.in[I_XS] + (size_t)(row0 - MP) * D);
        if (MODE == 0 || (MODE == 1 && x_from_input)) rows_do<MODE, false>(xin, XB + (size_t)row0 * D, a.out + (size_t)row0 * D, XB + (size_t)row0 * D, Y + (size_t)row0 * D, H + (size_t)row0 * D, nrows, GB, GA, SH, lane);
        else rows_do<(MODE == 0 ? 1 : MODE), true>(xin, XB + (size_t)row0 * D, a.out + (size_t)row0 * D, XB + (size_t)row0 * D, Y + (size_t)row0 * D, H + (size_t)row0 * D, nrows, GB, GA, SH, lane);
    }
}

template <int N, int SZ>
__device__ __forceinline__ void tr_reduce_step(float (&v)[SZ], int lane) {
    constexpr int Hh = N / 2;
    const bool up = (lane & Hh) != 0;
#pragma unroll
    for (int i = 0; i < Hh; ++i) { const float send = up ? v[i] : v[i + Hh]; const float keep = up ? v[i + Hh] : v[i]; v[i] = keep + __shfl_xor(send, Hh); }
}
template <int R, int N> struct ConvLoop {
    static __device__ __forceinline__ void run(f32x2 (&z)[32], const f32x2 (&w)[31], const LAS unsigned* up) {
        const unsigned v = up[R * 192]; const f32x2 uv = {bflo(v), bfhi(v)};
#pragma unroll
        for (int i = (R - 30 > 0 ? R - 30 : 0); i <= (R < 31 ? R : 31); ++i) z[i] += w[R - i] * uv;
        if ((R & 7) == 7) asm volatile("" ::: "memory");
        ConvLoop<R + 1, N>::run(z, w, up);
    }
};
template <int N> struct ConvLoop<N, N> { static __device__ __forceinline__ void run(f32x2 (&)[32], const f32x2 (&)[31], const LAS unsigned*) {} };

constexpr int MIX_UC = 0, MIX_XA = 73728, XA_PITCH = 528, MIX_ST = MIX_XA + 79 * XA_PITCH;
static_assert(MIX_ST + 6 * 64 * 4 <= 131072, "mixer LDS");

__device__ __forceinline__ void mixer_phase(const Args& a, int l, LAS unsigned char* lds, int mode = 7) {
    const bf16* P = (const bf16*)(a.ws + WS_P); bf16* CAT = (bf16*)(a.ws + WS_CAT);
    LAS bf16* Uc = (LAS bf16*)(lds + MIX_UC);
    LAS unsigned char* XaB = lds + MIX_XA;
    LAS float* ST = (LAS float*)(lds + MIX_ST);
    const int NU = MP / 64 + NDB;
    for (int u = blockIdx.x; u < NU; u += gridDim.x) {
        int tid = threadIdx.x; asm volatile("" : "+v"(tid));
        const int lane = tid & 63, wave = __builtin_amdgcn_readfirstlane(tid >> 6);
        int rowbase, T, t0, start, b; bool smp;
        if (u < MP / 64) {
            int uu = u;
            if (gridDim.x == 256) { const int k_ = u >> 8, c_ = u & 255; uu = (8 * k_ + (c_ & 7)) * 32 + (((c_ >> 3) + 8 * k_) & 31); }
            b = uu / 32; t0 = (uu % 32) * 64; T = T_P; start = 0; rowbase = b * T_P; smp = false; }
        else { b = u - MP / 64; t0 = 0; T = T_S; start = PASTLEN; rowbase = MP + b * T_S; smp = true; }
        const int nbat = smp ? NDB : NB;
        float* pool_out = a.out + (smp ? O_POOLS : O_POOLP) + ((size_t)l * nbat + b) * 15 * 256;
        float* conv_out = a.out + (smp ? O_CONVS : O_CONVP) + ((size_t)l * nbat + b) * 30 * 384;
        float* sc_out = a.out + (smp ? O_SCS : O_SCP) + ((size_t)l * nbat + b) * 2 * 384;
        const float* st_pool = a.in[I_SPOOL] + ((size_t)l * NDB + b) * 15 * 256;
        const float* st_conv = a.in[I_SCONV] + ((size_t)l * NDB + b) * 30 * 384;
        const float* st_sc = a.in[I_SSC] + ((size_t)l * NDB + b) * 2 * 384;
        const int seg = tid / 48, oc = tid - seg * 48, cc = oc * 8;
        u32x4 va[12], vb[5];
        if (tid < 384) {
#pragma unroll
            for (int q = 0; q < 12; ++q) { const int r = seg + 8 * q, t = t0 - 30 + r;
                va[q] = (u32x4){0u, 0u, 0u, 0u};
                if (r < 94 && t >= 0 && t < T) va[q] = *(const u32x4*)(P + (size_t)(rowbase + t) * P2W + 256 + cc); }
        }
#pragma unroll
        for (int q = 0; q < 5; ++q) { const int i = tid + 512 * q, r = i >> 5, o = i & 31, t = t0 - 15 + r;
            vb[q] = (u32x4){0u, 0u, 0u, 0u};
            if (i < 79 * 32 && t >= 0 && t < T) vb[q] = *(const u32x4*)(P + (size_t)(rowbase + t) * P2W + o * 8); }
        if (smp) {
            if (tid < 384) {
#pragma unroll
                for (int q = 0; q < 4; ++q) { const int r = seg + 8 * q, t = r - 30;
                    if (t < 0) { const f32x4 p0 = *(const f32x4*)(st_conv + (30 + t) * 384 + cc), p1 = *(const f32x4*)(st_conv + (30 + t) * 384 + cc + 4);
                        va[q].x = pk2(p0[0], p0[1]); va[q].y = pk2(p0[2], p0[3]); va[q].z = pk2(p1[0], p1[1]); va[q].w = pk2(p1[2], p1[3]); } }
            }
#pragma unroll
            for (int q = 0; q < 1; ++q) { const int i = tid, r = i >> 5, o = i & 31, t = r - 15, c = o * 8;
                if (t < 0) { const f32x4 p0 = *(const f32x4*)(st_pool + (15 + t) * 256 + c), p1 = *(const f32x4*)(st_pool + (15 + t) * 256 + c + 4);
                    vb[q].x = pk2(p0[0], p0[1]); vb[q].y = pk2(p0[2], p0[3]); vb[q].z = pk2(p1[0], p1[1]); vb[q].w = pk2(p1[2], p1[3]); } }
        }
        if (tid < 384) {
#pragma unroll
            for (int q = 0; q < 12; ++q) { const int r = seg + 8 * q; if (r < 94) *(LAS u32x4*)(Uc + r * 384 + cc) = va[q]; }
        }
#pragma unroll
        for (int q = 0; q < 5; ++q) { const int i = tid + 512 * q, r = i >> 5, o = i & 31; if (i < 79 * 32) *(LAS u32x4*)(XaB + r * XA_PITCH + o * 16) = vb[q]; }
        if (t0 + 64 >= T && !smp) {
            u32x4 cw[3], pw, sw;
#pragma unroll
            for (int q = 0; q < 3; ++q) { const int i = tid + 512 * q, sr = i / 48, o = i - sr * 48; cw[q] = (u32x4){0u, 0u, 0u, 0u};
                if (i < 30 * 48) cw[q] = *(const u32x4*)(P + (size_t)(rowbase + T - 30 + sr) * P2W + 256 + o * 8); }
            pw = (u32x4){0u, 0u, 0u, 0u}; sw = (u32x4){0u, 0u, 0u, 0u};
            if (tid < 15 * 32) pw = *(const u32x4*)(P + (size_t)(rowbase + T - 15 + (tid >> 5)) * P2W + (tid & 31) * 8);
            if (tid < 2 * 48) sw = *(const u32x4*)(P + (size_t)(rowbase + T - 2 + tid / 48) * P2W + 640 + (tid % 48) * 8);
#pragma unroll
            for (int q = 0; q < 3; ++q) { const int i = tid + 512 * q, sr = i / 48, o = i - sr * 48; const u32x4 w = cw[q];
                if (i < 30 * 48) { float* d = conv_out + sr * 384 + o * 8; *(f32x4*)d = (f32x4){bflo(w.x), bfhi(w.x), bflo(w.y), bfhi(w.y)}; *(f32x4*)(d + 4) = (f32x4){bflo(w.z), bfhi(w.z), bflo(w.w), bfhi(w.w)}; } }
            if (tid < 15 * 32) { float* d = pool_out + (tid >> 5) * 256 + (tid & 31) * 8; *(f32x4*)d = (f32x4){bflo(pw.x), bfhi(pw.x), bflo(pw.y), bfhi(pw.y)}; *(f32x4*)(d + 4) = (f32x4){bflo(pw.z), bfhi(pw.z), bflo(pw.w), bfhi(pw.w)}; }
            if (tid < 2 * 48) { float* d = sc_out + (tid / 48) * 384 + (tid % 48) * 8; *(f32x4*)d = (f32x4){bflo(sw.x), bfhi(sw.x), bflo(sw.y), bfhi(sw.y)}; *(f32x4*)(d + 4) = (f32x4){bflo(sw.z), bfhi(sw.z), bflo(sw.w), bfhi(sw.w)}; }
        } else if (t0 + 64 >= T) {
            f32x4 a0v = {0.f, 0.f, 0.f, 0.f}, a1v = a0v, b0v = a0v, b1v = a0v; u32x4 bw = {0u, 0u, 0u, 0u}, cw2 = bw, pw = bw, sw = bw;
            { const int i = tid, sr = i / 48, c = (i - sr * 48) * 8; a0v = *(const f32x4*)(st_conv + (16 + sr) * 384 + c); a1v = *(const f32x4*)(st_conv + (16 + sr) * 384 + c + 4); }
            const int i1 = tid + 512, sr1 = i1 / 48, c1 = (i1 - sr1 * 48) * 8, t1 = sr1 - 14;
            if (t1 < 0) { b0v = *(const f32x4*)(st_conv + (30 + t1) * 384 + c1); b1v = *(const f32x4*)(st_conv + (30 + t1) * 384 + c1 + 4); }
            else bw = *(const u32x4*)(P + (size_t)(rowbase + t1) * P2W + 256 + c1);
            const int i2 = tid + 1024, sr2 = i2 / 48, c2 = (i2 - sr2 * 48) * 8;
            if (i2 < 30 * 48) cw2 = *(const u32x4*)(P + (size_t)(rowbase + sr2 - 14) * P2W + 256 + c2);
            if (tid < 15 * 32) pw = *(const u32x4*)(P + (size_t)(rowbase + (tid >> 5) + 1) * P2W + (tid & 31) * 8);
            if (tid < 2 * 48) sw = *(const u32x4*)(P + (size_t)(rowbase + 14 + tid / 48) * P2W + 640 + (tid % 48) * 8);
            { const int i = tid, sr = i / 48, c = (i - sr * 48) * 8; float* d = conv_out + sr * 384 + c; *(f32x4*)d = a0v; *(f32x4*)(d + 4) = a1v; }
            { float* d = conv_out + sr1 * 384 + c1;
              if (t1 < 0) { *(f32x4*)d = b0v; *(f32x4*)(d + 4) = b1v; }
              else { *(f32x4*)d = (f32x4){bflo(bw.x), bfhi(bw.x), bflo(bw.y), bfhi(bw.y)}; *(f32x4*)(d + 4) = (f32x4){bflo(bw.z), bfhi(bw.z), bflo(bw.w), bfhi(bw.w)}; } }
            if (i2 < 30 * 48) { float* d = conv_out + sr2 * 384 + c2; *(f32x4*)d = (f32x4){bflo(cw2.x), bfhi(cw2.x), bflo(cw2.y), bfhi(cw2.y)}; *(f32x4*)(d + 4) = (f32x4){bflo(cw2.z), bfhi(cw2.z), bflo(cw2.w), bfhi(cw2.w)}; }
            if (tid < 15 * 32) { float* d = pool_out + (tid >> 5) * 256 + (tid & 31) * 8; *(f32x4*)d = (f32x4){bflo(pw.x), bfhi(pw.x), bflo(pw.y), bfhi(pw.y)}; *(f32x4*)(d + 4) = (f32x4){bflo(pw.z), bfhi(pw.z), bflo(pw.w), bfhi(pw.w)}; }
            if (tid < 2 * 48) { float* d = sc_out + (tid / 48) * 384 + (tid % 48) * 8; *(f32x4*)d = (f32x4){bflo(sw.x), bfhi(sw.x), bflo(sw.y), bfhi(sw.y)}; *(f32x4*)(d + 4) = (f32x4){bflo(sw.z), bfhi(sw.z), bflo(sw.w), bfhi(sw.w)}; }
        }
        if (tid < 384) {
            float w0[8], w1[8], w2[8];
            { const float* ws = a.in[I_WSC] + (size_t)l * 3 * 384 + cc;
#pragma unroll
              for (int e = 0; e < 8; ++e) { w0[e] = ws[e]; w1[e] = ws[384 + e]; w2[e] = ws[768 + e]; } }
            float up2[8], up1[8];
#pragma unroll
            for (int ps = 0; ps < 2; ++ps) {
                u32x4 vu[6], vg[4];
#pragma unroll
                for (int d = (ps ? 2 : 0); d < 6; ++d) { const int t = t0 + 8 * seg + 4 * ps + d - 2; vu[d] = (u32x4){0u, 0u, 0u, 0u};
                    if (t >= 0 && t < T) vu[d] = *(const u32x4*)(P + (size_t)(rowbase + t) * P2W + 640 + cc); }
#pragma unroll
                for (int d = 0; d < 4; ++d) { const int t = t0 + 8 * seg + 4 * ps + d; vg[d] = (u32x4){0u, 0u, 0u, 0u};
                    if (t < T) vg[d] = *(const u32x4*)(P + (size_t)(rowbase + t) * P2W + 1024 + cc); }
#pragma unroll
                for (int d = (ps ? 2 : 0); d < 6; ++d) {
                    const int t = t0 + 8 * seg + 4 * ps + d - 2;
                    float uc[8];
#pragma unroll
                    for (int e = 0; e < 4; ++e) { uc[2 * e] = bflo(vu[d][e]); uc[2 * e + 1] = bfhi(vu[d][e]); }
                    if (ps == 0 && d < 2 && smp && t < 0) { const f32x4 p0 = *(const f32x4*)(st_sc + (2 + t) * 384 + cc), p1 = *(const f32x4*)(st_sc + (2 + t) * 384 + cc + 4);
#pragma unroll
                        for (int e = 0; e < 4; ++e) { uc[e] = p0[e]; uc[4 + e] = p1[e]; } }
                    if (d >= 2) {
                        const u32x4 bv = vg[d - 2];
                        float y[8];
#pragma unroll
                        for (int e = 0; e < 4; ++e) {
                            y[2 * e] = bflo(bv[e]) * (w0[2 * e] * up2[2 * e] + w1[2 * e] * up1[2 * e] + w2[2 * e] * uc[2 * e]);
                            y[2 * e + 1] = bfhi(bv[e]) * (w0[2 * e + 1] * up2[2 * e + 1] + w1[2 * e + 1] * up1[2 * e + 1] + w2[2 * e + 1] * uc[2 * e + 1]); }
                        { u32x4 w; w.x = pk2(y[0], y[1]); w.y = pk2(y[2], y[3]); w.z = pk2(y[4], y[5]); w.w = pk2(y[6], y[7]);
                          *(u32x4*)(CAT + (size_t)(t < T ? rowbase + t : MR + (t & 63)) * D + 640 + cc) = w; }
                    }
#pragma unroll
                    for (int e = 0; e < 8; ++e) { if (ps == 1 || d >= 1) up2[e] = up1[e]; up1[e] = uc[e]; }
                }
            }
        }
        __syncthreads();
        f32x2 z[32];
        int tid2 = tid; asm volatile("" : "+v"(tid2));
        const int half = (tid2 >= 192) ? 1 : 0, p = tid2 - 192 * half;
        const bool rows_live = (t0 + 32 * half) < T;
        if (wave < 6 && (mode & 2) && rows_live) {
            f32x2 w[31];
            const float* wd = a.in[I_WDW] + (size_t)l * 31 * 384 + 2 * p;
#pragma unroll
            for (int j = 0; j < 31; ++j) w[j] = *(const f32x2*)(wd + j * 384);
            const f32x2 bb = *(const f32x2*)(a.in[I_BDW] + l * 384 + 2 * p);
#pragma unroll
            for (int i = 0; i < 32; ++i) z[i] = bb;
            const LAS unsigned* up = (const LAS unsigned*)Uc + (32 * half) * 192 + p;
            ConvLoop<0, 62>::run(z, w, up);
            float sv[32];
            { const bool up = (lane & 32) != 0;
#pragma unroll
              for (int i = 0; i < 32; ++i) { const f32x2 zl = z[i >> 1], zh = z[16 + (i >> 1)];
                  const float va_ = (i & 1) ? (zl[0] * zl[0] + zl[1] * zl[1]) : (zl[0] + zl[1]), vb_ = (i & 1) ? (zh[0] * zh[0] + zh[1] * zh[1]) : (zh[0] + zh[1]);
                  const float send = up ? va_ : vb_, keep = up ? vb_ : va_; sv[i] = keep + __shfl_xor(send, 32);
                  if ((i & 7) == 7) asm volatile("" ::: "memory"); } }
            tr_reduce_step<32>(sv, lane); tr_reduce_step<16>(sv, lane); tr_reduce_step<8>(sv, lane); tr_reduce_step<4>(sv, lane); tr_reduce_step<2>(sv, lane);
            ST[wave * 64 + lane] = sv[0];
        } else if (mode & 2) {
            const int fr = tid2 & 15, fq = (tid2 & 63) >> 4;
#pragma unroll 1
            for (int gi = 0; gi < 2; ++gi) {
                const int g = (wave == 6) ? (gi ? 3 : 0) : (gi ? 2 : 1), win = 2 << g;
                bf16x8 Wf[4][2];
#pragma unroll
                for (int nt = 0; nt < 4; ++nt)
#pragma unroll
                    for (int kk = 0; kk < 2; ++kk) { const float* wp = a.in[I_WPOOL] + (((size_t)l * 4 + g) * 64 + 32 * kk + 8 * fq) * 64 + 16 * nt + fr;
                        u32x4 q; q.x = pk2(wp[0], wp[64]); q.y = pk2(wp[128], wp[192]); q.z = pk2(wp[256], wp[320]); q.w = pk2(wp[384], wp[448]);
                        Wf[nt][kk] = __builtin_bit_cast(bf16x8, q); }
                f32x4 spv[4];
#pragma unroll
                for (int nt = 0; nt < 4; ++nt) spv[nt] = *(const f32x4*)(a.in[I_SPOOLW] + l * 256 + 64 * g + 16 * nt + 4 * fq);
#pragma unroll 1
                for (int mt = 0; mt < 4; ++mt) {
                    if (t0 + 16 * mt >= T) break;
                    const int i = 16 * mt + fr, r = i + 15;
                    const int pos = t0 + i + start; const float cnt = (float)((pos + 1 < win) ? pos + 1 : win); const float inv = 1.0f / cnt;
                    bf16x8 Af[2];
#pragma unroll
                    for (int kk = 0; kk < 2; ++kk) {
                        const LAS unsigned char* base = XaB + r * XA_PITCH + (64 * g + 32 * kk + 8 * fq) * 2;
                        float s[8];
#pragma unroll
                        for (int e = 0; e < 8; ++e) s[e] = 0.f;
                        for (int d = 0; d < win; ++d) { const u32x4 v = *(const LAS u32x4*)(base - d * XA_PITCH);
#pragma unroll
                            for (int e = 0; e < 4; ++e) { s[2 * e] += bflo(v[e]); s[2 * e + 1] += bfhi(v[e]); } }
                        const u32x4 cv = *(const LAS u32x4*)base;
                        u32x4 q;
#pragma unroll
                        for (int e = 0; e < 4; ++e) q[e] = pk2(s[2 * e] * inv - bflo(cv[e]), s[2 * e + 1] * inv - bfhi(cv[e]));
                        Af[kk] = __builtin_bit_cast(bf16x8, q);
                    }
                    const bool valid = (t0 + i) < T;
#pragma unroll
                    for (int nt = 0; nt < 4; ++nt) {
                        f32x4 acc = {0.f, 0.f, 0.f, 0.f};
                        acc = __builtin_amdgcn_mfma_f32_16x16x32_bf16(Wf[nt][0], Af[0], acc, 0, 0, 0);
                        acc = __builtin_amdgcn_mfma_f32_16x16x32_bf16(Wf[nt][1], Af[1], acc, 0, 0, 0);
                        const f32x4 sp = spv[nt];
                        u32x2 o; o.x = pk2(acc[0] * sp[0], acc[1] * sp[1]); o.y = pk2(acc[2] * sp[2], acc[3] * sp[3]);
                        *(u32x2*)(CAT + (size_t)(valid ? rowbase + t0 + i : MR + i) * D + 64 * g + 16 * nt + 4 * fq) = o;
                    }
                }
            }
        }
        __syncthreads();
        if (wave < 6 && (mode & 4) && rows_live) {
            f32x2 lg = *(const f32x2*)(a.in[I_LNG] + l * 384 + 2 * p), lb = *(const f32x2*)(a.in[I_LNB] + l * 384 + 2 * p);
            asm volatile("" : "+v"(lg), "+v"(lb));
            const float tot = ST[(3 * half) * 64 + lane] + ST[(3 * half + 1) * 64 + lane] + ST[(3 * half + 2) * 64 + lane];
            const float oth = __shfl_xor(tot, 1);
            const float s1 = (lane & 1) ? oth : tot, s2 = (lane & 1) ? tot : oth;
            const float mu_l = s1 * (1.0f / 384.0f); float var_l = s2 * (1.0f / 384.0f) - mu_l * mu_l; var_l = var_l > 0.f ? var_l : 0.f;
            const float rstd_l = __builtin_amdgcn_rsqf(var_l + EPS);
            const int trow = t0 + 32 * half;
            bf16* crow = CAT + (size_t)(rowbase + trow) * D + 256 + 2 * p;
            bf16* cdummy = CAT + (size_t)(MR + 32 * half) * D + 256 + 2 * p;
#pragma unroll
            for (int i = 0; i < 32; ++i) {
                const float mu = __builtin_bit_cast(float, __builtin_amdgcn_readlane(__builtin_bit_cast(int, mu_l), 2 * i));
                const float rstd = __builtin_bit_cast(float, __builtin_amdgcn_readlane(__builtin_bit_cast(int, rstd_l), 2 * i));
                const f32x2 sc2 = lg * rstd, of2 = lb - sc2 * mu;
                const f32x2 y = z[i] * sc2 + of2;
                *(unsigned*)((trow + i < T ? crow + (size_t)i * D : cdummy + (size_t)i * D)) = pk2(y[0] * sigmoid_f(y[0]), y[1] * sigmoid_f(y[1]));
            }
        }
    }
    __syncthreads();
}


__device__ __forceinline__ void sample_gemm(int kind, const bf16* A, const bf16* Bt, int NT, int K, bf16* O, int ldc) {
    int tid = threadIdx.x; asm volatile("" : "+v"(tid));
    const int lane = tid & 63, wave = __builtin_amdgcn_readfirstlane(tid >> 6), fr = lane & 15, fq = lane >> 4;
    const int gw = blockIdx.x * 8 + wave, NGW = gridDim.x * 8, ntask = NT * 64;
    for (int task = gw; task < ntask; task += NGW) {
        const int mt = task & 7, sb = (task >> 3) & 7, pn = task >> 6;
        const bf16* ap = A + (size_t)(mt * 16 + fr) * K + 8 * fq;
        const bf16* bp0 = Bt + (size_t)(256 * pn + 16 * sb + fr) * K + 8 * fq;
        const bf16* bp1 = bp0 + (size_t)128 * K;
        f32x4 acc0 = {0.f, 0.f, 0.f, 0.f}, acc1 = {0.f, 0.f, 0.f, 0.f};
        bf16x8 fa[4], fb0[4], fb1[4], ga[4], gb0[4], gb1[4];
#pragma unroll
        for (int j = 0; j < 4; ++j) { fa[j] = *(const bf16x8*)(ap + 32 * j); fb0[j] = *(const bf16x8*)(bp0 + 32 * j); fb1[j] = *(const bf16x8*)(bp1 + 32 * j); }
#pragma unroll 1
        for (int k0 = 0; k0 < K; k0 += 256) {
#pragma unroll
            for (int j = 0; j < 4; ++j) { ga[j] = *(const bf16x8*)(ap + k0 + 128 + 32 * j); gb0[j] = *(const bf16x8*)(bp0 + k0 + 128 + 32 * j); gb1[j] = *(const bf16x8*)(bp1 + k0 + 128 + 32 * j); }
#pragma unroll
            for (int j = 0; j < 4; ++j) { acc0 = __builtin_amdgcn_mfma_f32_16x16x32_bf16(fb0[j], fa[j], acc0, 0, 0, 0); acc1 = __builtin_amdgcn_mfma_f32_16x16x32_bf16(fb1[j], fa[j], acc1, 0, 0, 0); }
            const int kn = (k0 + 256 < K) ? k0 + 256 : k0;
#pragma unroll
            for (int j = 0; j < 4; ++j) { fa[j] = *(const bf16x8*)(ap + kn + 32 * j); fb0[j] = *(const bf16x8*)(bp0 + kn + 32 * j); fb1[j] = *(const bf16x8*)(bp1 + kn + 32 * j); }
#pragma unroll
            for (int j = 0; j < 4; ++j) { acc0 = __builtin_amdgcn_mfma_f32_16x16x32_bf16(gb0[j], ga[j], acc0, 0, 0, 0); acc1 = __builtin_amdgcn_mfma_f32_16x16x32_bf16(gb1[j], ga[j], acc1, 0, 0, 0); }
        }
        bf16* orow = O + (size_t)(mt * 16 + fr) * ldc + 16 * sb + 4 * fq;
        int mode = 0, col = 256 * pn;
        if (kind == 0) { if (pn == 0) col = 0; else if (pn >= 7) { col = 1024 + (pn - 7) * 256; if (pn == 8) mode = 1; } else if (pn <= 3) { mode = 2; col = 256 + (pn - 1) * 128; } else { mode = 3; col = 640 + (pn - 4) * 128; } }
        else if (kind == 2) { mode = 4; col = 128 * pn; }
        if (mode <= 1) {
            u32x2 o; o.x = pk2(acc0[0], acc0[1]); o.y = pk2(acc0[2], acc0[3]); *(u32x2*)(orow + col) = o;
            if (mode == 0) { u32x2 q; q.x = pk2(acc1[0], acc1[1]); q.y = pk2(acc1[2], acc1[3]); *(u32x2*)(orow + col + 128) = q; }
        } else {
            f32x4 r;
#pragma unroll
            for (int e = 0; e < 4; ++e) r[e] = (mode == 2) ? acc0[e] * sigmoid_f(acc1[e]) : (mode == 3) ? acc0[e] * acc1[e] : acc0[e] * sigmoid_f(acc0[e]) * acc1[e];
            u32x2 o; o.x = pk2(r[0], r[1]); o.y = pk2(r[2], r[3]); *(u32x2*)(orow + col) = o;
        }
    }
}

constexpr int NPH = 16;
__global__ void __launch_bounds__(512) mega_fwd(Args a) {
    extern __shared__ __attribute__((aligned(16))) unsigned char lds_raw[];
    LAS unsigned char* lds = (LAS unsigned char*)lds_raw;
    cg::grid_group grid = cg::this_grid();
#if ONE_LAUNCH
    volatile LAS unsigned* xst = (volatile LAS unsigned*)(lds + 131072 + 256);
    if (threadIdx.x < 2) xst[threadIdx.x] = 0u;
    __syncthreads();
    const XcdBarrier xbar = xcd_barrier_post((unsigned*)a.ws, xst);
#endif
    bf16* H = (bf16*)(a.ws + WS_H); bf16* Y = (bf16*)(a.ws + WS_Y); bf16* P = (bf16*)(a.ws + WS_P); bf16* CAT = (bf16*)(a.ws + WS_CAT); bf16* ACT = (bf16*)(a.ws + WS_ACT);
#ifdef SYNC_PROBE
    for (int i_ = 0; i_ < SYNC_PROBE; ++i_) grid.sync();
#endif
    for (int ph = a.ph_lo; ph < a.ph_hi; ++ph) {
#ifdef DUP_MASK
      const int kk_ = ph < 2 ? ph + 7 : (ph - 2) % 7;
      const int nrep_ = ((DUP_MASK >> kk_) & 1) ? 2 : 1;
      for (int rep_ = 0; rep_ < nrep_; ++rep_) {
        if (rep_) grid.sync();
#endif
        if (ph == 0) {
#ifndef SKIP_P0
            p0_prologue(a, lds);
#endif
        }
        else if (ph == 1) {
#ifndef SKIP_ROW
            row_phase<0>(a, true, 0, 0, nullptr, 0, 0, a.in[I_GPREMIX]);
#endif
        }
        else {
            const int l = (ph - 2) / 7, k = (ph - 2) % 7;
            const unsigned char* wl = a.ws + WS_W + (size_t)l * WL_SZ;
            if (k == 0 || k == 2 || k == 4 || k == 5) {
                const bf16* sA; const bf16* sB; bf16* sO; int sNT, sK, sld, skind;
                if (k == 0) {
                    pg8::Gemm g{H, (const bf16*)(wl + WL_IN), MP, INWP, D}; pg8::EpiInProj E{P, P2W};
                    pg8::StaticOrder S; S.init(g.M, g.N, gridDim.x, blockIdx.x);
                    pg8::gemm_phase<pg8::EpiInProj, pg8::StaticOrder, true, true>(lds, g, S, E);
                    sA = H; sB = g.Bt; sO = P; sNT = INWP / 256; sK = D; sld = P2W; skind = 0;
                } else if (k == 4) {
#ifndef SKIP_G3
                    pg8::Gemm g{H, (const bf16*)(wl + WL_GU), MP, NGU, D}; pg8::EpiSwiGLU E{ACT, DFF};
                    pg8::StaticOrder S; S.init(g.M, g.N, gridDim.x, blockIdx.x);
                    pg8::gemm_phase<pg8::EpiSwiGLU, pg8::StaticOrder, true, true>(lds, g, S, E);
#endif
                    sA = H; sB = (const bf16*)(wl + WL_GU); sO = ACT; sNT = NGU / 256; sK = D; sld = DFF; skind = 2;
                } else {
#ifndef SKIP_G1
                    pg8::Gemm g; pg8::EpiBf16 E;
                    if (k == 2) { g = pg8::Gemm{CAT, (const bf16*)(wl + WL_OUT), MP, D, D}; E = pg8::EpiBf16{Y, D}; }
                    else { g = pg8::Gemm{ACT, (const bf16*)(wl + WL_DN), MP, D, DFF}; E = pg8::EpiBf16{Y, D}; }
                    pg8::StaticOrder S; S.init(g.M, g.N, gridDim.x, blockIdx.x);
                    pg8::gemm_phase<pg8::EpiBf16, pg8::StaticOrder, true, true>(lds, g, S, E);
#endif
                    sA = (k == 2) ? CAT : ACT; sB = (const bf16*)(wl + (k == 2 ? WL_OUT : WL_DN)); sO = Y; sNT = D / 256; sK = (k == 2) ? D : DFF; sld = D; skind = 1;
                }
                sample_gemm(skind, sA + (size_t)MP * sK, sB, sNT, sK, sO + (size_t)MP * sld, sld);
            } else if (k == 1) {
#ifndef SKIP_MIX
#ifdef MIX_PROBE
                for (int rep = 0; rep < 2; ++rep) { int md = rep ? 7 : MIX_PROBE; asm volatile("" : "+s"(md)); mixer_phase(a, l, lds, md); if (rep == 0) grid.sync(); }
#else
                mixer_phase(a, l, lds);
#endif
#endif
            }
            else if (k == 3) {
#ifndef SKIP_ROW
                row_phase<1>(a, l == 0, l, 2, a.in[I_GPOSTMIX] + l * D, l, 3, a.in[I_GPREFFN] + l * D);
#endif
            }
            else {
#ifndef SKIP_ROW
                if (l == 0) row_phase<1>(a, false, 0, 5, a.in[I_GPOSTFFN], 1, 0, a.in[I_GPREMIX] + D);
                else row_phase<2>(a, false, 1, 5, a.in[I_GPOSTFFN] + D, 1, 0, nullptr);
#endif
            }
        }
#ifdef DUP_MASK
      }
#endif
#if ONE_LAUNCH
        if (ph + 1 < a.ph_hi) { if (a.ph_lo != 0) grid.sync(); else xcd_barrier(xbar); }
#else
        if (ph + 1 < a.ph_hi) grid.sync();
#endif
    }
}

extern "C" void kernel_launch(void* const* d_in, const int* in_sizes, int n_in, void* d_out, int out_size, void* d_ws, size_t ws_size, hipStream_t stream) {
    static int grid = 0;
    if (grid == 0) {
        if (n_in != 25 || ws_size < WS_END) { fprintf(stderr, "kernel_launch: unexpected n_in %d / ws_size %zu\n", n_in, ws_size); grid = -1; return; }
        int dev = 0, cus = 0, per_cu = 0;
        hipGetDevice(&dev); hipDeviceGetAttribute(&cus, hipDeviceAttributeMultiprocessorCount, dev);
        if (hipFuncSetAttribute((const void*)mega_fwd, hipFuncAttributeMaxDynamicSharedMemorySize, LDS_BYTES) != hipSuccess) { fprintf(stderr, "kernel_launch: hipFuncSetAttribute failed\n"); grid = -1; return; }
        if (hipOccupancyMaxActiveBlocksPerMultiprocessor(&per_cu, (const void*)mega_fwd, 512, LDS_BYTES) != hipSuccess || per_cu < 1) { fprintf(stderr, "kernel_launch: occupancy query gave %d\n", per_cu); per_cu = 1; }
        (void)hipGetLastError();
        grid = cus;
    }
    if (grid < 0) return;
    Args a{};
    for (int i = 0; i < 25; ++i) a.in[i] = (const float*)d_in[i];
    a.out = (float*)d_out; a.ws = (unsigned char*)d_ws;
#if ONE_LAUNCH
    if (hipMemsetAsync(d_ws, 0, 16384, stream) != hipSuccess) { fprintf(stderr, "kernel_launch: memset of the barrier words failed\n"); return; }
    a.ph_lo = 0; a.ph_hi = NPH;
    void* args[] = {&a};
    hipError_t e = hipLaunchCooperativeKernel((const void*)mega_fwd, dim3(grid), dim3(512), args, LDS_BYTES, stream);
    if (e != hipSuccess) fprintf(stderr, "cooperative launch failed: %s (grid %d)\n", hipGetErrorString(e), grid);
#else
    (void)hipMemsetAsync(d_ws, 0, 16384, stream);
    for (int ph = 0; ph < NPH; ++ph) { a.ph_lo = ph; a.ph_hi = ph + 1; hipLaunchKernelGGL(mega_fwd, dim3(grid), dim3(512), LDS_BYTES, stream, a); }
#endif
}
```

```cpp
#include <hip/hip_runtime.h>
#include <hip/hip_cooperative_groups.h>
#include <cstdio>
#include <cstdint>
namespace cg = cooperative_groups;

#ifndef ONE_LAUNCH
#define ONE_LAUNCH 1
#endif

namespace pg8 {
#define PG8_LAS __attribute__((address_space(3)))
typedef unsigned short bf16_t;
typedef short bf16x8 __attribute__((ext_vector_type(8)));
typedef float f32x4 __attribute__((ext_vector_type(4)));
typedef unsigned u32x4 __attribute__((ext_vector_type(4)));
constexpr int BM = 256, BK = 64, HALF = 128, HTB = HALF * BK * 2, STAGE_BYTES = 8 * HTB, NXCD = 8, WGM = 4;

__host__ __device__ __forceinline__ int lds_byte(int r, int c) { const int st = (r >> 4) * 2 + (c >> 5), rr = r & 15, cc = c & 31, ob = rr * 64 + cc * 2; return st * 1024 + (ob ^ (((ob >> 9) & 1) << 5)); }
__host__ __device__ __forceinline__ void stage_rc(int b, int& R, int& C) { const int st = b / 1024, sb = b % 1024, swz = sb ^ (((sb >> 9) & 1) << 5); R = (st >> 1) * 16 + swz / 64; C = (st & 1) * 32 + (swz % 64) / 2; }
__host__ __device__ __forceinline__ int perm32(int rho) { const int n = rho >> 4, i = rho & 15; return 8 * (i >> 2) + 4 * n + (i & 3); }

struct Unit { int pm, pn; };
struct Gemm { const bf16_t* A; const bf16_t* Bt; int M, N, K; };

struct StaticOrder {
    int nM, nN, nwg, G, c;
    __host__ __device__ void init(int M, int N, int G_, int c_) { nM = M / BM; nN = N / BM; nwg = nM * nN; G = G_; c = c_; }
    __host__ __device__ bool next(int i, Unit& u) const {
        const long L = (long)i * G + c; if (L >= nwg) return false;
        int wgid = (int)L; { const int q = nwg / NXCD, r = nwg % NXCD, xcd = wgid % NXCD, off = wgid / NXCD; wgid = (xcd < r ? xcd * (q + 1) : r * (q + 1) + (xcd - r) * q) + off; }
        const int nig = WGM * nN, gid = wgid / nig, fm = gid * WGM, gsz = (nM - fm) < WGM ? (nM - fm) : WGM;
        u.pm = fm + ((wgid % nig) % gsz); u.pn = (wgid % nig) / gsz; return true;
    }
    __device__ __forceinline__ void a_ready(const Unit&) const {}
    __device__ __forceinline__ void done(const Unit&) const {}
};

__device__ __forceinline__ unsigned cvt_pk_bf16(float lo, float hi) { unsigned r; asm volatile("v_cvt_pk_bf16_f32 %0, %1, %2" : "=v"(r) : "v"(lo), "v"(hi)); return r; }

struct EpiBf16 {
    static constexpr bool PERM = true, AFTER_DRAIN = false;
    bf16_t* O; int ldc;
    __device__ __forceinline__ void operator()(const f32x4 (&acc)[2][2][4][2], const Unit& u, int wr, int wc, int fr, int fq) const {
        const int row0 = u.pm * BM + wr * 64 + fr; const int col0 = u.pn * BM + wc * 32 + 8 * fq;
#pragma unroll
        for (int ai = 0; ai < 2; ++ai)
#pragma unroll
            for (int m = 0; m < 4; ++m) { bf16_t* rowp = O + (size_t)(row0 + ai * HALF + m * 16) * ldc + col0;
#pragma unroll
                for (int bj = 0; bj < 2; ++bj) { const f32x4 v0 = acc[ai][bj][m][0], v1 = acc[ai][bj][m][1];
                    u32x4 w; w.x = cvt_pk_bf16(v0[0], v0[1]); w.y = cvt_pk_bf16(v0[2], v0[3]); w.z = cvt_pk_bf16(v1[0], v1[1]); w.w = cvt_pk_bf16(v1[2], v1[3]);
                    *(u32x4*)(rowp + bj * HALF) = w; } }
    }
};
__device__ __forceinline__ float silu_f(float g) { return g * __builtin_amdgcn_rcpf(1.0f + __builtin_amdgcn_exp2f(-1.44269504089f * g)); }
struct EpiSwiGLU {
    static constexpr bool PERM = true, AFTER_DRAIN = false;
    bf16_t* O; int ldc;
    __device__ __forceinline__ void operator()(const f32x4 (&acc)[2][2][4][2], const Unit& u, int wr, int wc, int fr, int fq) const {
        const int row0 = u.pm * BM + wr * 64 + fr; const int col0 = u.pn * HALF + wc * 32 + 8 * fq;
#pragma unroll
        for (int ai = 0; ai < 2; ++ai)
#pragma unroll
            for (int m = 0; m < 4; ++m) { bf16_t* rowp = O + (size_t)(row0 + ai * HALF + m * 16) * ldc + col0;
                const f32x4 g0 = acc[ai][0][m][0], g1 = acc[ai][0][m][1], u0 = acc[ai][1][m][0], u1 = acc[ai][1][m][1];
                u32x4 w;
                w.x = cvt_pk_bf16(silu_f(g0[0]) * u0[0], silu_f(g0[1]) * u0[1]); w.y = cvt_pk_bf16(silu_f(g0[2]) * u0[2], silu_f(g0[3]) * u0[3]);
                w.z = cvt_pk_bf16(silu_f(g1[0]) * u1[0], silu_f(g1[1]) * u1[1]); w.w = cvt_pk_bf16(silu_f(g1[2]) * u1[2], silu_f(g1[3]) * u1[3]);
                *(u32x4*)rowp = w; asm volatile("" ::: "memory"); }
    }
};

__device__ __forceinline__ float sigm_f(float g) { return __builtin_amdgcn_rcpf(1.0f + __builtin_amdgcn_exp2f(-1.44269504089f * g)); }
struct EpiInProj {
    static constexpr bool PERM = true, AFTER_DRAIN = false;
    bf16_t* O; int ldc;
    __device__ __forceinline__ void operator()(const f32x4 (&acc)[2][2][4][2], const Unit& u, int wr, int wc, int fr, int fq) const {
        const int row0 = u.pm * BM + wr * 64 + fr; const int cl = wc * 32 + 8 * fq; const int pn = u.pn;
        if (pn == 0 || pn >= 7) {
            const int col0 = (pn == 0 ? 0 : 1024 + (pn - 7) * 256) + cl;
#pragma unroll
            for (int ai = 0; ai < 2; ++ai)
#pragma unroll
                for (int m = 0; m < 4; ++m) { bf16_t* rowp = O + (size_t)(row0 + ai * HALF + m * 16) * ldc + col0;
#pragma unroll
                    for (int bj = 0; bj < 2; ++bj) { const f32x4 v0 = acc[ai][bj][m][0], v1 = acc[ai][bj][m][1];
                        u32x4 w; w.x = cvt_pk_bf16(v0[0], v0[1]); w.y = cvt_pk_bf16(v0[2], v0[3]); w.z = cvt_pk_bf16(v1[0], v1[1]); w.w = cvt_pk_bf16(v1[2], v1[3]);
                        if (bj == 0 || pn != 8) *(u32x4*)(rowp + bj * HALF) = w; } }
        } else {
            const bool glu = pn <= 3; const int col0 = (glu ? 256 + (pn - 1) * 128 : 640 + (pn - 4) * 128) + cl;
#pragma unroll
            for (int ai = 0; ai < 2; ++ai)
#pragma unroll
                for (int m = 0; m < 4; ++m) { bf16_t* rowp = O + (size_t)(row0 + ai * HALF + m * 16) * ldc + col0;
                    const f32x4 a0 = acc[ai][0][m][0], a1 = acc[ai][0][m][1]; f32x4 g0 = acc[ai][1][m][0], g1 = acc[ai][1][m][1];
                    if (glu) {
#pragma unroll
                        for (int e = 0; e < 4; ++e) { g0[e] = sigm_f(g0[e]); g1[e] = sigm_f(g1[e]); } }
                    u32x4 w; w.x = cvt_pk_bf16(a0[0] * g0[0], a0[1] * g0[1]); w.y = cvt_pk_bf16(a0[2] * g0[2], a0[3] * g0[3]);
                    w.z = cvt_pk_bf16(a1[0] * g1[0], a1[1] * g1[1]); w.w = cvt_pk_bf16(a1[2] * g1[2], a1[3] * g1[3]);
                    *(u32x4*)rowp = w; asm volatile("" ::: "memory"); }
        }
    }
};

template <class Epi, class Sched, bool ALIGN_EPI = false, bool SP2 = false>
__device__ __forceinline__ void gemm_phase(PG8_LAS unsigned char* lds, const Gemm g, const Sched& S, const Epi& E) {
    int tid_ = threadIdx.x; asm volatile("" : "+v"(tid_));
    const int tid = tid_, wid = __builtin_amdgcn_readfirstlane(tid >> 6), lane = tid & 63, wr = wid >> 2, wc = wid & 3, fr = lane & 15, fq = lane >> 4;
    const int K = g.K, nt = K / BK;
    unsigned voffA[2], voffB[2];
#pragma unroll
    for (int i = 0; i < 2; ++i) { int R, C; stage_rc(tid * 16 + i * 8192, R, C); const int Rb = Epi::PERM ? ((R & ~31) + perm32(R & 31)) : R;
        voffA[i] = (unsigned)(R * K + C) * 2u; voffB[i] = (unsigned)(Rb * K + C) * 2u; }
    const size_t kstep = (size_t)(BK * 2);
    const size_t hstep = (size_t)HALF * K * 2;
    const size_t tstep = 2 * hstep;
    const unsigned ldsw = (unsigned)wid * 1024u;
    const int aoff = lds_byte(wr * 64 + fr, fq * 8), boff = lds_byte(wc * 32 + fr, fq * 8);
#define PG8_SA(b, h) (((b) * 2 + (h)) * HTB)
#define PG8_SB(b, h) ((4 + (b) * 2 + (h)) * HTB)
#define PG8_STAGE(bufoff, gbase, voff) do { _Pragma("unroll") for (int _i = 0; _i < 2; ++_i) \
        __builtin_amdgcn_global_load_lds((const unsigned*)((const char*)(gbase) + (voff)[_i]), (PG8_LAS unsigned*)(lds + (bufoff) + ldsw + _i * 8192), 16, 0, 0); } while (0)
#define PG8_LDA(dst, b, h) do { _Pragma("unroll") for (int m = 0; m < 4; ++m) _Pragma("unroll") for (int k = 0; k < 2; ++k) dst[m][k] = *(const PG8_LAS bf16x8*)(lds + PG8_SA(b, h) + aoff + m * 2048 + k * 1024); } while (0)
#define PG8_LDB(dst, b, h) do { _Pragma("unroll") for (int n = 0; n < 2; ++n) _Pragma("unroll") for (int k = 0; k < 2; ++k) dst[n][k] = *(const PG8_LAS bf16x8*)(lds + PG8_SB(b, h) + boff + n * 2048 + k * 1024); } while (0)
#define PG8_MMA(ai, bj, At, Bt) do { __builtin_amdgcn_s_setprio(1); _Pragma("unroll") for (int m = 0; m < 4; ++m) _Pragma("unroll") for (int n = 0; n < 2; ++n) _Pragma("unroll") for (int k = 0; k < 2; ++k) \
        acc[ai][bj][m][n] = __builtin_amdgcn_mfma_f32_16x16x32_bf16(Bt[n][k], At[m][k], acc[ai][bj][m][n], 0, 0, 0); __builtin_amdgcn_s_setprio(0); } while (0)
#define PG8_WAIT_V(n) asm volatile("s_waitcnt vmcnt(" #n ")" ::: "memory")
#define PG8_WAIT_L(n) asm volatile("s_waitcnt lgkmcnt(" #n ")" ::: "memory")
#define PG8_BAR __builtin_amdgcn_s_barrier()
#define PG8_SCHED __builtin_amdgcn_sched_barrier(0)
    Unit cur, nxt; int ui = 0;
    if (!S.next(0, cur)) return;
#ifdef STAGGER_TICKS
    {
        const unsigned long long t0_ = __builtin_amdgcn_s_memrealtime(); const unsigned long long dl_ = (unsigned long long)((blockIdx.x >> 3) & 7) * STAGGER_TICKS;
        while (__builtin_amdgcn_s_memrealtime() - t0_ < dl_) __builtin_amdgcn_s_sleep(8);
    }
#endif
    f32x4 acc[2][2][4][2];
#pragma unroll
    for (int a = 0; a < 2; ++a)
#pragma unroll
        for (int b = 0; b < 2; ++b)
#pragma unroll
            for (int m = 0; m < 4; ++m)
#pragma unroll
                for (int n = 0; n < 2; ++n) acc[a][b][m][n] = (f32x4){0.f, 0.f, 0.f, 0.f};
    bf16x8 At[4][2], B0[2][2], B1[2][2];
    const char* cA = (const char*)g.A + (size_t)cur.pm * tstep; const char* cB = (const char*)g.Bt + (size_t)cur.pn * tstep;
    S.a_ready(cur);
    if constexpr (SP2) {
        PG8_STAGE(PG8_SB(0, 0), cB, voffB); PG8_STAGE(PG8_SB(0, 1), cB + hstep, voffB); PG8_STAGE(PG8_SA(0, 0), cA, voffA); PG8_STAGE(PG8_SA(0, 1), cA + hstep, voffA);
        if (wr == 1) PG8_BAR;
        PG8_WAIT_V(2); PG8_BAR;
        PG8_STAGE(PG8_SB(1, 0), cB + kstep, voffB); PG8_STAGE(PG8_SA(1, 0), cA + kstep, voffA); PG8_STAGE(PG8_SB(1, 1), cB + hstep + kstep, voffB);
        PG8_WAIT_V(6); PG8_BAR;
    } else {
        PG8_STAGE(PG8_SB(0, 0), cB, voffB); PG8_STAGE(PG8_SA(0, 0), cA, voffA); PG8_STAGE(PG8_SB(0, 1), cB + hstep, voffB); PG8_STAGE(PG8_SA(0, 1), cA + hstep, voffA);
        if (wr == 1) PG8_BAR;
        PG8_WAIT_V(4); PG8_BAR;
        PG8_STAGE(PG8_SB(1, 0), cB + kstep, voffB); PG8_STAGE(PG8_SA(1, 0), cA + kstep, voffA); PG8_STAGE(PG8_SB(1, 1), cB + hstep + kstep, voffB);
        PG8_WAIT_V(6); PG8_BAR;
    }
    for (;;) {
        const bool has_next = S.next(ui + 1, nxt);
        const char* nA = has_next ? (const char*)g.A + (size_t)nxt.pm * tstep : cA; const char* nB = has_next ? (const char*)g.Bt + (size_t)nxt.pn * tstep : cB;
        for (int t = 0; t < nt; t += 2) {
            const bool last = (t == nt - 2);
            const char* a1 = cA + (size_t)(t + 1) * kstep;
            const char* a2 = last ? nA : cA + (size_t)(t + 2) * kstep; const char* b2 = last ? nB : cB + (size_t)(t + 2) * kstep;
            const char* a3 = a2 + kstep; const char* b3 = b2 + kstep;
            if (last && has_next) S.a_ready(nxt);
            if constexpr (SP2) {
            PG8_LDB(B0, 0, 0); PG8_LDB(B1, 0, 1); PG8_SCHED; PG8_LDA(At, 0, 0); PG8_STAGE(PG8_SA(1, 1), a1 + hstep, voffA);
            PG8_WAIT_V(8); PG8_WAIT_L(0); PG8_BAR; PG8_MMA(0, 0, At, B0); PG8_MMA(0, 1, At, B1); PG8_BAR; PG8_SCHED;
            PG8_LDA(At, 0, 1); PG8_STAGE(PG8_SB(0, 0), b2, voffB); PG8_STAGE(PG8_SB(0, 1), b2 + hstep, voffB); PG8_STAGE(PG8_SA(0, 0), a2, voffA);
            PG8_WAIT_V(8); PG8_WAIT_L(0); PG8_BAR; PG8_MMA(1, 0, At, B0); PG8_MMA(1, 1, At, B1); PG8_BAR; PG8_SCHED;
            PG8_LDB(B0, 1, 0); PG8_LDB(B1, 1, 1); PG8_SCHED; PG8_LDA(At, 1, 0); PG8_STAGE(PG8_SA(0, 1), a2 + hstep, voffA);
            PG8_WAIT_V(8); PG8_WAIT_L(0); PG8_BAR; PG8_MMA(0, 0, At, B0); PG8_MMA(0, 1, At, B1); PG8_BAR; PG8_SCHED;
            PG8_LDA(At, 1, 1); PG8_STAGE(PG8_SB(1, 0), b3, voffB); PG8_STAGE(PG8_SB(1, 1), b3 + hstep, voffB); PG8_STAGE(PG8_SA(1, 0), a3, voffA);
            PG8_WAIT_V(8); PG8_WAIT_L(0); PG8_BAR; PG8_MMA(1, 0, At, B0); PG8_MMA(1, 1, At, B1); PG8_BAR; PG8_SCHED;
            } else {
            PG8_LDB(B0, 0, 0); PG8_SCHED; PG8_LDA(At, 0, 0); PG8_STAGE(PG8_SA(1, 1), a1 + hstep, voffA);
            PG8_WAIT_L(8); PG8_BAR; PG8_WAIT_L(0); PG8_MMA(0, 0, At, B0); PG8_BAR; PG8_SCHED;
            PG8_LDB(B1, 0, 1); PG8_STAGE(PG8_SB(0, 0), b2, voffB);
            PG8_BAR; PG8_WAIT_L(0); PG8_MMA(0, 1, At, B1); PG8_BAR;
            PG8_LDA(At, 0, 1); PG8_STAGE(PG8_SA(0, 0), a2, voffA);
            PG8_BAR; PG8_WAIT_L(0); PG8_MMA(1, 0, At, B0); PG8_BAR; PG8_SCHED;
            PG8_STAGE(PG8_SB(0, 1), b2 + hstep, voffB);
            PG8_WAIT_V(6); PG8_BAR; PG8_MMA(1, 1, At, B1); PG8_BAR;
            PG8_LDB(B0, 1, 0); PG8_SCHED; PG8_LDA(At, 1, 0); PG8_STAGE(PG8_SA(0, 1), a2 + hstep, voffA);
            PG8_WAIT_L(8); PG8_BAR; PG8_WAIT_L(0); PG8_MMA(0, 0, At, B0); PG8_BAR; PG8_SCHED;
            PG8_LDB(B1, 1, 1); PG8_STAGE(PG8_SB(1, 0), b3, voffB);
            PG8_BAR; PG8_WAIT_L(0); PG8_MMA(0, 1, At, B1); PG8_BAR;
            PG8_LDA(At, 1, 1); PG8_STAGE(PG8_SA(1, 0), a3, voffA);
            PG8_BAR; PG8_WAIT_L(0); PG8_MMA(1, 0, At, B0); PG8_BAR; PG8_SCHED;
            PG8_STAGE(PG8_SB(1, 1), b3 + hstep, voffB);
            PG8_WAIT_V(6); PG8_BAR; PG8_MMA(1, 1, At, B1); PG8_BAR;
            }
        }
        if constexpr (ALIGN_EPI) { if (wr == 0) PG8_BAR; }
        if constexpr (!Epi::AFTER_DRAIN) { E(acc, cur, wr, wc, fr, fq); S.done(cur); }
        if (!has_next) break;
#pragma unroll
        for (int a = 0; a < 2; ++a)
#pragma unroll
            for (int b = 0; b < 2; ++b)
#pragma unroll
                for (int m = 0; m < 4; ++m)
#pragma unroll
                    for (int n = 0; n < 2; ++n) acc[a][b][m][n] = (f32x4){0.f, 0.f, 0.f, 0.f};
        cur = nxt; cA = nA; cB = nB; ++ui;
        if constexpr (ALIGN_EPI) { if (wr == 1) PG8_BAR; }
    }
    PG8_WAIT_V(0);
    if constexpr (!ALIGN_EPI) { if (wr == 0) PG8_BAR; }
    PG8_BAR;
#undef PG8_SA
#undef PG8_SB
#undef PG8_STAGE
#undef PG8_LDA
#undef PG8_LDB
#undef PG8_MMA
#undef PG8_WAIT_V
#undef PG8_WAIT_L
#undef PG8_BAR
#undef PG8_SCHED
}
}

#define LAS __attribute__((address_space(3)))
typedef unsigned short bf16;
typedef float f32x4 __attribute__((ext_vector_type(4)));
typedef float f32x2 __attribute__((ext_vector_type(2)));
typedef unsigned u32x4 __attribute__((ext_vector_type(4)));
typedef unsigned u32x2 __attribute__((ext_vector_type(2)));
typedef short bf16x8 __attribute__((ext_vector_type(8)));

constexpr int D = 1024, NB = 32, T_P = 2048, NDB = 8, T_S = 16, PASTLEN = 4096;
constexpr int MP = NB * T_P;
constexpr int MS = NDB * T_S;
constexpr int MR = MP + MS;
constexpr int MPAD = 257 * 256;
constexpr int INW = 2176, INWP = 2304, DFF = 2816, NGU = 2 * DFF;
constexpr int PW = 256, CW = 384, SW = 384, P2W = 1408;
constexpr float EPS = 1e-6f;
constexpr int NMODR = NB + NDB;
constexpr int KCH = 8;

constexpr size_t O_YP = 0, O_YS = (size_t)MP * D, O_POOLP = O_YS + (size_t)MS * D, O_CONVP = O_POOLP + 2 * 32 * 15 * 256,
                 O_SCP = O_CONVP + 2 * 32 * 30 * 384, O_POOLS = O_SCP + 2 * 32 * 2 * 384, O_CONVS = O_POOLS + 2 * 8 * 15 * 256, O_SCS = O_CONVS + 2 * 8 * 30 * 384;
constexpr size_t MiB = 1u << 20;
constexpr size_t WL_IN = 0, WL_OUT = (size_t)INWP * D * 2, WL_GU = WL_OUT + (size_t)D * D * 2, WL_DN = WL_GU + (size_t)NGU * D * 2, WL_SZ = WL_DN + (size_t)D * DFF * 2;
static_assert(WL_SZ == 23 * MiB, "weight block");
constexpr size_t WS_W = 2 * MiB, WS_PART = 48 * MiB, WS_H = 64 * MiB, WS_Y = 193 * MiB, WS_P = 322 * MiB, WS_CAT = 612 * MiB, WS_ACT = WS_P, WS_XB = 741 * MiB, WS_END = 870 * MiB;
static_assert(WS_PART + (size_t)2 * NMODR * 6144 * 4 <= WS_H && WS_H + (size_t)MPAD * D * 2 <= WS_Y && WS_Y + (size_t)MPAD * D * 2 <= WS_P && WS_P + (size_t)MPAD * INWP * 2 <= WS_CAT && WS_CAT + (size_t)MPAD * D * 2 <= WS_XB && WS_ACT + (size_t)MPAD * DFF * 2 <= WS_XB && WS_XB + (size_t)MR * D * 2 <= WS_END, "ws map");

constexpr int LDS_BYTES = 147456;

struct Args { const float* in[25]; float* out; unsigned char* ws; int ph_lo, ph_hi; };
enum { I_XP = 0, I_XS, I_CP, I_CS, I_SPOOL, I_SCONV, I_SSC, I_WADA, I_BADA, I_GPREMIX, I_GPOSTMIX, I_GPREFFN, I_GPOSTFFN, I_WIN, I_WPOOL, I_SPOOLW, I_WDW, I_BDW, I_LNG, I_LNB, I_WSC, I_WOUT, I_WGATE, I_WUP, I_WDOWN };

__device__ __forceinline__ unsigned f2bf(float f) { unsigned u = __builtin_bit_cast(unsigned, f); return (u + 0x7fffu + ((u >> 16) & 1u)) >> 16; }
__device__ __forceinline__ unsigned pk2(float lo, float hi) { unsigned r; asm("v_cvt_pk_bf16_f32 %0, %1, %2" : "=v"(r) : "v"(lo), "v"(hi)); return r; }
__device__ __forceinline__ float bflo(unsigned u) { return __builtin_bit_cast(float, u << 16); }
__device__ __forceinline__ float bfhi(unsigned u) { return __builtin_bit_cast(float, u & 0xffff0000u); }
__device__ __forceinline__ float wave_sum(float v) {
#pragma unroll
    for (int o = 1; o < 64; o <<= 1) v += __shfl_xor(v, o);
    return v;
}
__device__ __forceinline__ float sigmoid_f(float g) { return __builtin_amdgcn_rcpf(1.0f + __builtin_amdgcn_exp2f(-1.44269504089f * g)); }
__device__ __forceinline__ float silu_acc(float g) { return g * __builtin_amdgcn_rcpf(1.0f + __builtin_amdgcn_exp2f(-1.44269504089f * g)); }


#define XB_TMO      128
#define XB_XCNT(j)  (256  + 64 * (j))
#define XB_XSUB(j)  (1280 + 64 * (j))
#define XB_XGEN(j)  (2304 + 64 * (j))
#define XB_TOP      3328
#define XB_TOPGEN   3392
#define XCD_BAR_WORDS 3456
#define XB_SPIN_CAP (1u << 22)
__device__ __forceinline__ unsigned xb_ld(unsigned* p)              { return __hip_atomic_load(p, __ATOMIC_RELAXED, __HIP_MEMORY_SCOPE_AGENT); }
__device__ __forceinline__ unsigned xb_add(unsigned* p, unsigned v) { return __hip_atomic_fetch_add(p, v, __ATOMIC_RELAXED, __HIP_MEMORY_SCOPE_AGENT); }
__device__ __forceinline__ unsigned xb_xcc_id() { return (unsigned)__builtin_amdgcn_s_getreg((3 << 11) | 20) & 0xFu; }
#define XB_SPIN(cond, bar) do { unsigned _sp = 0; while (cond) { __builtin_amdgcn_s_sleep(1); \
    if ((++_sp & 255u) == 0u) { if (xb_ld(&(bar)[XB_TMO])) break; if (_sp > XB_SPIN_CAP) { atomicAdd(&(bar)[XB_TMO], 1u); break; } } } } while (0)
struct XcdBarrier { unsigned* bar; unsigned x; volatile LAS unsigned* st; };
__device__ __forceinline__ XcdBarrier xcd_barrier_post(unsigned* bar, volatile LAS unsigned* st) {
    XcdBarrier b; b.bar = bar; b.x = xb_xcc_id(); b.st = st;
    if (threadIdx.x == 0) (void)xb_add(&bar[XB_XCNT(b.x)], 1u);
    return b;
}
__device__ __forceinline__ void xcd_barrier_complete(unsigned* bar, unsigned x, unsigned& nloc, unsigned& nx) {
    const unsigned G = gridDim.x * gridDim.y * gridDim.z;
    unsigned sum, cnt, mine, sp = 0u;
    for (;;) {
        sum = 0u; cnt = 0u; mine = 0u;
#pragma unroll
        for (unsigned j = 0; j < 16; ++j) { const unsigned c = xb_ld(&bar[XB_XCNT(j)]); sum += c; cnt += (c > 0u) ? 1u : 0u; mine = (j == x) ? c : mine; }
        if (sum == G) break;
        __builtin_amdgcn_s_sleep(1);
        if ((++sp & 255u) == 0u) { if (xb_ld(&bar[XB_TMO])) break; if (sp > XB_SPIN_CAP) { atomicAdd(&bar[XB_TMO], 1u); break; } }
    }
    nloc = mine > 0u ? mine : 1u; nx = cnt > 0u ? cnt : 1u;
}
__device__ __forceinline__ void xcd_barrier(const XcdBarrier& b) {
    asm volatile("s_waitcnt vmcnt(0)" ::: "memory");
    __syncthreads();
    if (threadIdx.x == 0) {
        unsigned* bar = b.bar;
        __builtin_amdgcn_s_waitcnt(0);
        unsigned nloc = b.st[0], nx = b.st[1];
        if (nloc == 0u) { xcd_barrier_complete(bar, b.x, nloc, nx); b.st[0] = nloc; b.st[1] = nx; }
        const unsigned old = xb_add(&bar[XB_XSUB(b.x)], 1u);
        const unsigned gen = old / nloc;
        if (old + 1u == (gen + 1u) * nloc) {
            __builtin_amdgcn_fence(__ATOMIC_RELEASE, "agent");
            asm volatile("s_waitcnt vmcnt(0)" ::: "memory");
            const unsigned og = xb_add(&bar[XB_TOP], 1u);
            const unsigned tg = og / nx;
            if (og + 1u == (tg + 1u) * nx) xb_add(&bar[XB_TOPGEN], 1u);
            else XB_SPIN(xb_ld(&bar[XB_TOPGEN]) == tg, bar);
            __builtin_amdgcn_fence(__ATOMIC_ACQUIRE, "agent");
            xb_add(&bar[XB_XGEN(b.x)], 1u);
            asm volatile("s_waitcnt vmcnt(0)" ::: "memory");
        } else {
            XB_SPIN(xb_ld(&bar[XB_XGEN(b.x)]) == gen, bar);
            __builtin_amdgcn_fence(__ATOMIC_ACQUIRE, "agent");
            asm volatile("s_waitcnt vmcnt(0)" ::: "memory");
        }
    }
    __syncthreads();
}

__device__ __forceinline__ void p0_transpose_item(const float* W, int N, bf16* WT, int Kp, int dest_row0, int k0, int n0, LAS float* scr, int lane) {
    f32x4 tv[8];
#pragma unroll
    for (int i = 0; i < 8; ++i) tv[i] = *(const f32x4*)(W + (size_t)(k0 + 8 * i + (lane >> 3)) * N + n0 + 4 * (lane & 7));
#pragma unroll
    for (int i = 0; i < 8; ++i) { LAS float* d = scr + (8 * i + (lane >> 3)) * 33 + 4 * (lane & 7); d[0] = tv[i][0]; d[1] = tv[i][1]; d[2] = tv[i][2]; d[3] = tv[i][3]; }
    asm volatile("s_waitcnt lgkmcnt(0)" ::: "memory");
    const int c = lane & 7;
#pragma unroll
    for (int j = 0; j < 4; ++j) { const int n = (lane >> 3) + 8 * j; const LAS float* s = scr + (8 * c) * 33 + n;
        u32x4 o; o.x = pk2(s[0 * 33], s[1 * 33]); o.y = pk2(s[2 * 33], s[3 * 33]); o.z = pk2(s[4 * 33], s[5 * 33]); o.w = pk2(s[6 * 33], s[7 * 33]);
        *(u32x4*)(WT + (size_t)(dest_row0 + n) * Kp + k0 + 8 * c) = o; }
    asm volatile("s_waitcnt lgkmcnt(0)" ::: "memory");
}

__device__ __forceinline__ void p0_prologue(const Args& a, LAS unsigned char* lds) {
    int tid = threadIdx.x; asm volatile("" : "+v"(tid));
    const int lane = tid & 63, wave = __builtin_amdgcn_readfirstlane(tid >> 6);
    LAS float* scr = (LAS float*)(lds + wave * 16384);
    const int gw = blockIdx.x * 8 + wave, NGW = gridDim.x * 8;
    constexpr int NMODWG = 192;
    float* modp = (float*)(a.ws + WS_PART);
    for (int wi = blockIdx.x; wi < NMODWG; wi += gridDim.x) {
        const int cb = wi % 96, l = wi / 96;
        LAS float* sc = (LAS float*)(lds + wave * 10240);
        float acc[NMODR];
#pragma unroll
        for (int r = 0; r < NMODR; ++r) acc[r] = 0.f;
        const float* wp = a.in[I_WADA] + (size_t)l * D * 6144 + cb * 64;
#pragma unroll 1
        for (int half = 0; half < 2; ++half) {
            const int kb = wave * 128 + half * 64;
            int ln = lane; asm volatile("" : "+v"(ln));
            float cvv[NMODR];
#pragma unroll
            for (int r = 0; r < NMODR; ++r) cvv[r] = (r < NB) ? a.in[I_CP][r * D + kb + ln] : a.in[I_CS][(r - NB) * D + kb + ln];
#pragma unroll
            for (int r = 0; r < NMODR; ++r) sc[r * 64 + ln] = silu_acc(cvv[r]);
            asm volatile("s_waitcnt lgkmcnt(0)" ::: "memory");
#pragma unroll 1
            for (int k0 = 0; k0 < 64; k0 += 16) {
                int ko = (kb + k0) * 6144 + lane; asm volatile("" : "+v"(ko));
                float w[16];
#pragma unroll
                for (int i = 0; i < 16; ++i) w[i] = wp[ko + i * 6144];
#pragma unroll
                for (int r = 0; r < NMODR; ++r) {
                    const LAS f32x4* sp = (const LAS f32x4*)(sc + r * 64 + k0);
                    const f32x4 s0 = sp[0], s1 = sp[1], s2 = sp[2], s3 = sp[3];
                    acc[r] += ((s0[0] * w[0] + s0[1] * w[1]) + (s0[2] * w[2] + s0[3] * w[3])) + ((s1[0] * w[4] + s1[1] * w[5]) + (s1[2] * w[6] + s1[3] * w[7]))
                            + ((s2[0] * w[8] + s2[1] * w[9]) + (s2[2] * w[10] + s2[3] * w[11])) + ((s3[0] * w[12] + s3[1] * w[13]) + (s3[2] * w[14] + s3[3] * w[15]));
                    if ((r & 3) == 3) asm volatile("" ::: "memory"); }
            }
            asm volatile("s_waitcnt lgkmcnt(0)" ::: "memory");
        }
#pragma unroll
        for (int r = 0; r < NMODR; ++r) sc[r * 64 + lane] = acc[r];
        __syncthreads();
        for (int o = tid; o < NMODR * 64; o += 512) { float v = a.in[I_BADA][l * 6144 + cb * 64 + (o & 63)];
#pragma unroll
            for (int w8 = 0; w8 < 8; ++w8) v += ((const LAS float*)lds)[w8 * 2560 + o];
            modp[((size_t)l * NMODR + (o >> 6)) * 6144 + cb * 64 + (o & 63)] = v; }
        __syncthreads();
    }
    constexpr int I_IN = 16 * (INW / 32), I_OUT = 16 * (D / 32), I_G = 16 * (DFF / 32), I_DN = (DFF / 64) * (D / 32), I_PADZ = 128;
    constexpr int PER_L = I_IN + I_OUT + 2 * I_G + I_DN + I_PADZ;
    unsigned* qctr = (unsigned*)a.ws + 3520;
    (void)gw; (void)NGW; int qbase = 0;
    for (int qi = 0;; ++qi) {
        int itb;
        if ((qi & 7) == 0) { unsigned itq = 0; if (lane == 0) { itq = __hip_atomic_load(qctr, __ATOMIC_RELAXED, __HIP_MEMORY_SCOPE_AGENT); if (itq < (unsigned)(2 * PER_L)) itq = atomicAdd(qctr, 8u); } itb = __builtin_amdgcn_readfirstlane((int)itq); qbase = itb; }
        const int it0 = qbase + (qi & 7);
        if (it0 >= 2 * PER_L) { if ((qi & 7) == 7 || qbase >= 2 * PER_L) break; else continue; }
        const int l = it0 / PER_L; int r = it0 % PER_L;
        bf16* wl = (bf16*)(a.ws + WS_W + (size_t)l * WL_SZ);
        if (r < I_IN) { const int nblk = INW / 32, kb = r / nblk, nb = r % nblk, n0 = nb * 32; int dr;
            if (n0 < 256) dr = n0;
            else if (n0 < 640) { const int j = n0 - 256; dr = 256 * (1 + (j >> 7)) + (j & 127); }
            else if (n0 < 1024) { const int j = n0 - 640; dr = 256 * (1 + (j >> 7)) + 128 + (j & 127); }
            else if (n0 < 1408) { const int j = n0 - 1024; dr = 256 * (4 + (j >> 7)) + (j & 127); }
            else if (n0 < 1792) { dr = 1792 + (n0 - 1408); }
            else { const int j = n0 - 1792; dr = 256 * (4 + (j >> 7)) + 128 + (j & 127); }
            p0_transpose_item(a.in[I_WIN] + (size_t)l * D * INW, INW, (bf16*)((char*)wl + WL_IN), D, dr, kb * 64, n0, scr, lane); continue; } r -= I_IN;
        if (r < I_OUT) { const int nblk = D / 32, kb = r / nblk, nb = r % nblk; p0_transpose_item(a.in[I_WOUT] + (size_t)l * D * D, D, (bf16*)((char*)wl + WL_OUT), D, nb * 32, kb * 64, nb * 32, scr, lane); continue; } r -= I_OUT;
        if (r < 2 * I_G) { const int up = r >= I_G; if (up) r -= I_G; const int nblk = DFF / 32, kb = r / nblk, nb = r % nblk, n0 = nb * 32;
            p0_transpose_item(a.in[up ? I_WUP : I_WGATE] + (size_t)l * D * DFF, DFF, (bf16*)((char*)wl + WL_GU), D, (n0 >> 7) * 256 + up * 128 + (n0 & 127), kb * 64, n0, scr, lane); continue; } r -= 2 * I_G;
        if (r < I_DN) { const int nblk = D / 32, kb = r / nblk, nb = r % nblk; p0_transpose_item(a.in[I_WDOWN] + (size_t)l * DFF * D, D, (bf16*)((char*)wl + WL_DN), DFF, nb * 32, kb * 64, nb * 32, scr, lane); continue; } r -= I_DN;
        { u32x4* z = (u32x4*)((char*)wl + WL_IN + (size_t)(INW + r) * D * 2); z[lane] = (u32x4){0u, 0u, 0u, 0u}; z[lane + 64] = (u32x4){0u, 0u, 0u, 0u}; }
    }
}

__device__ __forceinline__ void load_mod(const Args& a, int l, int r, int which, int lane, f32x4 (&v)[4]) {
    const float* modp = (const float*)(a.ws + WS_PART) + ((size_t)l * NMODR + r) * 6144 + which * 1024;
#pragma unroll
    for (int j = 0; j < 4; ++j) v[j] = *(const f32x4*)(modp + 256 * j + 4 * lane);
}
__device__ __forceinline__ void load_vec(const float* g, int lane, f32x4 (&v)[4]) {
#pragma unroll
    for (int j = 0; j < 4; ++j) v[j] = *(const f32x4*)(g + 256 * j + 4 * lane);
}
template <int MODE, bool XBF>
__device__ __forceinline__ void rows_do(const float* xin, const bf16* xinb, float* xout, bf16* xoutb, const bf16* Y, bf16* H, int nrows, const f32x4 (&GB)[4], const f32x4 (&GA)[4], const f32x4 (&SH)[4], int lane) {
    constexpr int R = 2;
    f32x4 xcf[R][4], xnf[R][4]; u32x2 xcb[R][4], xnb[R][4], yc[R][4], yn[R][4];
#pragma unroll
    for (int rr = 0; rr < R; ++rr) { const int ir = (rr < nrows) ? rr : nrows - 1;
#pragma unroll
        for (int j = 0; j < 4; ++j) {
            if (XBF) xcb[rr][j] = *(const u32x2*)(xinb + (size_t)ir * D + 256 * j + 4 * lane); else xcf[rr][j] = *(const f32x4*)(xin + (size_t)ir * D + 256 * j + 4 * lane);
            if (MODE != 0) yc[rr][j] = *(const u32x2*)(Y + (size_t)ir * D + 256 * j + 4 * lane); } }
    for (int i = 0; i < nrows; i += R) {
#pragma unroll
        for (int rr = 0; rr < R; ++rr) { const int ip = (i + R + rr < nrows) ? i + R + rr : nrows - 1;
#pragma unroll
            for (int j = 0; j < 4; ++j) {
                if (XBF) xnb[rr][j] = *(const u32x2*)(xinb + (size_t)ip * D + 256 * j + 4 * lane); else xnf[rr][j] = *(const f32x4*)(xin + (size_t)ip * D + 256 * j + 4 * lane);
                if (MODE != 0) yn[rr][j] = *(const u32x2*)(Y + (size_t)ip * D + 256 * j + 4 * lane); } }
        f32x4 x[R][4];
#pragma unroll
        for (int rr = 0; rr < R; ++rr)
#pragma unroll
            for (int j = 0; j < 4; ++j) { if (XBF) x[rr][j] = (f32x4){bflo(xcb[rr][j].x), bfhi(xcb[rr][j].x), bflo(xcb[rr][j].y), bfhi(xcb[rr][j].y)}; else x[rr][j] = xcf[rr][j]; }
        const bool v1 = (i + 1 < nrows);
        if (MODE != 0) {
            f32x4 y[R][4]; float ss[R];
#pragma unroll
            for (int rr = 0; rr < R; ++rr) { ss[rr] = 0.f;
#pragma unroll
                for (int j = 0; j < 4; ++j) { y[rr][j] = (f32x4){bflo(yc[rr][j].x), bfhi(yc[rr][j].x), bflo(yc[rr][j].y), bfhi(yc[rr][j].y)}; ss[rr] += (y[rr][j][0] * y[rr][j][0] + y[rr][j][1] * y[rr][j][1]) + (y[rr][j][2] * y[rr][j][2] + y[rr][j][3] * y[rr][j][3]); } }
#pragma unroll
            for (int o = 1; o < 64; o <<= 1) {
#pragma unroll
                for (int rr = 0; rr < R; ++rr) ss[rr] += __shfl_xor(ss[rr], o); }
#pragma unroll
            for (int rr = 0; rr < R; ++rr) { const float rs = __builtin_amdgcn_rsqf(ss[rr] * (1.0f / D) + EPS);
#pragma unroll
                for (int j = 0; j < 4; ++j) x[rr][j] += GB[j] * (y[rr][j] * rs); }
        }
        float rs2[R];
        if (MODE != 2) {
            float ss[R];
#pragma unroll
            for (int rr = 0; rr < R; ++rr) { ss[rr] = 0.f;
#pragma unroll
                for (int j = 0; j < 4; ++j) ss[rr] += (x[rr][j][0] * x[rr][j][0] + x[rr][j][1] * x[rr][j][1]) + (x[rr][j][2] * x[rr][j][2] + x[rr][j][3] * x[rr][j][3]); }
#pragma unroll
            for (int o = 1; o < 64; o <<= 1) {
#pragma unroll
                for (int rr = 0; rr < R; ++rr) ss[rr] += __shfl_xor(ss[rr], o); }
#pragma unroll
            for (int rr = 0; rr < R; ++rr) rs2[rr] = __builtin_amdgcn_rsqf(ss[rr] * (1.0f / D) + EPS);
        }
#pragma unroll
        for (int rr = 0; rr < R; ++rr) {
            const int ir = (rr == 0 || v1) ? i + rr : i;
#pragma unroll
            for (int j = 0; j < 4; ++j) {
                if (MODE == 2) *(f32x4*)(xout + (size_t)ir * D + 256 * j + 4 * lane) = x[rr][j];
                if (MODE == 1) { u32x2 o; o.x = pk2(x[rr][j][0], x[rr][j][1]); o.y = pk2(x[rr][j][2], x[rr][j][3]); *(u32x2*)(xoutb + (size_t)ir * D + 256 * j + 4 * lane) = o; }
                if (MODE != 2) { const f32x4 h = (x[rr][j] * rs2[rr]) * GA[j] + SH[j]; u32x2 o; o.x = pk2(h[0], h[1]); o.y = pk2(h[2], h[3]); *(u32x2*)(H + (size_t)ir * D + 256 * j + 4 * lane) = o; }
            }
        }
#pragma unroll
        for (int rr = 0; rr < R; ++rr)
#pragma unroll
            for (int j = 0; j < 4; ++j) { if (XBF) xcb[rr][j] = xnb[rr][j]; else xcf[rr][j] = xnf[rr][j]; if (MODE != 0) yc[rr][j] = yn[rr][j]; }
    }
}
template <int MODE>
__device__ __forceinline__ void row_phase(const Args& a, bool x_from_input, int lb, int wgt, const float* gpost, int lh, int wsh, const float* gpre) {
    int tid = threadIdx.x; asm volatile("" : "+v"(tid));
    const int lane = tid & 63, wave = __builtin_amdgcn_readfirstlane(tid >> 6);
    const int gw = blockIdx.x * 8 + wave, NGW = gridDim.x * 8;
    const bf16* Y = (const bf16*)(a.ws + WS_Y); bf16* H = (bf16*)(a.ws + WS_H); bf16* XB = (bf16*)(a.ws + WS_XB);
    const int nchunk = MP / 32 + MS;
    for (int ch = gw; ch < nchunk; ch += NGW) {
        int row0, nrows, r;
        if (ch < MP / 32) { row0 = ch * 32; nrows = 32; r = row0 / T_P; } else { const int j = ch - MP / 32; row0 = MP + j; nrows = 1; r = NB + j / T_S; }
        f32x4 GB[4], GA[4], SH[4];
        if (MODE != 0) { f32x4 gt[4], gp[4]; load_mod(a, lb, r, wgt, lane, gt); load_vec(gpost, lane, gp);
#pragma unroll
            for (int j = 0; j < 4; ++j) GB[j] = gt[j] * gp[j]; }
        if (MODE != 2) { f32x4 sc[4], gp[4]; load_mod(a, lh, r, wsh + 1, lane, sc); load_mod(a, lh, r, wsh, lane, SH); load_vec(gpre, lane, gp);
#pragma unroll
            for (int j = 0; j < 4; ++j) GA[j] = gp[j] * (1.0f + sc[j]); }
        const float* xin = (row0 < MP ? a.in[I_XP] + (size_t)row0 * D : a.in[I_XS] + (size_t)(row0 - MP) * D);
        if (MODE == 0 || (MODE == 1 && x_from_input)) rows_do<MODE, false>(xin, XB + (size_t)row0 * D, a.out + (size_t)row0 * D, XB + (size_t)row0 * D, Y + (size_t)row0 * D, H + (size_t)row0 * D, nrows, GB, GA, SH, lane);
        else rows_do<(MODE == 0 ? 1 : MODE), true>(xin, XB + (size_t)row0 * D, a.out + (size_t)row0 * D, XB + (size_t)row0 * D, Y + (size_t)row0 * D, H + (size_t)row0 * D, nrows, GB, GA, SH, lane);
    }
}

template <int N, int SZ>
__device__ __forceinline__ void tr_reduce_step(float (&v)[SZ], int lane) {
    constexpr int Hh = N / 2;
    const bool up = (lane & Hh) != 0;
#pragma unroll
    for (int i = 0; i < Hh; ++i) { const float send = up ? v[i] : v[i + Hh]; const float keep = up ? v[i + Hh] : v[i]; v[i] = keep + __shfl_xor(send, Hh); }
}
template <int R, int N> struct ConvLoop {
    static __device__ __forceinline__ void run(f32x2 (&z)[32], const f32x2 (&w)[31], const LAS unsigned* up) {
        const unsigned v = up[R * 192]; const f32x2 uv = {bflo(v), bfhi(v)};
#pragma unroll
        for (int i = (R - 30 > 0 ? R - 30 : 0); i <= (R < 31 ? R : 31); ++i) z[i] += w[R - i] * uv;
        if ((R & 7) == 7) asm volatile("" ::: "memory");
        ConvLoop<R + 1, N>::run(z, w, up);
    }
};
template <int N> struct ConvLoop<N, N> { static __device__ __forceinline__ void run(f32x2 (&)[32], const f32x2 (&)[31], const LAS unsigned*) {} };

constexpr int MIX_UC = 0, MIX_XA = 73728, XA_PITCH = 528, MIX_ST = MIX_XA + 79 * XA_PITCH;
static_assert(MIX_ST + 6 * 64 * 4 <= 131072, "mixer LDS");

__device__ __forceinline__ void mixer_phase(const Args& a, int l, LAS unsigned char* lds, int mode = 7) {
    const bf16* P = (const bf16*)(a.ws + WS_P); bf16* CAT = (bf16*)(a.ws + WS_CAT);
    LAS bf16* Uc = (LAS bf16*)(lds + MIX_UC);
    LAS unsigned char* XaB = lds + MIX_XA;
    LAS float* ST = (LAS float*)(lds + MIX_ST);
    const int NU = MP / 64 + NDB;
    for (int u = blockIdx.x; u < NU; u += gridDim.x) {
        int tid = threadIdx.x; asm volatile("" : "+v"(tid));
        const int lane = tid & 63, wave = __builtin_amdgcn_readfirstlane(tid >> 6);
        int rowbase, T, t0, start, b; bool smp;
        if (u < MP / 64) {
            int uu = u;
            if (gridDim.x == 256) { const int k_ = u >> 8, c_ = u & 255; uu = (8 * k_ + (c_ & 7)) * 32 + (((c_ >> 3) + 8 * k_) & 31); }
            b = uu / 32; t0 = (uu % 32) * 64; T = T_P; start = 0; rowbase = b * T_P; smp = false; }
        else { b = u - MP / 64; t0 = 0; T = T_S; start = PASTLEN; rowbase = MP + b * T_S; smp = true; }
        const int nbat = smp ? NDB : NB;
        float* pool_out = a.out + (smp ? O_POOLS : O_POOLP) + ((size_t)l * nbat + b) * 15 * 256;
        float* conv_out = a.out + (smp ? O_CONVS : O_CONVP) + ((size_t)l * nbat + b) * 30 * 384;
        float* sc_out = a.out + (smp ? O_SCS : O_SCP) + ((size_t)l * nbat + b) * 2 * 384;
        const float* st_pool = a.in[I_SPOOL] + ((size_t)l * NDB + b) * 15 * 256;
        const float* st_conv = a.in[I_SCONV] + ((size_t)l * NDB + b) * 30 * 384;
        const float* st_sc = a.in[I_SSC] + ((size_t)l * NDB + b) * 2 * 384;
        const int seg = tid / 48, oc = tid - seg * 48, cc = oc * 8;
        u32x4 va[12], vb[5];
        if (tid < 384) {
#pragma unroll
            for (int q = 0; q < 12; ++q) { const int r = seg + 8 * q, t = t0 - 30 + r;
                va[q] = (u32x4){0u, 0u, 0u, 0u};
                if (r < 94 && t >= 0 && t < T) va[q] = *(const u32x4*)(P + (size_t)(rowbase + t) * P2W + 256 + cc); }
        }
#pragma unroll
        for (int q = 0; q < 5; ++q) { const int i = tid + 512 * q, r = i >> 5, o = i & 31, t = t0 - 15 + r;
            vb[q] = (u32x4){0u, 0u, 0u, 0u};
            if (i < 79 * 32 && t >= 0 && t < T) vb[q] = *(const u32x4*)(P + (size_t)(rowbase + t) * P2W + o * 8); }
        if (smp) {
            if (tid < 384) {
#pragma unroll
                for (int q = 0; q < 4; ++q) { const int r = seg + 8 * q, t = r - 30;
                    if (t < 0) { const f32x4 p0 = *(const f32x4*)(st_conv + (30 + t) * 384 + cc), p1 = *(const f32x4*)(st_conv + (30 + t) * 384 + cc + 4);
                        va[q].x = pk2(p0[0], p0[1]); va[q].y = pk2(p0[2], p0[3]); va[q].z = pk2(p1[0], p1[1]); va[q].w = pk2(p1[2], p1[3]); } }
            }
#pragma unroll
            for (int q = 0; q < 1; ++q) { const int i = tid, r = i >> 5, o = i & 31, t = r - 15, c = o * 8;
                if (t < 0) { const f32x4 p0 = *(const f32x4*)(st_pool + (15 + t) * 256 + c), p1 = *(const f32x4*)(st_pool + (15 + t) * 256 + c + 4);
                    vb[q].x = pk2(p0[0], p0[1]); vb[q].y = pk2(p0[2], p0[3]); vb[q].z = pk2(p1[0], p1[1]); vb[q].w = pk2(p1[2], p1[3]); } }
        }
        if (tid < 384) {
#pragma unroll
            for (int q = 0; q < 12; ++q) { const int r = seg + 8 * q; if (r < 94) *(LAS u32x4*)(Uc + r * 384 + cc) = va[q]; }
        }
#pragma unroll
        for (int q = 0; q < 5; ++q) { const int i = tid + 512 * q, r = i >> 5, o = i & 31; if (i < 79 * 32) *(LAS u32x4*)(XaB + r * XA_PITCH + o * 16) = vb[q]; }
        if (t0 + 64 >= T && !smp) {
            u32x4 cw[3], pw, sw;
#pragma unroll
            for (int q = 0; q < 3; ++q) { const int i = tid + 512 * q, sr = i / 48, o = i - sr * 48; cw[q] = (u32x4){0u, 0u, 0u, 0u};
                if (i < 30 * 48) cw[q] = *(const u32x4*)(P + (size_t)(rowbase + T - 30 + sr) * P2W + 256 + o * 8); }
            pw = (u32x4){0u, 0u, 0u, 0u}; sw = (u32x4){0u, 0u, 0u, 0u};
            if (tid < 15 * 32) pw = *(const u32x4*)(P + (size_t)(rowbase + T - 15 + (tid >> 5)) * P2W + (tid & 31) * 8);
            if (tid < 2 * 48) sw = *(const u32x4*)(P + (size_t)(rowbase + T - 2 + tid / 48) * P2W + 640 + (tid % 48) * 8);
#pragma unroll
            for (int q = 0; q < 3; ++q) { const int i = tid + 512 * q, sr = i / 48, o = i - sr * 48; const u32x4 w = cw[q];
                if (i < 30 * 48) { float* d = conv_out + sr * 384 + o * 8; *(f32x4*)d = (f32x4){bflo(w.x), bfhi(w.x), bflo(w.y), bfhi(w.y)}; *(f32x4*)(d + 4) = (f32x4){bflo(w.z), bfhi(w.z), bflo(w.w), bfhi(w.w)}; } }
            if (tid < 15 * 32) { float* d = pool_out + (tid >> 5) * 256 + (tid & 31) * 8; *(f32x4*)d = (f32x4){bflo(pw.x), bfhi(pw.x), bflo(pw.y), bfhi(pw.y)}; *(f32x4*)(d + 4) = (f32x4){bflo(pw.z), bfhi(pw.z), bflo(pw.w), bfhi(pw.w)}; }
            if (tid < 2 * 48) { float* d = sc_out + (tid / 48) * 384 + (tid % 48) * 8; *(f32x4*)d = (f32x4){bflo(sw.x), bfhi(sw.x), bflo(sw.y), bfhi(sw.y)}; *(f32x4*)(d + 4) = (f32x4){bflo(sw.z), bfhi(sw.z), bflo(sw.w), bfhi(sw.w)}; }
        } else if (t0 + 64 >= T) {
            f32x4 a0v = {0.f, 0.f, 0.f, 0.f}, a1v = a0v, b0v = a0v, b1v = a0v; u32x4 bw = {0u, 0u, 0u, 0u}, cw2 = bw, pw = bw, sw = bw;
            { const int i = tid, sr = i / 48, c = (i - sr * 48) * 8; a0v = *(const f32x4*)(st_conv + (16 + sr) * 384 + c); a1v = *(const f32x4*)(st_conv + (16 + sr) * 384 + c + 4); }
            const int i1 = tid + 512, sr1 = i1 / 48, c1 = (i1 - sr1 * 48) * 8, t1 = sr1 - 14;
            if (t1 < 0) { b0v = *(const f32x4*)(st_conv + (30 + t1) * 384 + c1); b1v = *(const f32x4*)(st_conv + (30 + t1) * 384 + c1 + 4); }
            else bw = *(const u32x4*)(P + (size_t)(rowbase + t1) * P2W + 256 + c1);
            const int i2 = tid + 1024, sr2 = i2 / 48, c2 = (i2 - sr2 * 48) * 8;
            if (i2 < 30 * 48) cw2 = *(const u32x4*)(P + (size_t)(rowbase + sr2 - 14) * P2W + 256 + c2);
            if (tid < 15 * 32) pw = *(const u32x4*)(P + (size_t)(rowbase + (tid >> 5) + 1) * P2W + (tid & 31) * 8);
            if (tid < 2 * 48) sw = *(const u32x4*)(P + (size_t)(rowbase + 14 + tid / 48) * P2W + 640 + (tid % 48) * 8);
            { const int i = tid, sr = i / 48, c = (i - sr * 48) * 8; float* d = conv_out + sr * 384 + c; *(f32x4*)d = a0v; *(f32x4*)(d + 4) = a1v; }
            { float* d = conv_out + sr1 * 384 + c1;
              if (t1 < 0) { *(f32x4*)d = b0v; *(f32x4*)(d + 4) = b1v; }
              else { *(f32x4*)d = (f32x4){bflo(bw.x), bfhi(bw.x), bflo(bw.y), bfhi(bw.y)}; *(f32x4*)(d + 4) = (f32x4){bflo(bw.z), bfhi(bw.z), bflo(bw.w), bfhi(bw.w)}; } }
            if (i2 < 30 * 48) { float* d = conv_out + sr2 * 384 + c2; *(f32x4*)d = (f32x4){bflo(cw2.x), bfhi(cw2.x), bflo(cw2.y), bfhi(cw2.y)}; *(f32x4*)(d + 4) = (f32x4){bflo(cw2.z), bfhi(cw2.z), bflo(cw2.w), bfhi(cw2.w)}; }
            if (tid < 15 * 32) { float* d = pool_out + (tid >> 5) * 256 + (tid & 31) * 8; *(f32x4*)d = (f32x4){bflo(pw.x), bfhi(pw.x), bflo(pw.y), bfhi(pw.y)}; *(f32x4*)(d + 4) = (f32x4){bflo(pw.z), bfhi(pw.z), bflo(pw.w), bfhi(pw.w)}; }
            if (tid < 2 * 48) { float* d = sc_out + (tid / 48) * 384 + (tid % 48) * 8; *(f32x4*)d = (f32x4){bflo(sw.x), bfhi(sw.x), bflo(sw.y), bfhi(sw.y)}; *(f32x4*)(d + 4) = (f32x4){bflo(sw.z), bfhi(sw.z), bflo(sw.w), bfhi(sw.w)}; }
        }
        if (tid < 384) {
            float w0[8], w1[8], w2[8];
            { const float* ws = a.in[I_WSC] + (size_t)l * 3 * 384 + cc;
#pragma unroll
              for (int e = 0; e < 8; ++e) { w0[e] = ws[e]; w1[e] = ws[384 + e]; w2[e] = ws[768 + e]; } }
            float up2[8], up1[8];
#pragma unroll
            for (int ps = 0; ps < 2; ++ps) {
                u32x4 vu[6], vg[4];
#pragma unroll
                for (int d = (ps ? 2 : 0); d < 6; ++d) { const int t = t0 + 8 * seg + 4 * ps + d - 2; vu[d] = (u32x4){0u, 0u, 0u, 0u};
                    if (t >= 0 && t < T) vu[d] = *(const u32x4*)(P + (size_t)(rowbase + t) * P2W + 640 + cc); }
#pragma unroll
                for (int d = 0; d < 4; ++d) { const int t = t0 + 8 * seg + 4 * ps + d; vg[d] = (u32x4){0u, 0u, 0u, 0u};
                    if (t < T) vg[d] = *(const u32x4*)(P + (size_t)(rowbase + t) * P2W + 1024 + cc); }
#pragma unroll
                for (int d = (ps ? 2 : 0); d < 6; ++d) {
                    const int t = t0 + 8 * seg + 4 * ps + d - 2;
                    float uc[8];
#pragma unroll
                    for (int e = 0; e < 4; ++e) { uc[2 * e] = bflo(vu[d][e]); uc[2 * e + 1] = bfhi(vu[d][e]); }
                    if (ps == 0 && d < 2 && smp && t < 0) { const f32x4 p0 = *(const f32x4*)(st_sc + (2 + t) * 384 + cc), p1 = *(const f32x4*)(st_sc + (2 + t) * 384 + cc + 4);
#pragma unroll
                        for (int e = 0; e < 4; ++e) { uc[e] = p0[e]; uc[4 + e] = p1[e]; } }
                    if (d >= 2) {
                        const u32x4 bv = vg[d - 2];
                        float y[8];
#pragma unroll
                        for (int e = 0; e < 4; ++e) {
                            y[2 * e] = bflo(bv[e]) * (w0[2 * e] * up2[2 * e] + w1[2 * e] * up1[2 * e] + w2[2 * e] * uc[2 * e]);
                            y[2 * e + 1] = bfhi(bv[e]) * (w0[2 * e + 1] * up2[2 * e + 1] + w1[2 * e + 1] * up1[2 * e + 1] + w2[2 * e + 1] * uc[2 * e + 1]); }
                        { u32x4 w; w.x = pk2(y[0], y[1]); w.y = pk2(y[2], y[3]); w.z = pk2(y[4], y[5]); w.w = pk2(y[6], y[7]);
                          *(u32x4*)(CAT + (size_t)(t < T ? rowbase + t : MR + (t & 63)) * D + 640 + cc) = w; }
                    }
#pragma unroll
                    for (int e = 0; e < 8; ++e) { if (ps == 1 || d >= 1) up2[e] = up1[e]; up1[e] = uc[e]; }
                }
            }
        }
        __syncthreads();
        f32x2 z[32];
        int tid2 = tid; asm volatile("" : "+v"(tid2));
        const int half = (tid2 >= 192) ? 1 : 0, p = tid2 - 192 * half;
        const bool rows_live = (t0 + 32 * half) < T;
        if (wave < 6 && (mode & 2) && rows_live) {
            f32x2 w[31];
            const float* wd = a.in[I_WDW] + (size_t)l * 31 * 384 + 2 * p;
#pragma unroll
            for (int j = 0; j < 31; ++j) w[j] = *(const f32x2*)(wd + j * 384);
            const f32x2 bb = *(const f32x2*)(a.in[I_BDW] + l * 384 + 2 * p);
#pragma unroll
            for (int i = 0; i < 32; ++i) z[i] = bb;
            const LAS unsigned* up = (const LAS unsigned*)Uc + (32 * half) * 192 + p;
            ConvLoop<0, 62>::run(z, w, up);
            float sv[32];
            { const bool up = (lane & 32) != 0;
#pragma unroll
              for (int i = 0; i < 32; ++i) { const f32x2 zl = z[i >> 1], zh = z[16 + (i >> 1)];
                  const float va_ = (i & 1) ? (zl[0] * zl[0] + zl[1] * zl[1]) : (zl[0] + zl[1]), vb_ = (i & 1) ? (zh[0] * zh[0] + zh[1] * zh[1]) : (zh[0] + zh[1]);
                  const float send = up ? va_ : vb_, keep = up ? vb_ : va_; sv[i] = keep + __shfl_xor(send, 32);
                  if ((i & 7) == 7) asm volatile("" ::: "memory"); } }
            tr_reduce_step<32>(sv, lane); tr_reduce_step<16>(sv, lane); tr_reduce_step<8>(sv, lane); tr_reduce_step<4>(sv, lane); tr_reduce_step<2>(sv, lane);
            ST[wave * 64 + lane] = sv[0];
        } else if (mode & 2) {
            const int fr = tid2 & 15, fq = (tid2 & 63) >> 4;
#pragma unroll 1
            for (int gi = 0; gi < 2; ++gi) {
                const int g = (wave == 6) ? (gi ? 3 : 0) : (gi ? 2 : 1), win = 2 << g;
                bf16x8 Wf[4][2];
#pragma unroll
                for (int nt = 0; nt < 4; ++nt)
#pragma unroll
                    for (int kk = 0; kk < 2; ++kk) { const float* wp = a.in[I_WPOOL] + (((size_t)l * 4 + g) * 64 + 32 * kk + 8 * fq) * 64 + 16 * nt + fr;
                        u32x4 q; q.x = pk2(wp[0], wp[64]); q.y = pk2(wp[128], wp[192]); q.z = pk2(wp[256], wp[320]); q.w = pk2(wp[384], wp[448]);
                        Wf[nt][kk] = __builtin_bit_cast(bf16x8, q); }
                f32x4 spv[4];
#pragma unroll
                for (int nt = 0; nt < 4; ++nt) spv[nt] = *(const f32x4*)(a.in[I_SPOOLW] + l * 256 + 64 * g + 16 * nt + 4 * fq);
#pragma unroll 1
                for (int mt = 0; mt < 4; ++mt) {
                    if (t0 + 16 * mt >= T) break;
                    const int i = 16 * mt + fr, r = i + 15;
                    const int pos = t0 + i + start; const float cnt = (float)((pos + 1 < win) ? pos + 1 : win); const float inv = 1.0f / cnt;
                    bf16x8 Af[2];
#pragma unroll
                    for (int kk = 0; kk < 2; ++kk) {
                        const LAS unsigned char* base = XaB + r * XA_PITCH + (64 * g + 32 * kk + 8 * fq) * 2;
                        float s[8];
#pragma unroll
                        for (int e = 0; e < 8; ++e) s[e] = 0.f;
                        for (int d = 0; d < win; ++d) { const u32x4 v = *(const LAS u32x4*)(base - d * XA_PITCH);
#pragma unroll
                            for (int e = 0; e < 4; ++e) { s[2 * e] += bflo(v[e]); s[2 * e + 1] += bfhi(v[e]); } }
                        const u32x4 cv = *(const LAS u32x4*)base;
                        u32x4 q;
#pragma unroll
                        for (int e = 0; e < 4; ++e) q[e] = pk2(s[2 * e] * inv - bflo(cv[e]), s[2 * e + 1] * inv - bfhi(cv[e]));
                        Af[kk] = __builtin_bit_cast(bf16x8, q);
                    }
                    const bool valid = (t0 + i) < T;
#pragma unroll
                    for (int nt = 0; nt < 4; ++nt) {
                        f32x4 acc = {0.f, 0.f, 0.f, 0.f};
                        acc = __builtin_amdgcn_mfma_f32_16x16x32_bf16(Wf[nt][0], Af[0], acc, 0, 0, 0);
                        acc = __builtin_amdgcn_mfma_f32_16x16x32_bf16(Wf[nt][1], Af[1], acc, 0, 0, 0);
                        const f32x4 sp = spv[nt];
                        u32x2 o; o.x = pk2(acc[0] * sp[0], acc[1] * sp[1]); o.y = pk2(acc[2] * sp[2], acc[3] * sp[3]);
                        *(u32x2*)(CAT + (size_t)(valid ? rowbase + t0 + i : MR + i) * D + 64 * g + 16 * nt + 4 * fq) = o;
                    }
                }
            }
        }
        __syncthreads();
        if (wave < 6 && (mode & 4) && rows_live) {
            f32x2 lg = *(const f32x2*)(a.in[I_LNG] + l * 384 + 2 * p), lb = *(const f32x2*)(a.in[I_LNB] + l * 384 + 2 * p);
            asm volatile("" : "+v"(lg), "+v"(lb));
            const float tot = ST[(3 * half) * 64 + lane] + ST[(3 * half + 1) * 64 + lane] + ST[(3 * half + 2) * 64 + lane];
            const float oth = __shfl_xor(tot, 1);
            const float s1 = (lane & 1) ? oth : tot, s2 = (lane & 1) ? tot : oth;
            const float mu_l = s1 * (1.0f / 384.0f); float var_l = s2 * (1.0f / 384.0f) - mu_l * mu_l; var_l = var_l > 0.f ? var_l : 0.f;
            const float rstd_l = __builtin_amdgcn_rsqf(var_l + EPS);
            const int trow = t0 + 32 * half;
            bf16* crow = CAT + (size_t)(rowbase + trow) * D + 256 + 2 * p;
            bf16* cdummy = CAT + (size_t)(MR + 32 * half) * D + 256 + 2 * p;
#pragma unroll
            for (int i = 0; i < 32; ++i) {
                const float mu = __builtin_bit_cast(float, __builtin_amdgcn_readlane(__builtin_bit_cast(int, mu_l), 2 * i));
                const float rstd = __builtin_bit_cast(float, __builtin_amdgcn_readlane(__builtin_bit_cast(int, rstd_l), 2 * i));
                const f32x2 sc2 = lg * rstd, of2 = lb - sc2 * mu;
                const f32x2 y = z[i] * sc2 + of2;
                *(unsigned*)((trow + i < T ? crow + (size_t)i * D : cdummy + (size_t)i * D)) = pk2(y[0] * sigmoid_f(y[0]), y[1] * sigmoid_f(y[1]));
            }
        }
    }
    __syncthreads();
}


__device__ __forceinline__ void sample_gemm(int kind, const bf16* A, const bf16* Bt, int NT, int K, bf16* O, int ldc) {
    int tid = threadIdx.x; asm volatile("" : "+v"(tid));
    const int lane = tid & 63, wave = __builtin_amdgcn_readfirstlane(tid >> 6), fr = lane & 15, fq = lane >> 4;
    const int gw = blockIdx.x * 8 + wave, NGW = gridDim.x * 8, ntask = NT * 64;
    for (int task = gw; task < ntask; task += NGW) {
        const int mt = task & 7, sb = (task >> 3) & 7, pn = task >> 6;
        const bf16* ap = A + (size_t)(mt * 16 + fr) * K + 8 * fq;
        const bf16* bp0 = Bt + (size_t)(256 * pn + 16 * sb + fr) * K + 8 * fq;
        const bf16* bp1 = bp0 + (size_t)128 * K;
        f32x4 acc0 = {0.f, 0.f, 0.f, 0.f}, acc1 = {0.f, 0.f, 0.f, 0.f};
        bf16x8 fa[4], fb0[4], fb1[4], ga[4], gb0[4], gb1[4];
#pragma unroll
        for (int j = 0; j < 4; ++j) { fa[j] = *(const bf16x8*)(ap + 32 * j); fb0[j] = *(const bf16x8*)(bp0 + 32 * j); fb1[j] = *(const bf16x8*)(bp1 + 32 * j); }
#pragma unroll 1
        for (int k0 = 0; k0 < K; k0 += 256) {
#pragma unroll
            for (int j = 0; j < 4; ++j) { ga[j] = *(const bf16x8*)(ap + k0 + 128 + 32 * j); gb0[j] = *(const bf16x8*)(bp0 + k0 + 128 + 32 * j); gb1[j] = *(const bf16x8*)(bp1 + k0 + 128 + 32 * j); }
#pragma unroll
            for (int j = 0; j < 4; ++j) { acc0 = __builtin_amdgcn_mfma_f32_16x16x32_bf16(fb0[j], fa[j], acc0, 0, 0, 0); acc1 = __builtin_amdgcn_mfma_f32_16x16x32_bf16(fb1[j], fa[j], acc1, 0, 0, 0); }
            const int kn = (k0 + 256 < K) ? k0 + 256 : k0;
#pragma unroll
            for (int j = 0; j < 4; ++j) { fa[j] = *(const bf16x8*)(ap + kn + 32 * j); fb0[j] = *(const bf16x8*)(bp0 + kn + 32 * j); fb1[j] = *(const bf16x8*)(bp1 + kn + 32 * j); }
#pragma unroll
            for (int j = 0; j < 4; ++j) { acc0 = __builtin_amdgcn_mfma_f32_16x16x32_bf16(gb0[j], ga[j], acc0, 0, 0, 0); acc1 = __builtin_amdgcn_mfma_f32_16x16x32_bf16(gb1[j], ga[j], acc1, 0, 0, 0); }
        }
        bf16* orow = O + (size_t)(mt * 16 + fr) * ldc + 16 * sb + 4 * fq;
        int mode = 0, col = 256 * pn;
        if (kind == 0) { if (pn == 0) col = 0; else if (pn >= 7) { col = 1024 + (pn - 7) * 256; if (pn == 8) mode = 1; } else if (pn <= 3) { mode = 2; col = 256 + (pn - 1) * 128; } else { mode = 3; col = 640 + (pn - 4) * 128; } }
        else if (kind == 2) { mode = 4; col = 128 * pn; }
        if (mode <= 1) {
            u32x2 o; o.x = pk2(acc0[0], acc0[1]); o.y = pk2(acc0[2], acc0[3]); *(u32x2*)(orow + col) = o;
            if (mode == 0) { u32x2 q; q.x = pk2(acc1[0], acc1[1]); q.y = pk2(acc1[2], acc1[3]); *(u32x2*)(orow + col + 128) = q; }
        } else {
            f32x4 r;
#pragma unroll
            for (int e = 0; e < 4; ++e) r[e] = (mode == 2) ? acc0[e] * sigmoid_f(acc1[e]) : (mode == 3) ? acc0[e] * acc1[e] : acc0[e] * sigmoid_f(acc0[e]) * acc1[e];
            u32x2 o; o.x = pk2(r[0], r[1]); o.y = pk2(r[2], r[3]); *(u32x2*)(orow + col) = o;
        }
    }
}

constexpr int NPH = 16;
__global__ void __launch_bounds__(512) mega_fwd(Args a) {
    extern __shared__ __attribute__((aligned(16))) unsigned char lds_raw[];
    LAS unsigned char* lds = (LAS unsigned char*)lds_raw;
    cg::grid_group grid = cg::this_grid();
#if ONE_LAUNCH
    volatile LAS unsigned* xst = (volatile LAS unsigned*)(lds + 131072 + 256);
    if (threadIdx.x < 2) xst[threadIdx.x] = 0u;
    __syncthreads();
    const XcdBarrier xbar = xcd_barrier_post((unsigned*)a.ws, xst);
#endif
    bf16* H = (bf16*)(a.ws + WS_H); bf16* Y = (bf16*)(a.ws + WS_Y); bf16* P = (bf16*)(a.ws + WS_P); bf16* CAT = (bf16*)(a.ws + WS_CAT); bf16* ACT = (bf16*)(a.ws + WS_ACT);
#ifdef SYNC_PROBE
    for (int i_ = 0; i_ < SYNC_PROBE; ++i_) grid.sync();
#endif
    for (int ph = a.ph_lo; ph < a.ph_hi; ++ph) {
#ifdef DUP_MASK
      const int kk_ = ph < 2 ? ph + 7 : (ph - 2) % 7;
      const int nrep_ = ((DUP_MASK >> kk_) & 1) ? 2 : 1;
      for (int rep_ = 0; rep_ < nrep_; ++rep_) {
        if (rep_) grid.sync();
#endif
        if (ph == 0) {
#ifndef SKIP_P0
            p0_prologue(a, lds);
#endif
        }
        else if (ph == 1) {
#ifndef SKIP_ROW
            row_phase<0>(a, true, 0, 0, nullptr, 0, 0, a.in[I_GPREMIX]);
#endif
        }
        else {
            const int l = (ph - 2) / 7, k = (ph - 2) % 7;
            const unsigned char* wl = a.ws + WS_W + (size_t)l * WL_SZ;
            if (k == 0 || k == 2 || k == 4 || k == 5) {
                const bf16* sA; const bf16* sB; bf16* sO; int sNT, sK, sld, skind;
                if (k == 0) {
                    pg8::Gemm g{H, (const bf16*)(wl + WL_IN), MP, INWP, D}; pg8::EpiInProj E{P, P2W};
                    pg8::StaticOrder S; S.init(g.M, g.N, gridDim.x, blockIdx.x);
                    pg8::gemm_phase<pg8::EpiInProj, pg8::StaticOrder, true, true>(lds, g, S, E);
                    sA = H; sB = g.Bt; sO = P; sNT = INWP / 256; sK = D; sld = P2W; skind = 0;
                } else if (k == 4) {
#ifndef SKIP_G3
                    pg8::Gemm g{H, (const bf16*)(wl + WL_GU), MP, NGU, D}; pg8::EpiSwiGLU E{ACT, DFF};
                    pg8::StaticOrder S; S.init(g.M, g.N, gridDim.x, blockIdx.x);
                    pg8::gemm_phase<pg8::EpiSwiGLU, pg8::StaticOrder, true, true>(lds, g, S, E);
#endif
                    sA = H; sB = (const bf16*)(wl + WL_GU); sO = ACT; sNT = NGU / 256; sK = D; sld = DFF; skind = 2;
                } else {
#ifndef SKIP_G1
                    pg8::Gemm g; pg8::EpiBf16 E;
                    if (k == 2) { g = pg8::Gemm{CAT, (const bf16*)(wl + WL_OUT), MP, D, D}; E = pg8::EpiBf16{Y, D}; }
                    else { g = pg8::Gemm{ACT, (const bf16*)(wl + WL_DN), MP, D, DFF}; E = pg8::EpiBf16{Y, D}; }
                    pg8::StaticOrder S; S.init(g.M, g.N, gridDim.x, blockIdx.x);
                    pg8::gemm_phase<pg8::EpiBf16, pg8::StaticOrder, true, true>(lds, g, S, E);
#endif
                    sA = (k == 2) ? CAT : ACT; sB = (const bf16*)(wl + (k == 2 ? WL_OUT : WL_DN)); sO = Y; sNT = D / 256; sK = (k == 2) ? D : DFF; sld = D; skind = 1;
                }
                sample_gemm(skind, sA + (size_t)MP * sK, sB, sNT, sK, sO + (size_t)MP * sld, sld);
            } else if (k == 1) {
#ifndef SKIP_MIX
#ifdef MIX_PROBE
                for (int rep = 0; rep < 2; ++rep) { int md = rep ? 7 : MIX_PROBE; asm volatile("" : "+s"(md)); mixer_phase(a, l, lds, md); if (rep == 0) grid.sync(); }
#else
                mixer_phase(a, l, lds);
#endif
#endif
            }
            else if (k == 3) {
#ifndef SKIP_ROW
                row_phase<1>(a, l == 0, l, 2, a.in[I_GPOSTMIX] + l * D, l, 3, a.in[I_GPREFFN] + l * D);
#endif
            }
            else {
#ifndef SKIP_ROW
                if (l == 0) row_phase<1>(a, false, 0, 5, a.in[I_GPOSTFFN], 1, 0, a.in[I_GPREMIX] + D);
                else row_phase<2>(a, false, 1, 5, a.in[I_GPOSTFFN] + D, 1, 0, nullptr);
#endif
            }
        }
#ifdef DUP_MASK
      }
#endif
#if ONE_LAUNCH
        if (ph + 1 < a.ph_hi) { if (a.ph_lo != 0) grid.sync(); else xcd_barrier(xbar); }
#else
        if (ph + 1 < a.ph_hi) grid.sync();
#endif
    }
}

extern "C" void kernel_launch(void* const* d_in, const int* in_sizes, int n_in, void* d_out, int out_size, void* d_ws, size_t ws_size, hipStream_t stream) {
    static int grid = 0;
    if (grid == 0) {
        if (n_in != 25 || ws_size < WS_END) { fprintf(stderr, "kernel_launch: unexpected n_in %d / ws_size %zu\n", n_in, ws_size); grid = -1; return; }
        int dev = 0, cus = 0, per_cu = 0;
        hipGetDevice(&dev); hipDeviceGetAttribute(&cus, hipDeviceAttributeMultiprocessorCount, dev);
        if (hipFuncSetAttribute((const void*)mega_fwd, hipFuncAttributeMaxDynamicSharedMemorySize, LDS_BYTES) != hipSuccess) { fprintf(stderr, "kernel_launch: hipFuncSetAttribute failed\n"); grid = -1; return; }
        if (hipOccupancyMaxActiveBlocksPerMultiprocessor(&per_cu, (const void*)mega_fwd, 512, LDS_BYTES) != hipSuccess || per_cu < 1) { fprintf(stderr, "kernel_launch: occupancy query gave %d\n", per_cu); per_cu = 1; }
        (void)hipGetLastError();
        grid = cus;
    }
    if (grid < 0) return;
    Args a{};
    for (int i = 0; i < 25; ++i) a.in[i] = (const float*)d_in[i];
    a.out = (float*)d_out; a.ws = (unsigned char*)d_ws;
#if ONE_LAUNCH
    if (hipMemsetAsync(d_ws, 0, 16384, stream) != hipSuccess) { fprintf(stderr, "kernel_launch: memset of the barrier words failed\n"); return; }
    a.ph_lo = 0; a.ph_hi = NPH;
    void* args[] = {&a};
    hipError_t e = hipLaunchCooperativeKernel((const void*)mega_fwd, dim3(grid), dim3(512), args, LDS_BYTES, stream);
    if (e != hipSuccess) fprintf(stderr, "cooperative launch failed: %s (grid %d)\n", hipGetErrorString(e), grid);
#else
    (void)hipMemsetAsync(d_ws, 0, 16384, stream);
    for (int ph = 0; ph < NPH; ++ph) { a.ph_lo = ph; a.ph_hi = ph + 1; hipLaunchKernelGGL(mega_fwd, dim3(grid), dim3(512), LDS_BYTES, stream, a); }
#endif
}
```
